# Optimizing an MI355X kernel written in HIP

```python
import math
import jax
import jax.numpy as jnp
from jax import lax

D_MODEL = 1024
BATCH = 8
SEQ = 2048
DEPTH = 4
DEC_BATCH = 32
DEC_SEQ = 4
PAST_LEN = 8192
PAGE_SIZE = 128

N_MIXERS = 3
N_SSD = (DEPTH + 2) // 3
N_SWA = (DEPTH + 1) // 3
N_DIFF = DEPTH // 3

D_FF = -((-8 * D_MODEL) // (3 * 256)) * 256

SSM_EXPAND = 2
D_INNER = SSM_EXPAND * D_MODEL
SSM_HEAD_DIM = 64
SSM_HEADS = D_INNER // SSM_HEAD_DIM
SSM_GROUPS = 4
D_STATE = 128
CONV_W = 4
CONV_DIM = D_INNER + 2 * SSM_GROUPS * D_STATE
SSM_IN_DIM = 2 * D_INNER + 2 * SSM_GROUPS * D_STATE + SSM_HEADS
SSD_CHUNK = 128

HEAD_DIM = 64
N_ATTN_HEADS = 12
NUM_BUCKETS = 32
MAX_DISTANCE = 2048

SWA_GROUPS = ((128, 1), (512, 4), (2048, 16))
SWA_HEADS_PER_GROUP = N_ATTN_HEADS // len(SWA_GROUPS)

DIFF_KV_HEADS = 4
DIFF_REP = N_ATTN_HEADS // DIFF_KV_HEADS
DIFF_V_DIM = 2 * HEAD_DIM
DIFF_QKV_DIM = N_ATTN_HEADS * 2 * HEAD_DIM + DIFF_KV_HEADS * 2 * HEAD_DIM + DIFF_KV_HEADS * DIFF_V_DIM
Q_BLOCK = 128

EPS = 1e-6

kernel_name = 'hybrid_ssd_dilated_diff_decoder_step'


def rmsnorm(x, g):
    xf = x.astype(jnp.float32)
    y = xf * lax.rsqrt(jnp.mean(xf * xf, axis=-1, keepdims=True) + EPS)
    return (y * g.astype(jnp.float32)).astype(x.dtype)


def rel_bucket(dist):
    max_exact = NUM_BUCKETS // 2
    d = jnp.maximum(dist, 0)
    df = jnp.maximum(d, 1).astype(jnp.float32)
    large = max_exact + (jnp.log(df / max_exact) / math.log(MAX_DISTANCE / max_exact)
                         * (NUM_BUCKETS - max_exact)).astype(jnp.int32)
    return jnp.where(d < max_exact, d, jnp.minimum(large, NUM_BUCKETS - 1))


def swiglu(h, w_in, w_out):
    g, u = jnp.split(h @ w_in, 2, axis=-1)
    return (jax.nn.silu(g) * u) @ w_out


def segsum(a):
    t = a.shape[-1]
    cs = jnp.cumsum(a, axis=-1)
    diff = cs[..., :, None] - cs[..., None, :]
    return jnp.where(jnp.tril(jnp.ones((t, t), bool)), diff, -jnp.inf)


def ssd_scan(x, dt, a, b, c, h0):
    bt, L, H, P = x.shape
    G, N = b.shape[-2:]
    R = H // G
    q = SSD_CHUNK if L % SSD_CHUNK == 0 else L
    nc = L // q
    xdt = (x * dt[..., None]).reshape(bt, nc, q, G, R, P)
    adt = jnp.transpose((dt * a).reshape(bt, nc, q, G, R), (0, 1, 3, 4, 2))
    b = b.reshape(bt, nc, q, G, N)
    c = c.reshape(bt, nc, q, G, N)
    a_cum = jnp.cumsum(adt, axis=-1)
    cb = jnp.einsum('bcign,bcjgn->bcgij', c, b)
    w = cb[:, :, :, None] * jnp.exp(segsum(adt))
    y_diag = jnp.einsum('bcgrij,bcjgrp->bcigrp', w, xdt)
    decay_states = jnp.exp(a_cum[..., -1:] - a_cum)
    states = jnp.einsum('bcjgn,bcgrj,bcjgrp->bcgrpn', b, decay_states, xdt)
    states = jnp.concatenate([h0.reshape(bt, 1, G, R, P, N), states], axis=1)
    chunk_a = jnp.pad(jnp.transpose(a_cum[..., -1], (0, 2, 3, 1)), ((0, 0), (0, 0), (0, 0), (1, 0)))
    new_states = jnp.einsum('bgrzc,bcgrpn->bzgrpn', jnp.exp(segsum(chunk_a)), states)
    y_off = jnp.einsum('bcign,bcgrpn,bcgri->bcigrp', c, new_states[:, :-1], jnp.exp(a_cum))
    y = (y_diag + y_off).reshape(bt, L, H, P)
    return y, new_states[:, -1].reshape(bt, H, P, N)


def ssd_mixer(h, conv_state, ssm_state, w_in, conv_w, conv_b, dt_bias, a_log, d_skip, norm_g, w_out):
    f32 = jnp.float32
    bt, L, _ = h.shape
    z, xbc, dt = jnp.split(h @ w_in, [D_INNER, D_INNER + CONV_DIM], axis=-1)
    ext = jnp.concatenate([conv_state.astype(xbc.dtype), xbc], axis=1)
    conv = conv_b + sum(ext[:, k:k + L] * conv_w[k] for k in range(CONV_W))
    new_conv = ext[:, L:]
    xs, bs, cs = jnp.split(jax.nn.silu(conv), [D_INNER, D_INNER + SSM_GROUPS * D_STATE], axis=-1)
    xh = xs.reshape(bt, L, SSM_HEADS, SSM_HEAD_DIM).astype(f32)
    dtf = jax.nn.softplus(dt.astype(f32) + dt_bias.astype(f32))
    a = -jnp.exp(a_log.astype(f32))
    y, new_state = ssd_scan(xh, dtf, a,
                            bs.reshape(bt, L, SSM_GROUPS, D_STATE).astype(f32),
                            cs.reshape(bt, L, SSM_GROUPS, D_STATE).astype(f32),
                            ssm_state.astype(f32))
    y = y + xh * d_skip.astype(f32)[:, None]
    gated = (y.reshape(bt, L, D_INNER) * jax.nn.silu(z.astype(f32))).reshape(bt, L, SSM_GROUPS, D_INNER // SSM_GROUPS)
    y = rmsnorm(gated, norm_g.reshape(SSM_GROUPS, D_INNER // SSM_GROUPS)).reshape(bt, L, D_INNER)
    return y.astype(h.dtype) @ w_out, new_conv, new_state.astype(ssm_state.dtype)


def swa_project(h, w_qkv, q_norm, k_norm):
    bt, L, _ = h.shape
    q, k, v = jnp.split(h @ w_qkv, 3, axis=-1)
    shape = (bt, L, N_ATTN_HEADS, HEAD_DIM)
    return rmsnorm(q.reshape(shape), q_norm), rmsnorm(k.reshape(shape), k_norm), v.reshape(shape)


def _to_classes(t, dil, blk, lp):
    bt, L = t.shape[:2]
    rest = t.shape[2:]
    t = jnp.pad(t, [(0, 0), (0, lp - L)] + [(0, 0)] * len(rest))
    t = jnp.moveaxis(t.reshape((bt, lp // dil, dil) + rest), 2, 1)
    return t.reshape((bt, dil, lp // (dil * blk), blk) + rest)


def _from_classes(t, L):
    bt, dil, nb, blk = t.shape[:4]
    rest = t.shape[4:]
    t = jnp.moveaxis(t.reshape((bt, dil, nb * blk) + rest), 1, 2)
    return t.reshape((bt, nb * blk * dil) + rest)[:, :L]


def _with_prev(t):
    prev = jnp.concatenate([jnp.zeros_like(t[:, :, :1]), t[:, :, :-1]], axis=2)
    return jnp.concatenate([prev, t], axis=3)


def dilated_group_prompt(q, k, v, bias_tab, win, dil):
    f32 = jnp.float32
    L = q.shape[1]
    steps = win // dil
    blk = steps
    span = dil * blk
    lp = -(-L // span) * span
    nb = lp // span
    qb = _to_classes(q, dil, blk, lp)
    kk = _with_prev(_to_classes(k, dil, blk, lp))
    vv = _with_prev(_to_classes(v, dil, blk, lp))
    s = jnp.einsum('bcnihd,bcnjhd->bcnhij', qb, kk).astype(f32) * (HEAD_DIM ** -0.5)
    i = jnp.arange(blk)[:, None]
    j = jnp.arange(2 * blk)[None, :]
    step = blk + i - j
    bias = bias_tab[rel_bucket(jnp.clip(step, 0, steps) * dil)].astype(f32)
    s = s + jnp.transpose(bias, (2, 0, 1))
    key_sub = jnp.arange(nb)[:, None, None] * blk + j[None] - blk
    valid = (step >= 0)[None] & (step <= steps)[None] & (key_sub >= 0)
    s = jnp.where(valid[None, None, :, None], s, -jnp.inf)
    lse = jax.nn.logsumexp(s, axis=-1)
    p = jnp.exp(s - lse[..., None])
    o = jnp.einsum('bcnhij,bcnjhd->bcnihd', p, vv.astype(f32))
    return _from_classes(o, L), _from_classes(jnp.swapaxes(lse, -1, -2), L)


def dilated_group_sample(q, k, v, buf, bias_tab, win, dil):
    f32 = jnp.float32
    T = q.shape[1]
    lb = buf.shape[1]
    k_ext = jnp.concatenate([buf[:, :, 0], k.astype(buf.dtype)], axis=1)
    v_ext = jnp.concatenate([buf[:, :, 1], v.astype(buf.dtype)], axis=1)
    steps = win // dil
    n = jnp.arange(steps + 1)
    idx = lb + jnp.arange(T)[:, None] - n[None, :] * dil
    valid = idx >= 0
    idx = jnp.maximum(idx, 0)
    kg = k_ext[:, idx]
    vg = v_ext[:, idx]
    s = jnp.einsum('bthd,btnhd->bthn', q, kg).astype(f32) * (HEAD_DIM ** -0.5)
    s = s + bias_tab[rel_bucket(n * dil)].astype(f32).T
    s = jnp.where(valid[:, None, :], s, -jnp.inf)
    lse = jax.nn.logsumexp(s, axis=-1)
    p = jnp.exp(s - lse[..., None])
    o = jnp.einsum('bthn,btnhd->bthd', p, vg.astype(f32))
    keep = min(win, lb + T)
    new_buf = jnp.concatenate([buf, jnp.stack([k, v], axis=2).astype(buf.dtype)], axis=1)[:, lb + T - keep:]
    return o, lse, new_buf


def swa_combine(outs, lses, w_out):
    alpha = jax.nn.softmax(jnp.stack(lses, axis=0), axis=0)
    o = jnp.concatenate([alpha[g][..., None] * outs[g] for g in range(len(outs))], axis=2)
    bt, L = o.shape[:2]
    return o.reshape(bt, L, -1).astype(w_out.dtype) @ w_out


def swa_prompt(h, w_qkv, q_norm, k_norm, w_out, rel_bias):
    q, k, v = swa_project(h, w_qkv, q_norm, k_norm)
    L = h.shape[1]
    outs, lses, bufs = [], [], []
    for g, (win, dil) in enumerate(SWA_GROUPS):
        sl = slice(g * SWA_HEADS_PER_GROUP, (g + 1) * SWA_HEADS_PER_GROUP)
        o, lse = dilated_group_prompt(q[:, :, sl], k[:, :, sl], v[:, :, sl], rel_bias[:, sl], win, dil)
        outs.append(o)
        lses.append(lse)
        keep = min(win, L)
        bufs.append(jnp.stack([k[:, L - keep:, sl], v[:, L - keep:, sl]], axis=2))
    return swa_combine(outs, lses, w_out), bufs


def swa_sample(h, bufs, w_qkv, q_norm, k_norm, w_out, rel_bias):
    q, k, v = swa_project(h, w_qkv, q_norm, k_norm)
    outs, lses, new_bufs = [], [], []
    for g, (win, dil) in enumerate(SWA_GROUPS):
        sl = slice(g * SWA_HEADS_PER_GROUP, (g + 1) * SWA_HEADS_PER_GROUP)
        o, lse, nbuf = dilated_group_sample(q[:, :, sl], k[:, :, sl], v[:, :, sl], bufs[g], rel_bias[:, sl], win, dil)
        outs.append(o)
        lses.append(lse)
        new_bufs.append(nbuf)
    return swa_combine(outs, lses, w_out), new_bufs


def diff_project(h, w_qkv, q_norm, k_norm):
    bt, L, _ = h.shape
    q, k, v = jnp.split(h @ w_qkv, [N_ATTN_HEADS * 2 * HEAD_DIM, (N_ATTN_HEADS + DIFF_KV_HEADS) * 2 * HEAD_DIM], axis=-1)
    q = rmsnorm(q.reshape(bt, L, DIFF_KV_HEADS, DIFF_REP, 2, HEAD_DIM), q_norm)
    k = rmsnorm(k.reshape(bt, L, DIFF_KV_HEADS, 2, HEAD_DIM), k_norm)
    return q, k, v.reshape(bt, L, DIFF_KV_HEADS, DIFF_V_DIM)


def diff_lambda_value(lam_p, lam_init):
    lp = lam_p.astype(jnp.float32)
    return jnp.exp(jnp.sum(lp[0] * lp[1])) - jnp.exp(jnp.sum(lp[2] * lp[3])) + lam_init


def diff_attend(q, k, v, q_pos, k_pos, lam, rel_bias):
    f32 = jnp.float32
    tq, tk = q.shape[1], k.shape[1]
    s = jnp.einsum('bigrmd,bjgmd->bgrmij', q, k).astype(f32) * (HEAD_DIM ** -0.5)
    dist = q_pos[:, None] - k_pos[None, :]
    bias = rel_bias[rel_bucket(dist)].astype(f32).reshape(tq, tk, DIFF_KV_HEADS, DIFF_REP)
    s = s + jnp.transpose(bias, (2, 3, 0, 1))[:, :, None]
    s = jnp.where(dist >= 0, s, -jnp.inf)
    p = jax.nn.softmax(s, axis=-1)
    a = p[:, :, :, 0] - lam * p[:, :, :, 1]
    return jnp.einsum('bgrij,bjgd->bigrd', a, v.astype(f32))


def diff_output(o, out_norm, lam_init, w_out):
    bt, L = o.shape[:2]
    o = rmsnorm(o.reshape(bt, L, N_ATTN_HEADS, DIFF_V_DIM), out_norm) * (1.0 - lam_init)
    return o.reshape(bt, L, -1).astype(w_out.dtype) @ w_out


def diff_prompt(h, w_qkv, q_norm, k_norm, lam_p, out_norm, w_out, rel_bias, lam_init):
    bt, L, _ = h.shape
    q, k, v = diff_project(h, w_qkv, q_norm, k_norm)
    lam = diff_lambda_value(lam_p, lam_init)
    nb = L // Q_BLOCK
    pos = jnp.arange(L)
    q_blocks = jnp.moveaxis(q.reshape((bt, nb, Q_BLOCK) + q.shape[2:]), 1, 0)
    o = lax.map(lambda a: diff_attend(a[0], k, v, a[1], pos, lam, rel_bias), (q_blocks, pos.reshape(nb, Q_BLOCK)))
    o = jnp.moveaxis(o, 0, 1).reshape(bt, L, DIFF_KV_HEADS, DIFF_REP, DIFF_V_DIM)
    return diff_output(o, out_norm, lam_init, w_out), k, v


def diff_sample(h, cache_k, cache_v, page_table, w_qkv, q_norm, k_norm, lam_p, out_norm, w_out, rel_bias, lam_init):
    bt, T, _ = h.shape
    q, k, v = diff_project(h, w_qkv, q_norm, k_norm)
    lam = diff_lambda_value(lam_p, lam_init)
    past_k = cache_k[page_table]
    past_k = past_k.reshape((bt, -1) + past_k.shape[3:])
    past_v = cache_v[page_table]
    past_v = past_v.reshape((bt, -1) + past_v.shape[3:])
    past = past_k.shape[1]
    k_all = jnp.concatenate([past_k, k.astype(past_k.dtype)], axis=1)
    v_all = jnp.concatenate([past_v, v.astype(past_v.dtype)], axis=1)
    o = diff_attend(q, k_all, v_all, past + jnp.arange(T), jnp.arange(past + T), lam, rel_bias)
    return diff_output(o, out_norm, lam_init, w_out), k, v


def setup_inputs(seed: int = 0) -> dict:
    key = jax.random.key(seed)
    keys = iter(jax.random.split(key, 64))
    f32 = jnp.float32

    def normal(shape, scale=1.0):
        return jax.random.normal(next(keys), shape, f32) * scale

    def gain(shape):
        return 1.0 + normal(shape, 0.02)

    n_pages = PAST_LEN // PAGE_SIZE
    n_used = DEC_BATCH * n_pages
    n_phys = n_used + max(1, n_used // 4)
    page_table = jax.random.permutation(next(keys), n_phys)[:n_used].reshape(DEC_BATCH, n_pages).astype(jnp.int32)
    dt0 = jnp.exp(jax.random.uniform(next(keys), (N_SSD, SSM_HEADS), f32, math.log(1e-3), math.log(1e-1)))
    dt_bias = dt0 + jnp.log(-jnp.expm1(-dt0))
    a_log = jnp.log(jax.random.uniform(next(keys), (N_SSD, SSM_HEADS), f32, 1.0, 16.0))
    swa_w = H_SWA = N_ATTN_HEADS * HEAD_DIM
    return {
        'x_prompt': normal((BATCH, SEQ, D_MODEL)),
        'x_sample': normal((DEC_BATCH, DEC_SEQ, D_MODEL)),
        'state_ssm_conv': normal((N_SSD, DEC_BATCH, CONV_W - 1, CONV_DIM)),
        'state_ssm': normal((N_SSD, DEC_BATCH, SSM_HEADS, SSM_HEAD_DIM, D_STATE), 0.1),
        'cache_swa_kv0': normal((N_SWA, DEC_BATCH, min(SWA_GROUPS[0][0], PAST_LEN), 2, SWA_HEADS_PER_GROUP, HEAD_DIM)),
        'cache_swa_kv1': normal((N_SWA, DEC_BATCH, min(SWA_GROUPS[1][0], PAST_LEN), 2, SWA_HEADS_PER_GROUP, HEAD_DIM)),
        'cache_swa_kv2': normal((N_SWA, DEC_BATCH, min(SWA_GROUPS[2][0], PAST_LEN), 2, SWA_HEADS_PER_GROUP, HEAD_DIM)),
        'cache_diff_k': normal((N_DIFF, n_phys, PAGE_SIZE, DIFF_KV_HEADS, 2, HEAD_DIM)),
        'cache_diff_v': normal((N_DIFF, n_phys, PAGE_SIZE, DIFF_KV_HEADS, DIFF_V_DIM)),
        'page_table': page_table,
        'rel_bias': normal((NUM_BUCKETS, N_ATTN_HEADS), 0.5),
        'norm_mix': gain((DEPTH, D_MODEL)),
        'norm_ffn': gain((DEPTH, D_MODEL)),
        'ffn_w_in': normal((DEPTH, D_MODEL, 2 * D_FF), D_MODEL ** -0.5),
        'ffn_w_out': normal((DEPTH, D_FF, D_MODEL), D_FF ** -0.5),
        'ssm_w_in': normal((N_SSD, D_MODEL, SSM_IN_DIM), D_MODEL ** -0.5),
        'ssm_conv_w': normal((N_SSD, CONV_W, CONV_DIM), CONV_W ** -0.5),
        'ssm_conv_b': normal((N_SSD, CONV_DIM), 0.02),
        'ssm_dt_bias': dt_bias,
        'ssm_a_log': a_log,
        'ssm_d': gain((N_SSD, SSM_HEADS)),
        'ssm_norm': gain((N_SSD, D_INNER)),
        'ssm_w_out': normal((N_SSD, D_INNER, D_MODEL), D_INNER ** -0.5),
        'swa_w_qkv': normal((N_SWA, D_MODEL, 3 * swa_w), D_MODEL ** -0.5),
        'swa_q_norm': gain((N_SWA, HEAD_DIM)),
        'swa_k_norm': gain((N_SWA, HEAD_DIM)),
        'swa_w_out': normal((N_SWA, H_SWA, D_MODEL), H_SWA ** -0.5),
        'diff_w_qkv': normal((N_DIFF, D_MODEL, DIFF_QKV_DIM), D_MODEL ** -0.5),
        'diff_q_norm': gain((N_DIFF, HEAD_DIM)),
        'diff_k_norm': gain((N_DIFF, HEAD_DIM)),
        'diff_lambda': normal((N_DIFF, 4, HEAD_DIM), 0.1),
        'diff_out_norm': gain((N_DIFF, DIFF_V_DIM)),
        'diff_w_out': normal((N_DIFF, N_ATTN_HEADS * DIFF_V_DIM, D_MODEL), (N_ATTN_HEADS * DIFF_V_DIM) ** -0.5),
    }


def reference(x_prompt, x_sample, state_ssm_conv, state_ssm, cache_swa_kv0, cache_swa_kv1, cache_swa_kv2,
              cache_diff_k, cache_diff_v, page_table, rel_bias, norm_mix, norm_ffn, ffn_w_in, ffn_w_out,
              ssm_w_in, ssm_conv_w, ssm_conv_b, ssm_dt_bias, ssm_a_log, ssm_d, ssm_norm, ssm_w_out,
              swa_w_qkv, swa_q_norm, swa_k_norm, swa_w_out,
              diff_w_qkv, diff_q_norm, diff_k_norm, diff_lambda, diff_out_norm, diff_w_out):
    xp, xs = x_prompt, x_sample
    bp = xp.shape[0]
    swa_caches = (cache_swa_kv0, cache_swa_kv1, cache_swa_kv2)
    conv_p, conv_s, ssm_p, ssm_s = [], [], [], []
    swa_p = tuple([] for _ in SWA_GROUPS)
    swa_s = tuple([] for _ in SWA_GROUPS)
    dk_p, dk_s, dv_p, dv_s = [], [], [], []
    i_ssd = i_swa = i_diff = 0
    for layer in range(DEPTH):
        hp = rmsnorm(xp, norm_mix[layer])
        hs = rmsnorm(xs, norm_mix[layer])
        kind = layer % N_MIXERS
        if kind == 0:
            i = i_ssd
            i_ssd += 1
            w = (ssm_w_in[i], ssm_conv_w[i], ssm_conv_b[i], ssm_dt_bias[i], ssm_a_log[i], ssm_d[i], ssm_norm[i], ssm_w_out[i])
            conv0 = jnp.zeros((bp, CONV_W - 1, CONV_DIM), hp.dtype)
            state0 = jnp.zeros((bp, SSM_HEADS, SSM_HEAD_DIM, D_STATE), jnp.float32)
            mp, c_p, s_p = ssd_mixer(hp, conv0, state0, *w)
            ms, c_s, s_s = ssd_mixer(hs, state_ssm_conv[i], state_ssm[i], *w)
            conv_p.append(c_p)
            conv_s.append(c_s)
            ssm_p.append(s_p)
            ssm_s.append(s_s)
        elif kind == 1:
            i = i_swa
            i_swa += 1
            w = (swa_w_qkv[i], swa_q_norm[i], swa_k_norm[i], swa_w_out[i], rel_bias)
            mp, bufs_p = swa_prompt(hp, *w)
            ms, bufs_s = swa_sample(hs, [c[i] for c in swa_caches], *w)
            for g in range(len(SWA_GROUPS)):
                swa_p[g].append(bufs_p[g])
                swa_s[g].append(bufs_s[g])
        else:
            i = i_diff
            i_diff += 1
            lam_init = 0.8 - 0.6 * math.exp(-0.3 * layer)
            w = (diff_w_qkv[i], diff_q_norm[i], diff_k_norm[i], diff_lambda[i], diff_out_norm[i], diff_w_out[i], rel_bias, lam_init)
            mp, k_p, v_p = diff_prompt(hp, *w)
            ms, k_s, v_s = diff_sample(hs, cache_diff_k[i], cache_diff_v[i], page_table, *w)
            dk_p.append(k_p)
            dk_s.append(k_s)
            dv_p.append(v_p)
            dv_s.append(v_s)
        xp = xp + mp.astype(xp.dtype)
        xs = xs + ms.astype(xs.dtype)
        xp = xp + swiglu(rmsnorm(xp, norm_ffn[layer]), ffn_w_in[layer], ffn_w_out[layer]).astype(xp.dtype)
        xs = xs + swiglu(rmsnorm(xs, norm_ffn[layer]), ffn_w_in[layer], ffn_w_out[layer]).astype(xs.dtype)
    ssm_conv_prompt = jnp.stack(conv_p)
    ssm_conv_sample = jnp.stack(conv_s)
    ssm_prompt = jnp.stack(ssm_p)
    ssm_sample = jnp.stack(ssm_s)
    swa_kv0_prompt = jnp.stack(swa_p[0])
    swa_kv0_sample = jnp.stack(swa_s[0])
    swa_kv1_prompt = jnp.stack(swa_p[1])
    swa_kv1_sample = jnp.stack(swa_s[1])
    swa_kv2_prompt = jnp.stack(swa_p[2])
    swa_kv2_sample = jnp.stack(swa_s[2])
    diff_k_prompt = jnp.stack(dk_p)
    diff_k_sample = jnp.stack(dk_s)
    diff_v_prompt = jnp.stack(dv_p)
    diff_v_sample = jnp.stack(dv_s)
    return (xp, xs, ssm_conv_prompt, ssm_conv_sample, ssm_prompt, ssm_sample,
            swa_kv0_prompt, swa_kv0_sample, swa_kv1_prompt, swa_kv1_sample, swa_kv2_prompt, swa_kv2_sample,
            diff_k_prompt, diff_k_sample, diff_v_prompt, diff_v_sample)
```

```cpp
#include <hip/hip_runtime.h>
#include <cstdio>
#include <cstdint>
#ifndef MK_PER_PHASE
#define MK_PER_PHASE 0
#endif
#ifndef REP_PRO
#define REP_PRO 1
#endif
#ifndef REP_SCAN
#define REP_SCAN 1
#endif
#ifndef REP_FFIN
#define REP_FFIN 1
#endif
#ifndef REP_SWA
#define REP_SWA 1
#endif
#ifndef REP_DATT
#define REP_DATT 1
#endif
#ifndef REP_DSMP
#define REP_DSMP 1
#endif
#ifndef REP_SCANP
#define REP_SCANP 1
#endif
#ifndef REP_SCANS
#define REP_SCANS 1
#endif
#ifndef REP_PRE
#define REP_PRE 1
#endif
#ifndef PROBE_FFIN
#define PROBE_FFIN 0
#endif
#ifndef REP_SKSW
#define REP_SKSW 1
#endif
#ifndef REP_COPY
#define REP_COPY 1
#endif
#ifndef PROBE_GN
#define PROBE_GN 0
#endif
#ifndef PROBE_FFOUT
#define PROBE_FFOUT 0
#endif
#ifndef DIFF_PARTITION
#define DIFF_PARTITION 0
#endif
#ifndef PROBE_BAR
#define PROBE_BAR 0
#endif
#ifndef PROBE_SSDIN
#define PROBE_SSDIN 0
#endif
#ifndef PROBE_QKV
#define PROBE_QKV 0
#endif
#ifndef PROBE_SST
#define PROBE_SST 0
#endif
#ifndef PROBE_SCANBAR
#define PROBE_SCANBAR 0
#endif
#ifndef PROBE_SCANT
#define PROBE_SCANT 0
#endif
#ifndef PROBE_DAT
#define PROBE_DAT 0
#endif
#ifndef DATT_XCD
#define DATT_XCD 1
#endif
#ifndef DATT_PRIO
#define DATT_PRIO 0
#endif
#ifndef PROBE_DAS
#define PROBE_DAS 0
#endif
namespace pg8 {
#define PG8_LAS __attribute__((address_space(3)))
typedef unsigned short bf16_t;
typedef short bf16x8 __attribute__((ext_vector_type(8)));
typedef float f32x4 __attribute__((ext_vector_type(4)));
typedef unsigned u32x4 __attribute__((ext_vector_type(4)));
constexpr int BM = 256, BK = 64, HALF = 128, HTB = HALF * BK * 2  , STAGE_BYTES = 8 * HTB, NXCD = 8, WGM = 8;

__host__ __device__ __forceinline__ int lds_byte(int r, int c) { const int st = (r >> 4) * 2 + (c >> 5), rr = r & 15, cc = c & 31, ob = rr * 64 + cc * 2; return st * 1024 + (ob ^ (((ob >> 9) & 1) << 5)); }
__host__ __device__ __forceinline__ void stage_rc(int b, int& R, int& C) { const int st = b / 1024, sb = b % 1024, swz = sb ^ (((sb >> 9) & 1) << 5); R = (st >> 1) * 16 + swz / 64; C = (st & 1) * 32 + (swz % 64) / 2; }
__host__ __device__ __forceinline__ int perm32(int rho) { const int n = rho >> 4, i = rho & 15; return 8 * (i >> 2) + 4 * n + (i & 3); }

struct Unit { int pm, pn; };
struct Gemm { const bf16_t* A; const bf16_t* Bt; int M, N, K; };

struct StaticOrder {
    int nM, nN, nwg, G, c;
    __host__ __device__ void init(int M, int N, int G_, int c_) { nM = M / BM; nN = N / BM; nwg = nM * nN; G = G_; c = c_; }
    __host__ __device__ bool next(int i, Unit& u) const {
        const long L = (long)i * G + c; if (L >= nwg) return false;
        int wgid = (int)L; { const int q = nwg / NXCD, r = nwg % NXCD, xcd = wgid % NXCD, off = wgid / NXCD; wgid = (xcd < r ? xcd * (q + 1) : r * (q + 1) + (xcd - r) * q) + off; }
        const int nig = WGM * nN, gid = wgid / nig, fm = gid * WGM, gsz = (nM - fm) < WGM ? (nM - fm) : WGM;
        u.pm = fm + ((wgid % nig) % gsz); u.pn = (wgid % nig) / gsz; return true;
    }
    __device__ __forceinline__ void a_ready(const Unit&) const {}
    __device__ __forceinline__ void done(const Unit&) const {}
};

__device__ __forceinline__ unsigned cvt_pk_bf16(float lo, float hi) { unsigned r; asm volatile("v_cvt_pk_bf16_f32 %0, %1, %2" : "=v"(r) : "v"(lo), "v"(hi)); return r; }
template <class Epi, class Sched, bool ALIGN_EPI = false, bool SP2 = false>
__device__ __forceinline__ void gemm_phase(PG8_LAS unsigned char* lds, const Gemm g, const Sched& S, const Epi& E) {
    const int tid = threadIdx.x, wid = __builtin_amdgcn_readfirstlane(tid >> 6), lane = tid & 63, wr = wid >> 2, wc = wid & 3, fr = lane & 15, fq = lane >> 4;
    const int K = g.K, nt = K / BK;
    unsigned voffA[2], voffB[2];
#pragma unroll
    for (int i = 0; i < 2; ++i) { int R, C; stage_rc(tid * 16 + i * 8192, R, C); const int Rb = Epi::PERM ? ((R & ~31) + perm32(R & 31)) : R;
        voffA[i] = (unsigned)(R * K + C) * 2u; voffB[i] = (unsigned)(Rb * K + C) * 2u; }
    const size_t kstep = (size_t)(BK * 2);
    const size_t hstep = (size_t)HALF * K * 2;
    const size_t tstep = 2 * hstep;
    const unsigned ldsw = (unsigned)wid * 1024u;
    const int aoff = lds_byte(wr * 64 + fr, fq * 8), boff = lds_byte(wc * 32 + fr, fq * 8);
#define PG8_SA(b, h) (((b) * 2 + (h)) * HTB)
#define PG8_SB(b, h) ((4 + (b) * 2 + (h)) * HTB)
#define PG8_STAGE(bufoff, gbase, voff) do { _Pragma("unroll") for (int _i = 0; _i < 2; ++_i) \
        __builtin_amdgcn_global_load_lds((const unsigned*)((const char*)(gbase) + (voff)[_i]), (PG8_LAS unsigned*)(lds + (bufoff) + ldsw + _i * 8192), 16, 0, 0); } while (0)
#define PG8_LDA(dst, b, h) do { _Pragma("unroll") for (int m = 0; m < 4; ++m) _Pragma("unroll") for (int k = 0; k < 2; ++k) dst[m][k] = *(const PG8_LAS bf16x8*)(lds + PG8_SA(b, h) + aoff + m * 2048 + k * 1024); } while (0)
#define PG8_LDB(dst, b, h) do { _Pragma("unroll") for (int n = 0; n < 2; ++n) _Pragma("unroll") for (int k = 0; k < 2; ++k) dst[n][k] = *(const PG8_LAS bf16x8*)(lds + PG8_SB(b, h) + boff + n * 2048 + k * 1024); } while (0)
#define PG8_MMA(ai, bj, At, Bt) do { __builtin_amdgcn_s_setprio(1); _Pragma("unroll") for (int m = 0; m < 4; ++m) _Pragma("unroll") for (int n = 0; n < 2; ++n) _Pragma("unroll") for (int k = 0; k < 2; ++k) \
        acc[ai][bj][m][n] = __builtin_amdgcn_mfma_f32_16x16x32_bf16(Bt[n][k], At[m][k], acc[ai][bj][m][n], 0, 0, 0); __builtin_amdgcn_s_setprio(0); } while (0)
#define PG8_WAIT_V(n) asm volatile("s_waitcnt vmcnt(" #n ")" ::: "memory")
#define PG8_WAIT_L(n) asm volatile("s_waitcnt lgkmcnt(" #n ")" ::: "memory")
#define PG8_BAR __builtin_amdgcn_s_barrier()
#define PG8_SCHED __builtin_amdgcn_sched_barrier(0)
    Unit cur, nxt; int ui = 0;
    if (!S.next(0, cur)) return;
    f32x4 acc[2][2][4][2];
#pragma unroll
    for (int a = 0; a < 2; ++a)
#pragma unroll
        for (int b = 0; b < 2; ++b)
#pragma unroll
            for (int m = 0; m < 4; ++m)
#pragma unroll
                for (int n = 0; n < 2; ++n) acc[a][b][m][n] = (f32x4){0.f, 0.f, 0.f, 0.f};
    bf16x8 At[4][2], B0[2][2], B1[2][2];
    const char* cA = (const char*)g.A + (size_t)cur.pm * tstep; const char* cB = (const char*)g.Bt + (size_t)cur.pn * tstep;
    S.a_ready(cur);
    if constexpr (SP2) {
        PG8_STAGE(PG8_SB(0, 0), cB, voffB); PG8_STAGE(PG8_SB(0, 1), cB + hstep, voffB); PG8_STAGE(PG8_SA(0, 0), cA, voffA); PG8_STAGE(PG8_SA(0, 1), cA + hstep, voffA);
        if (wr == 1) PG8_BAR;
        PG8_WAIT_V(2); PG8_BAR;
        PG8_STAGE(PG8_SB(1, 0), cB + kstep, voffB); PG8_STAGE(PG8_SA(1, 0), cA + kstep, voffA); PG8_STAGE(PG8_SB(1, 1), cB + hstep + kstep, voffB);
        PG8_WAIT_V(6); PG8_BAR;
    } else {
        PG8_STAGE(PG8_SB(0, 0), cB, voffB); PG8_STAGE(PG8_SA(0, 0), cA, voffA); PG8_STAGE(PG8_SB(0, 1), cB + hstep, voffB); PG8_STAGE(PG8_SA(0, 1), cA + hstep, voffA);
        if (wr == 1) PG8_BAR;
        PG8_WAIT_V(4); PG8_BAR;
        PG8_STAGE(PG8_SB(1, 0), cB + kstep, voffB); PG8_STAGE(PG8_SA(1, 0), cA + kstep, voffA); PG8_STAGE(PG8_SB(1, 1), cB + hstep + kstep, voffB);
        PG8_WAIT_V(6); PG8_BAR;
    }
    for (;;) {
        const bool has_next = S.next(ui + 1, nxt);
        const char* nA = has_next ? (const char*)g.A + (size_t)nxt.pm * tstep : cA; const char* nB = has_next ? (const char*)g.Bt + (size_t)nxt.pn * tstep : cB;
        for (int t = 0; t < nt; t += 2) {
            const bool last = (t == nt - 2);
            const char* a1 = cA + (size_t)(t + 1) * kstep;
            const char* a2 = last ? nA : cA + (size_t)(t + 2) * kstep; const char* b2 = last ? nB : cB + (size_t)(t + 2) * kstep;
            const char* a3 = a2 + kstep; const char* b3 = b2 + kstep;
            if (last && has_next) S.a_ready(nxt);
            if constexpr (SP2) {
            PG8_LDB(B0, 0, 0); PG8_LDB(B1, 0, 1); PG8_SCHED; PG8_LDA(At, 0, 0); PG8_STAGE(PG8_SA(1, 1), a1 + hstep, voffA);
            PG8_WAIT_V(8); PG8_WAIT_L(0); PG8_BAR; PG8_MMA(0, 0, At, B0); PG8_MMA(0, 1, At, B1); PG8_BAR; PG8_SCHED;
            PG8_LDA(At, 0, 1); PG8_STAGE(PG8_SB(0, 0), b2, voffB); PG8_STAGE(PG8_SB(0, 1), b2 + hstep, voffB); PG8_STAGE(PG8_SA(0, 0), a2, voffA);
            PG8_WAIT_V(8); PG8_WAIT_L(0); PG8_BAR; PG8_MMA(1, 0, At, B0); PG8_MMA(1, 1, At, B1); PG8_BAR; PG8_SCHED;
            PG8_LDB(B0, 1, 0); PG8_LDB(B1, 1, 1); PG8_SCHED; PG8_LDA(At, 1, 0); PG8_STAGE(PG8_SA(0, 1), a2 + hstep, voffA);
            PG8_WAIT_V(8); PG8_WAIT_L(0); PG8_BAR; PG8_MMA(0, 0, At, B0); PG8_MMA(0, 1, At, B1); PG8_BAR; PG8_SCHED;
            PG8_LDA(At, 1, 1); PG8_STAGE(PG8_SB(1, 0), b3, voffB); PG8_STAGE(PG8_SB(1, 1), b3 + hstep, voffB); PG8_STAGE(PG8_SA(1, 0), a3, voffA);
            PG8_WAIT_V(8); PG8_WAIT_L(0); PG8_BAR; PG8_MMA(1, 0, At, B0); PG8_MMA(1, 1, At, B1); PG8_BAR; PG8_SCHED;
            } else {
            PG8_LDB(B0, 0, 0); PG8_SCHED; PG8_LDA(At, 0, 0); PG8_STAGE(PG8_SA(1, 1), a1 + hstep, voffA);
            PG8_WAIT_L(8); PG8_BAR; PG8_WAIT_L(0); PG8_MMA(0, 0, At, B0); PG8_BAR; PG8_SCHED;
            PG8_LDB(B1, 0, 1); PG8_STAGE(PG8_SB(0, 0), b2, voffB);
            PG8_BAR; PG8_WAIT_L(0); PG8_MMA(0, 1, At, B1); PG8_BAR;
            PG8_LDA(At, 0, 1); PG8_STAGE(PG8_SA(0, 0), a2, voffA);
            PG8_BAR; PG8_WAIT_L(0); PG8_MMA(1, 0, At, B0); PG8_BAR; PG8_SCHED;
            PG8_STAGE(PG8_SB(0, 1), b2 + hstep, voffB);
            PG8_WAIT_V(6); PG8_BAR; PG8_MMA(1, 1, At, B1); PG8_BAR;
            PG8_LDB(B0, 1, 0); PG8_SCHED; PG8_LDA(At, 1, 0); PG8_STAGE(PG8_SA(0, 1), a2 + hstep, voffA);
            PG8_WAIT_L(8); PG8_BAR; PG8_WAIT_L(0); PG8_MMA(0, 0, At, B0); PG8_BAR; PG8_SCHED;
            PG8_LDB(B1, 1, 1); PG8_STAGE(PG8_SB(1, 0), b3, voffB);
            PG8_BAR; PG8_WAIT_L(0); PG8_MMA(0, 1, At, B1); PG8_BAR;
            PG8_LDA(At, 1, 1); PG8_STAGE(PG8_SA(1, 0), a3, voffA);
            PG8_BAR; PG8_WAIT_L(0); PG8_MMA(1, 0, At, B0); PG8_BAR; PG8_SCHED;
            PG8_STAGE(PG8_SB(1, 1), b3 + hstep, voffB);
            PG8_WAIT_V(6); PG8_BAR; PG8_MMA(1, 1, At, B1); PG8_BAR;
            }
        }
        if constexpr (ALIGN_EPI) { if (wr == 0) PG8_BAR; }
        if constexpr (!Epi::AFTER_DRAIN) { E(acc, cur, wr, wc, fr, fq); S.done(cur); }
        if (!has_next) break;
#pragma unroll
        for (int a = 0; a < 2; ++a)
#pragma unroll
            for (int b = 0; b < 2; ++b)
#pragma unroll
                for (int m = 0; m < 4; ++m)
#pragma unroll
                    for (int n = 0; n < 2; ++n) acc[a][b][m][n] = (f32x4){0.f, 0.f, 0.f, 0.f};
        cur = nxt; cA = nA; cB = nB; ++ui;
        if constexpr (ALIGN_EPI) { if (wr == 1) PG8_BAR; }
    }
    PG8_WAIT_V(0);
    if constexpr (!ALIGN_EPI) { if (wr == 0) PG8_BAR; }
    PG8_BAR;
    if constexpr (Epi::AFTER_DRAIN) { E.fused(acc, cur, wr, wc, fr, fq, lds, wid, lane); S.done(cur); }
#undef PG8_SA
#undef PG8_SB
#undef PG8_STAGE
#undef PG8_LDA
#undef PG8_LDB
#undef PG8_MMA
#undef PG8_WAIT_V
#undef PG8_WAIT_L
#undef PG8_BAR
#undef PG8_SCHED
}
}

constexpr int DM = 1024, SEQ = 2048, NBP = 8, NBS = 32, TS = 4, PAST = 8192;
constexpr int MP = NBP * SEQ;
constexpr int MS = NBS * TS;
constexpr int MTOK = MP + MS;
constexpr int MPAD = 16640;
constexpr int DFF = 2816, DIN = 2048, CONVD = 3072, ZXW = 5120, SSMN = 5152, SSMNP = 5376;
constexpr int SWAW = 768, DQW = 1536, DKW = 512;
constexpr float EPS = 1e-6f;
constexpr int NWAVES = 8, NTHR = 512;

enum { I_XP = 0, I_XS, I_CONVST, I_SSMST, I_SWA0, I_SWA1, I_SWA2, I_DCK, I_DCV, I_PT, I_RELB, I_NMIX, I_NFFN, I_FFIN, I_FFOUT,
       I_SSMWIN, I_CONVW, I_CONVB, I_DTB, I_ALOG, I_SSMD, I_SSMNORM, I_SSMWOUT, I_SWAQKV, I_SWAQN, I_SWAKN, I_SWAOUT,
       I_DQKV, I_DQN, I_DKN, I_DLAM, I_DON, I_DOUT, N_IN };

constexpr int O_Y_P = 0;
constexpr int O_Y_S = O_Y_P + MP * DM;
constexpr int O_CONV_P = O_Y_S + MS * DM;
constexpr int O_CONV_S = O_CONV_P + 2 * NBP * 3 * CONVD;
constexpr int O_SSM_P = O_CONV_S + 2 * NBS * 3 * CONVD;
constexpr int O_SSM_S = O_SSM_P + 2 * NBP * 32 * 64 * 128;
constexpr int O_KV0_P = O_SSM_S + 2 * NBS * 32 * 64 * 128;
constexpr int O_KV0_S = O_KV0_P + NBP * 128 * 512;
constexpr int O_KV1_P = O_KV0_S + NBS * 128 * 512;
constexpr int O_KV1_S = O_KV1_P + NBP * 512 * 512;
constexpr int O_KV2_P = O_KV1_S + NBS * 512 * 512;
constexpr int O_KV2_S = O_KV2_P + NBP * 2048 * 512;
constexpr int O_DK_P = O_KV2_S + NBS * 2048 * 512;
constexpr int O_DK_S = O_DK_P + MP * 512;
constexpr int O_DV_P = O_DK_S + MS * 512;
constexpr int O_DV_S = O_DV_P + MP * 512;
constexpr int O_TOTAL = O_DV_S + MS * 512;
static_assert(O_TOTAL == 110575616, "output size");

constexpr size_t al4k(size_t x) { return (x + 4095) & ~(size_t)4095; }
constexpr size_t WS_CTL = 0;
constexpr size_t WS_ZERO_BYTES = (size_t)1 << 20;
constexpr size_t WS_SS = (size_t)1 << 20;
constexpr size_t SZ_SS1 = (size_t)MPAD * 16 * 4;
constexpr size_t SZ_WSSDIN = (size_t)SSMNP * DM * 2, SZ_WSSDOUT = (size_t)DM * DIN * 2, SZ_WSWAQKV = (size_t)2304 * DM * 2, SZ_WSWAOUT = (size_t)DM * SWAW * 2,
                 SZ_WDQKV = (size_t)2560 * DM * 2, SZ_WDOUT = (size_t)DM * DQW * 2, SZ_WFFIN = (size_t)2 * DFF * DM * 2, SZ_WFFOUT = (size_t)DM * DFF * 2;
constexpr size_t WS_WSSDIN = WS_SS + al4k(8 * SZ_SS1);
constexpr size_t WS_WSSDOUT = WS_WSSDIN + 2 * al4k(SZ_WSSDIN);
constexpr size_t WS_WSWAQKV = WS_WSSDOUT + 2 * al4k(SZ_WSSDOUT);
constexpr size_t WS_WSWAOUT = WS_WSWAQKV + al4k(SZ_WSWAQKV);
constexpr size_t WS_WDQKV = WS_WSWAOUT + al4k(SZ_WSWAOUT);
constexpr size_t WS_WDOUT = WS_WDQKV + al4k(SZ_WDQKV);
constexpr size_t WS_WFFIN = WS_WDOUT + al4k(SZ_WDOUT);
constexpr size_t WS_WFFOUT = WS_WFFIN + 4 * al4k(SZ_WFFIN);
constexpr size_t WS_X = WS_WFFOUT + 4 * al4k(SZ_WFFOUT);
constexpr size_t WS_XB = WS_X + al4k((size_t)MPAD * DM * 4);
constexpr size_t WS_ZX = WS_XB + al4k((size_t)MPAD * DM * 2);
constexpr size_t WS_DT = WS_ZX + al4k((size_t)MPAD * ZXW * 2);
constexpr size_t WS_YG = WS_DT + al4k((size_t)MPAD * 32 * 4);
constexpr size_t WS_ACT = WS_YG + al4k((size_t)MPAD * DIN * 2);
constexpr size_t WS_QS = WS_ACT + al4k((size_t)MPAD * DFF * 2);
constexpr size_t WS_KS = WS_QS + al4k((size_t)MPAD * SWAW * 2);
constexpr size_t WS_VS = WS_KS + al4k((size_t)MPAD * SWAW * 2);
constexpr size_t WS_AO = WS_VS + al4k((size_t)MPAD * SWAW * 2);
constexpr size_t WS_QD = WS_AO + al4k((size_t)MPAD * SWAW * 2);
constexpr size_t WS_KD = WS_QD + al4k((size_t)MPAD * DQW * 2);
constexpr size_t WS_VD = WS_KD + al4k((size_t)MPAD * DKW * 2);
constexpr size_t WS_AOD = WS_VD + al4k((size_t)MPAD * DKW * 2);
constexpr size_t WS_VTD = WS_AOD + al4k((size_t)MPAD * DQW * 2);
constexpr size_t WS_BC = WS_VTD + al4k((size_t)NBP * 4 * 128 * SEQ * 2);
constexpr size_t WS_BT = WS_BC + al4k((size_t)MP * 1024 * 2);
constexpr size_t WS_SC = WS_BT + al4k((size_t)NBP * 4 * 128 * SEQ * 2);
constexpr size_t WS_VTS = WS_SC + al4k((size_t)MP * 32 * 16);
constexpr size_t WS_LSE = WS_VTS + al4k((size_t)NBP * 12 * 64 * SEQ * 2);
constexpr int PART_STRIDE = 132;
constexpr size_t WS_PART = WS_LSE + al4k((size_t)MP * 12 * 4);
constexpr size_t WS_END = WS_PART + al4k((size_t)1024 * 24 * PART_STRIDE * 4);

constexpr int CW_BAR = 4096;

constexpr int RING_BYTES = 131072;
constexpr int LDSCTL_OFF = RING_BYTES, MISC_OFF = LDSCTL_OFF + 320;
constexpr int LDS_BYTES = 147456;

#define GAS __attribute__((address_space(1)))
#define LAS __attribute__((address_space(3)))
typedef unsigned short bf16;
typedef unsigned v4u __attribute__((ext_vector_type(4)));
typedef unsigned v2u __attribute__((ext_vector_type(2)));
typedef float f32x4 __attribute__((ext_vector_type(4)));
typedef float f32x2 __attribute__((ext_vector_type(2)));
typedef float f32x16 __attribute__((ext_vector_type(16)));
typedef GAS unsigned gu32;
#define RLX_AGENT __ATOMIC_RELAXED, __HIP_MEMORY_SCOPE_AGENT
#define LDS_WAIT() asm volatile("s_waitcnt lgkmcnt(0)" ::: "memory")

__device__ __forceinline__ float bf2f(unsigned short v) { return __builtin_bit_cast(float, (unsigned)v << 16); }
__device__ __forceinline__ float bflo(unsigned w) { return __builtin_bit_cast(float, w << 16); }
__device__ __forceinline__ float bfhi(unsigned w) { return __builtin_bit_cast(float, w & 0xffff0000u); }
__device__ __forceinline__ unsigned f2bf(float f) { unsigned u = __builtin_bit_cast(unsigned, f); return (u + 0x7fffu + ((u >> 16) & 1u)) >> 16; }
__device__ __forceinline__ unsigned pk2(float lo, float hi) { return pg8::cvt_pk_bf16(lo, hi); }
__device__ __forceinline__ int opaque_tid() { int t = threadIdx.x; asm volatile("" : "+v"(t)); return t; }
__device__ __forceinline__ float wave_sum(float v) {
#pragma unroll
    for (int o = 1; o < 64; o <<= 1) v += __shfl_xor(v, o);
    return v;
}
__device__ __forceinline__ float wave_max(float v) {
#pragma unroll
    for (int o = 1; o < 64; o <<= 1) v = fmaxf(v, __shfl_xor(v, o));
    return v;
}
__device__ __forceinline__ float silu_f(float x) { return x * __builtin_amdgcn_rcpf(1.f + __expf(-x)); }
__device__ __forceinline__ float softplus_f(float x) { return x > 20.f ? x : log1pf(__expf(x)); }
__device__ __forceinline__ int rel_bucket(int d) {
    d = d < 0 ? 0 : d;
    if (d < 16) return d;
    const float v = logf((float)d / 16.0f) / 4.852030263919617f * 16.0f;
    const int l = 16 + (int)v;
    return l < 31 ? l : 31;
}

#define XB_TMO      128
#define XB_XCNT(j)  (256  + 64 * (j))
#define XB_XSUB(j)  (1280 + 64 * (j))
#define XB_XGEN(j)  (2304 + 64 * (j))
#define XB_TOP      3328
#define XB_TOPGEN   3392
#define XCD_BAR_WORDS 3456
#define XB_SPIN_CAP (1u << 18)
__device__ __forceinline__ unsigned xb_ld(unsigned* p)              { return __hip_atomic_load(p, __ATOMIC_RELAXED, __HIP_MEMORY_SCOPE_AGENT); }
__device__ __forceinline__ unsigned xb_add(unsigned* p, unsigned v) { return __hip_atomic_fetch_add(p, v, __ATOMIC_RELAXED, __HIP_MEMORY_SCOPE_AGENT); }
__device__ __forceinline__ unsigned xb_xcc_id() { return (unsigned)__builtin_amdgcn_s_getreg((3 << 11) | 20) & 0xFu; }
#define XB_SPIN(cond, bar) do { unsigned _sp = 0; while (cond) { __builtin_amdgcn_s_sleep(1); \
    if ((++_sp & 255u) == 0u) { if (xb_ld(&(bar)[XB_TMO])) break; if (_sp > XB_SPIN_CAP) { atomicAdd(&(bar)[XB_TMO], 1u); break; } } } } while (0)
struct XcdBarrier { unsigned* bar; unsigned x; volatile LAS unsigned* st; };
__device__ __forceinline__ XcdBarrier xcd_barrier_post(unsigned* bar, volatile LAS unsigned* st) {
    XcdBarrier b; b.bar = bar; b.x = xb_xcc_id(); b.st = st;
    if (threadIdx.x == 0) (void)xb_add(&bar[XB_XCNT(b.x)], 1u);
    return b;
}
__device__ __forceinline__ void xcd_barrier_complete(unsigned* bar, unsigned x, unsigned& nloc, unsigned& nx) {
    const unsigned G = gridDim.x * gridDim.y * gridDim.z;
    unsigned sum, cnt, mine, sp = 0u;
    for (;;) {
        sum = 0u; cnt = 0u; mine = 0u;
#pragma unroll
        for (unsigned j = 0; j < 16; ++j) { const unsigned c = xb_ld(&bar[XB_XCNT(j)]); sum += c; cnt += (c > 0u) ? 1u : 0u; mine = (j == x) ? c : mine; }
        if (sum == G) break;
        __builtin_amdgcn_s_sleep(1);
        if ((++sp & 255u) == 0u) { if (xb_ld(&bar[XB_TMO])) break; if (sp > XB_SPIN_CAP) { atomicAdd(&bar[XB_TMO], 1u); break; } }
    }
    nloc = mine > 0u ? mine : 1u; nx = cnt > 0u ? cnt : 1u;
}
__device__ __forceinline__ void xcd_barrier(const XcdBarrier& b) {
    asm volatile("s_waitcnt vmcnt(0)" ::: "memory");
    __syncthreads();
    if (threadIdx.x == 0) {
        unsigned* bar = b.bar;
        __builtin_amdgcn_s_waitcnt(0);
        unsigned nloc = b.st[0], nx = b.st[1];
        if (nloc == 0u) { xcd_barrier_complete(bar, b.x, nloc, nx); b.st[0] = nloc; b.st[1] = nx; }
        const unsigned old = xb_add(&bar[XB_XSUB(b.x)], 1u);
        const unsigned gen = old / nloc;
        if (old + 1u == (gen + 1u) * nloc) {
            __builtin_amdgcn_fence(__ATOMIC_RELEASE, "agent");
            asm volatile("s_waitcnt vmcnt(0)" ::: "memory");
            const unsigned og = xb_add(&bar[XB_TOP], 1u);
            const unsigned tg = og / nx;
            if (og + 1u == (tg + 1u) * nx) xb_add(&bar[XB_TOPGEN], 1u);
            else XB_SPIN(xb_ld(&bar[XB_TOPGEN]) == tg, bar);
            __builtin_amdgcn_fence(__ATOMIC_ACQUIRE, "agent");
            xb_add(&bar[XB_XGEN(b.x)], 1u);
            asm volatile("s_waitcnt vmcnt(0)" ::: "memory");
        } else {
            XB_SPIN(xb_ld(&bar[XB_XGEN(b.x)]) == gen, bar);
            __builtin_amdgcn_fence(__ATOMIC_ACQUIRE, "agent");
            asm volatile("s_waitcnt vmcnt(0)" ::: "memory");
        }
    }
    __syncthreads();
}

struct Args { const void* in[N_IN]; float* out; unsigned char* ws; int ph_lo, ph_hi; };
static_assert(sizeof(Args) == N_IN * 8 + 24, "Args has no padding");

__device__ __forceinline__ float rs_of(const float* ssp, int row) {
    const f32x4* p = (const f32x4*)(ssp + (size_t)row * 16); const f32x4 a = p[0], b = p[1], c = p[2], d = p[3];
    const float s = (((a[0] + a[1]) + (a[2] + a[3])) + ((b[0] + b[1]) + (b[2] + b[3]))) + (((c[0] + c[1]) + (c[2] + c[3])) + ((d[0] + d[1]) + (d[2] + d[3])));
    return rsqrtf(s * (1.0f / 1024.0f) + EPS);
}
#define RS_OF(ss, row) rs_of((ss), (row))

struct EpiSsdIn {
    static constexpr bool PERM = true, AFTER_DRAIN = false;
    bf16* ZX; float* DT; const float* ss; const float* dtb;
    __device__ __forceinline__ void operator()(const pg8::f32x4 (&acc)[2][2][4][2], const pg8::Unit& u, int wr, int wc, int fr, int fq) const {
        const int row0 = u.pm * 256 + wr * 64 + fr;
        {
            const int col0 = u.pn * 256 + wc * 32 + 8 * fq;
#pragma unroll
            for (int ai = 0; ai < 2; ++ai)
#pragma unroll
                for (int m = 0; m < 4; ++m) { const int row = row0 + ai * 128 + m * 16; const float rs = RS_OF(ss, row);
#pragma unroll
                    for (int bj = 0; bj < 2; ++bj) { const f32x4 v0 = acc[ai][bj][m][0] * rs, v1 = acc[ai][bj][m][1] * rs;
                        v4u w; w.x = pk2(v0[0], v0[1]); w.y = pk2(v0[2], v0[3]); w.z = pk2(v1[0], v1[1]); w.w = pk2(v1[2], v1[3]);
                        *(v4u*)(ZX + (size_t)row * ZXW + col0 + bj * 128) = w; } }
        }
    }
};

struct EpiNone { static constexpr bool PERM = true, AFTER_DRAIN = false;
    __device__ __forceinline__ void operator()(const pg8::f32x4 (&acc)[2][2][4][2], const pg8::Unit& u, int wr, int wc, int fr, int fq) const { asm volatile("" :: "v"(acc[0][0][0][0][0]), "v"(acc[1][1][3][1][3])); } };
struct EpiRes {
    static constexpr bool PERM = true, AFTER_DRAIN = false;
    const bf16* XB; float* ss_out; float* fin; bf16* XBd;
    __device__ __forceinline__ void operator()(const pg8::f32x4 (&acc)[2][2][4][2], const pg8::Unit& u, int wr, int wc, int fr, int fq) const {
        const int row0 = u.pm * 256 + wr * 64 + fr, col0 = u.pn * 256 + wc * 32 + 8 * fq;
#pragma unroll
        for (int ai = 0; ai < 2; ++ai)
#pragma unroll
            for (int m = 0; m < 4; ++m) { const int row = row0 + ai * 128 + m * 16; float q = 0.f;
                const bf16* xr = XB + (size_t)row * DM + col0;
                v4u xin[2];
#pragma unroll
                for (int bj = 0; bj < 2; ++bj) xin[bj] = *(const v4u*)(xr + bj * 128);
#pragma unroll
                for (int bj = 0; bj < 2; ++bj) { const int co = bj * 128; const v4u xi = xin[bj];
                    const f32x4 v0 = (f32x4){bflo(xi.x), bfhi(xi.x), bflo(xi.y), bfhi(xi.y)} + acc[ai][bj][m][0];
                    const f32x4 v1 = (f32x4){bflo(xi.z), bfhi(xi.z), bflo(xi.w), bfhi(xi.w)} + acc[ai][bj][m][1];
                    if (fin) { if (row < MTOK) { *(f32x4*)(fin + (size_t)row * DM + col0 + co) = v0; *(f32x4*)(fin + (size_t)row * DM + col0 + co + 4) = v1; } }
                    else { v4u w; w.x = pk2(v0[0], v0[1]); w.y = pk2(v0[2], v0[3]); w.z = pk2(v1[0], v1[1]); w.w = pk2(v1[2], v1[3]); *(v4u*)(XBd + (size_t)row * DM + col0 + co) = w;
                           q += ((v0[0] * v0[0] + v0[1] * v0[1]) + (v0[2] * v0[2] + v0[3] * v0[3])) + ((v1[0] * v1[0] + v1[1] * v1[1]) + (v1[2] * v1[2] + v1[3] * v1[3])); } }
                if (!fin) { q += __shfl_xor(q, 16); q += __shfl_xor(q, 32);
                    if (fq == 0) ss_out[(size_t)row * 16 + u.pn * 4 + wc] = q; } }
    }
};

struct EpiSwiGlu {
    static constexpr bool PERM = true, AFTER_DRAIN = false;
    bf16* ACT; const float* ss;
    __device__ __forceinline__ void operator()(const pg8::f32x4 (&acc)[2][2][4][2], const pg8::Unit& u, int wr, int wc, int fr, int fq) const {
        const int row0 = u.pm * 256 + wr * 64 + fr, col0 = u.pn * 128 + wc * 32 + 8 * fq;
#pragma unroll
        for (int ai = 0; ai < 2; ++ai)
#pragma unroll
            for (int m = 0; m < 4; ++m) { const int row = row0 + ai * 128 + m * 16; const float rs = RS_OF(ss, row);
                f32x4 o[2];
#pragma unroll
                for (int n = 0; n < 2; ++n) { const f32x4 g = acc[ai][0][m][n] * rs, up = acc[ai][1][m][n] * rs;
#pragma unroll
                    for (int j = 0; j < 4; ++j) o[n][j] = silu_f(g[j]) * up[j]; }
                v4u w; w.x = pk2(o[0][0], o[0][1]); w.y = pk2(o[0][2], o[0][3]); w.z = pk2(o[1][0], o[1][1]); w.w = pk2(o[1][2], o[1][3]);
                *(v4u*)(ACT + (size_t)row * DFF + col0) = w; }
    }
};

struct EpiSwaQkv {
    static constexpr bool PERM = true, AFTER_DRAIN = false;
    bf16 *Q, *K, *V, *VT; const float* ss; const float *qn, *kn; float* out;
    __device__ __forceinline__ void operator()(const pg8::f32x4 (&acc)[2][2][4][2], const pg8::Unit& u, int wr, int wc, int fr, int fq) const {
        const int row0 = u.pm * 256 + wr * 64 + fr;
        const int slot = u.pn * 4 + wc, kind = slot / 12, head = slot - kind * 12;
        const float* nwp = kind == 0 ? qn : kn;
        f32x4 nw[2][2];
#pragma unroll
        for (int bj = 0; bj < 2; ++bj)
#pragma unroll
            for (int n = 0; n < 2; ++n) nw[bj][n] = (kind < 2) ? *(const f32x4*)(nwp + 32 * bj + 8 * fq + 4 * n) : (f32x4){1.f, 1.f, 1.f, 1.f};
        bf16* dst = Q + (size_t)kind * ((WS_KS - WS_QS) / 2) + head * 64 + 8 * fq;
        const int g = head >> 2, j4 = head & 3, kv = kind - 1, keep = 128 << (2 * g);
        const int obp = g == 0 ? O_KV0_P : (g == 1 ? O_KV1_P : O_KV2_P), obs = g == 0 ? O_KV0_S : (g == 1 ? O_KV1_S : O_KV2_S);
#pragma unroll
        for (int ai = 0; ai < 2; ++ai)
#pragma unroll
            for (int m = 0; m < 4; ++m) { const int row = row0 + ai * 128 + m * 16; const float rs = RS_OF(ss, row);
                f32x4 v[2][2]; float q = 0.f;
#pragma unroll
                for (int bj = 0; bj < 2; ++bj)
#pragma unroll
                    for (int n = 0; n < 2; ++n) { v[bj][n] = acc[ai][bj][m][n] * rs; const f32x4 x = v[bj][n]; q += (x[0] * x[0] + x[1] * x[1]) + (x[2] * x[2] + x[3] * x[3]); }
                if (kind < 2) { q += __shfl_xor(q, 16); q += __shfl_xor(q, 32); const float r = rsqrtf(q * (1.0f / 64.0f) + EPS);
#pragma unroll
                    for (int bj = 0; bj < 2; ++bj)
#pragma unroll
                        for (int n = 0; n < 2; ++n) v[bj][n] = v[bj][n] * r * nw[bj][n]; }
                if (kind == 2 && u.pm < 64) {
                    const int b = row >> 11, t = row & 2047, pp = ((t & ((1 << (2 * g)) - 1)) << (11 - 2 * g)) + (t >> (2 * g)), tp = (pp & ~12) | ((pp & 4) << 1) | ((pp & 8) >> 1);
                    bf16* vt = VT + ((size_t)((b * 12 + head) * 64 + 8 * fq)) * SEQ + tp;
#pragma unroll
                    for (int bj = 0; bj < 2; ++bj)
#pragma unroll
                        for (int n = 0; n < 2; ++n)
#pragma unroll
                            for (int j = 0; j < 4; ++j) vt[(size_t)(32 * bj + 4 * n + j) * SEQ] = (bf16)f2bf(v[bj][n][j]);
                } else {
#pragma unroll
                for (int bj = 0; bj < 2; ++bj) { v4u w; w.x = pk2(v[bj][0][0], v[bj][0][1]); w.y = pk2(v[bj][0][2], v[bj][0][3]); w.z = pk2(v[bj][1][0], v[bj][1][1]); w.w = pk2(v[bj][1][2], v[bj][1][3]);
                    *(v4u*)(dst + (size_t)row * SWAW + 32 * bj) = w; }
                }
                if (kind >= 1 && row < MTOK) {
                    int base = -1;
                    if (row < MP) { const int b = row >> 11, t = row & 2047, t0 = 2048 - keep; if (t >= t0) base = obp + (((b * keep + (t - t0)) * 2 + kv) * 4 + j4) * 64; }
                    else { const int r2 = row - MP, b = r2 >> 2, tt = r2 & 3; base = obs + (((b * keep + (keep - 4 + tt)) * 2 + kv) * 4 + j4) * 64; }
                    if (base >= 0) {
#pragma unroll
                        for (int bj = 0; bj < 2; ++bj)
#pragma unroll
                            for (int n = 0; n < 2; ++n) *(f32x4*)(out + base + 32 * bj + 8 * fq + 4 * n) = v[bj][n]; }
                } }
    }
};

struct EpiDiffQkv {
    static constexpr bool PERM = true, AFTER_DRAIN = false;
    bf16 *Q, *K, *V, *VT; const float* ss; const float *qn, *kn; float* out;
    __device__ __forceinline__ void operator()(const pg8::f32x4 (&acc)[2][2][4][2], const pg8::Unit& u, int wr, int wc, int fr, int fq) const {
        const int row0 = u.pm * 256 + wr * 64 + fr;
        const int slot = u.pn * 4 + wc, kind = slot < 24 ? 0 : (slot < 32 ? 1 : 2);
        const float* nwp = kind == 0 ? qn : kn;
        f32x4 nw[2][2];
#pragma unroll
        for (int bj = 0; bj < 2; ++bj)
#pragma unroll
            for (int n = 0; n < 2; ++n) nw[bj][n] = (kind < 2) ? *(const f32x4*)(nwp + 32 * bj + 8 * fq + 4 * n) : (f32x4){1.f, 1.f, 1.f, 1.f};
        bf16* dst; int pitch, cofs;
        if (kind == 0) { dst = Q; pitch = DQW; cofs = slot * 64; } else { dst = K + (size_t)(kind - 1) * ((WS_VD - WS_KD) / 2); pitch = DKW; cofs = (slot - (kind == 1 ? 24 : 32)) * 64; }
        const int obp = kind == 1 ? O_DK_P : O_DV_P, obs = kind == 1 ? O_DK_S : O_DV_S;
#pragma unroll
        for (int ai = 0; ai < 2; ++ai)
#pragma unroll
            for (int m = 0; m < 4; ++m) { const int row = row0 + ai * 128 + m * 16; const float rs = RS_OF(ss, row);
                f32x4 v[2][2]; float q = 0.f;
#pragma unroll
                for (int bj = 0; bj < 2; ++bj)
#pragma unroll
                    for (int n = 0; n < 2; ++n) { v[bj][n] = acc[ai][bj][m][n] * rs; const f32x4 x = v[bj][n]; q += (x[0] * x[0] + x[1] * x[1]) + (x[2] * x[2] + x[3] * x[3]); }
                if (kind < 2) { q += __shfl_xor(q, 16); q += __shfl_xor(q, 32); const float r = rsqrtf(q * (1.0f / 64.0f) + EPS);
#pragma unroll
                    for (int bj = 0; bj < 2; ++bj)
#pragma unroll
                        for (int n = 0; n < 2; ++n) v[bj][n] = v[bj][n] * r * nw[bj][n]; }
                if (kind == 2 && u.pm < 64) {
                    const int b = row >> 11, t = row & 2047, tp = (t & ~12) | ((t & 4) << 1) | ((t & 8) >> 1), gg = (slot - 32) >> 1, half = (slot - 32) & 1;
                    bf16* vt = VT + ((size_t)((b * 4 + gg) * 128 + half * 64 + 8 * fq)) * SEQ + tp;
#pragma unroll
                    for (int bj = 0; bj < 2; ++bj)
#pragma unroll
                        for (int n = 0; n < 2; ++n)
#pragma unroll
                            for (int j = 0; j < 4; ++j) vt[(size_t)(32 * bj + 4 * n + j) * SEQ] = (bf16)f2bf(v[bj][n][j]);
                } else {
#pragma unroll
                for (int bj = 0; bj < 2; ++bj) { v4u w; w.x = pk2(v[bj][0][0], v[bj][0][1]); w.y = pk2(v[bj][0][2], v[bj][0][3]); w.z = pk2(v[bj][1][0], v[bj][1][1]); w.w = pk2(v[bj][1][2], v[bj][1][3]);
                    *(v4u*)(dst + (size_t)row * pitch + cofs + 32 * bj + 8 * fq) = w; }
                }
                if (kind >= 1 && row < MTOK) {
                    const int base = (row < MP ? obp + row * 512 : obs + (row - MP) * 512) + cofs;
#pragma unroll
                    for (int bj = 0; bj < 2; ++bj)
#pragma unroll
                        for (int n = 0; n < 2; ++n) *(f32x4*)(out + base + 32 * bj + 8 * fq + 4 * n) = v[bj][n];
                } }
    }
};


template <int NT>
__device__ __forceinline__ void wave_gemm(f32x4 (&acc)[NT], const bf16* Arow, const bf16* Bt, const int (&nb)[NT], int K, int r, int c4) {
    const bf16* ap = Arow + 8 * c4;
    const bf16* bp[NT];
#pragma unroll
    for (int nt = 0; nt < NT; ++nt) { bp[nt] = Bt + (size_t)(nb[nt] + r) * K + 8 * c4; acc[nt] = (f32x4){0.f, 0.f, 0.f, 0.f}; }
#pragma unroll 1
    for (int k0 = 0; k0 < K; k0 += 256) {
        pg8::bf16x8 af[8], bf_[NT][8];
#pragma unroll
        for (int s2 = 0; s2 < 8; ++s2) { af[s2] = *(const pg8::bf16x8*)(ap + k0 + 32 * s2);
#pragma unroll
            for (int nt = 0; nt < NT; ++nt) bf_[nt][s2] = *(const pg8::bf16x8*)(bp[nt] + k0 + 32 * s2); }
#pragma unroll
        for (int s2 = 0; s2 < 8; ++s2)
#pragma unroll
            for (int nt = 0; nt < NT; ++nt) acc[nt] = __builtin_amdgcn_mfma_f32_16x16x32_bf16(bf_[nt][s2], af[s2], acc[nt], 0, 0, 0);
    }
}
#define SK_WAVE_IDS const int tid = threadIdx.x, lane = tid & 63, wave = __builtin_amdgcn_readfirstlane(tid >> 6), r = lane & 15, c4 = lane >> 4; \
    const int nidle = (int)gridDim.x - c0, blkp = ((int)blockIdx.x - c0 + (int)gridDim.x) % (int)gridDim.x, ngw = nidle * NWAVES; \
    const int gwp = (blkp < nidle) ? wave * nidle + blkp : (1 << 30)

__device__ __forceinline__ void sk_res(const Args& A, const bf16* Aact, int K, const bf16* Bt, float* ss_out, float* fin, int c0) {
    SK_WAVE_IDS; bf16* XB = (bf16*)(A.ws + WS_XB);
    for (int task = gwp; task < 16 * 8; task += ngw) {
        const int it = task >> 3, rt = task & 7, row = MP + 16 * rt + r;
        const int nb[4] = {64 * it, 64 * it + 16, 64 * it + 32, 64 * it + 48};
        f32x4 acc[4]; wave_gemm<4>(acc, Aact + (size_t)row * K, Bt, nb, K, r, c4);
        float q = 0.f;
#pragma unroll
        for (int nt = 0; nt < 4; ++nt) { const int col = nb[nt] + 4 * c4; const v2u xi = *(const v2u*)(XB + (size_t)row * DM + col);
            const f32x4 v = (f32x4){bflo(xi.x), bfhi(xi.x), bflo(xi.y), bfhi(xi.y)} + acc[nt];
            if (fin) *(f32x4*)(fin + (size_t)row * DM + col) = v;
            else { v2u w; w.x = pk2(v[0], v[1]); w.y = pk2(v[2], v[3]); *(v2u*)(XB + (size_t)row * DM + col) = w; q += (v[0] * v[0] + v[1] * v[1]) + (v[2] * v[2] + v[3] * v[3]); } }
        if (!fin) { q += __shfl_xor(q, 16); q += __shfl_xor(q, 32); if (c4 == 0) ss_out[(size_t)row * 16 + it] = q; }
    }
}
__device__ __forceinline__ void sk_swiglu(const Args& A, const bf16* Bt, const float* ss, int c0) {
    SK_WAVE_IDS; const bf16* XB = (const bf16*)(A.ws + WS_XB); bf16* ACT = (bf16*)(A.ws + WS_ACT);
    for (int task = gwp; task < 88 * 8; task += ngw) {
        const int it = task >> 3, rt = task & 7, row = MP + 16 * rt + r, pn = it >> 2, i0 = (it & 3) * 32;
        const int nb[4] = {256 * pn + i0, 256 * pn + i0 + 16, 256 * pn + 128 + i0, 256 * pn + 128 + i0 + 16};
        f32x4 acc[4]; wave_gemm<4>(acc, XB + (size_t)row * DM, Bt, nb, DM, r, c4);
        const float rs = RS_OF(ss, row);
#pragma unroll
        for (int h2 = 0; h2 < 2; ++h2) { const f32x4 g = acc[h2] * rs, up = acc[2 + h2] * rs;
            v2u w; w.x = pk2(silu_f(g[0]) * up[0], silu_f(g[1]) * up[1]); w.y = pk2(silu_f(g[2]) * up[2], silu_f(g[3]) * up[3]);
            *(v2u*)(ACT + (size_t)row * DFF + 128 * pn + i0 + 16 * h2 + 4 * c4) = w; }
    }
}
__device__ __forceinline__ void sk_ssdin(const Args& A, const bf16* Bt, const float* ss, const float* dtb, int c0) {
    SK_WAVE_IDS; const bf16* XB = (const bf16*)(A.ws + WS_XB); bf16* ZX = (bf16*)(A.ws + WS_ZX); float* DT = (float*)(A.ws + WS_DT);
    for (int task = gwp; task < 80 * 8; task += ngw) {
        const int it = task >> 3, rt = task & 7, row = MP + 16 * rt + r;
        const int nb[4] = {64 * it, 64 * it + 16, 64 * it + 32, 64 * it + 48};
        f32x4 acc[4]; wave_gemm<4>(acc, XB + (size_t)row * DM, Bt, nb, DM, r, c4);
        const float rs = RS_OF(ss, row);
#pragma unroll
        for (int nt = 0; nt < 4; ++nt) { const f32x4 v = acc[nt] * rs; v2u w; w.x = pk2(v[0], v[1]); w.y = pk2(v[2], v[3]); *(v2u*)(ZX + (size_t)row * ZXW + nb[nt] + 4 * c4) = w; }
    }
    for (int task = (gwp < (1 << 30)) ? (gwp + ngw - (640 % ngw)) % ngw : gwp; task < (MP + MS) / 16; task += ngw) {
        const int row = 16 * task + r;
        const int nb[2] = {5120, 5136};
        f32x4 acc[2]; wave_gemm<2>(acc, XB + (size_t)row * DM, Bt, nb, DM, r, c4);
        const float rs = RS_OF(ss, row);
#pragma unroll
        for (int nt = 0; nt < 2; ++nt) { f32x4 v = acc[nt] * rs + *(const f32x4*)(dtb + 16 * nt + 4 * c4);
#pragma unroll
            for (int j = 0; j < 4; ++j) v[j] = softplus_f(v[j]);
            *(f32x4*)(DT + (size_t)row * 32 + 16 * nt + 4 * c4) = v; }
    }
}
__device__ __forceinline__ void sk_swaqkv(const Args& A, const bf16* Bt, const float* ss, int c0) {
    SK_WAVE_IDS; const bf16* XB = (const bf16*)(A.ws + WS_XB); bf16* Q = (bf16*)(A.ws + WS_QS);
    for (int task = gwp; task < 36 * 8; task += ngw) {
        const int slot = task >> 3, rt = task & 7, row = MP + 16 * rt + r, pn = slot >> 2, wc = slot & 3, kind = slot / 12, head = slot - kind * 12;
        const int nb[4] = {256 * pn + 32 * wc, 256 * pn + 32 * wc + 16, 256 * pn + 128 + 32 * wc, 256 * pn + 128 + 32 * wc + 16};
        f32x4 acc[4]; wave_gemm<4>(acc, XB + (size_t)row * DM, Bt, nb, DM, r, c4);
        const float rs = RS_OF(ss, row); float q = 0.f;
#pragma unroll
        for (int nt = 0; nt < 4; ++nt) { acc[nt] = acc[nt] * rs; q += (acc[nt][0] * acc[nt][0] + acc[nt][1] * acc[nt][1]) + (acc[nt][2] * acc[nt][2] + acc[nt][3] * acc[nt][3]); }
        if (kind < 2) { q += __shfl_xor(q, 16); q += __shfl_xor(q, 32); const float rr = rsqrtf(q * (1.0f / 64.0f) + EPS); const float* nwp = (const float*)A.in[kind == 0 ? I_SWAQN : I_SWAKN];
#pragma unroll
            for (int nt = 0; nt < 4; ++nt) acc[nt] = acc[nt] * rr * *(const f32x4*)(nwp + 16 * nt + 4 * c4); }
        bf16* dst = Q + (size_t)kind * ((WS_KS - WS_QS) / 2) + (size_t)row * SWAW + head * 64;
#pragma unroll
        for (int nt = 0; nt < 4; ++nt) { v2u w; w.x = pk2(acc[nt][0], acc[nt][1]); w.y = pk2(acc[nt][2], acc[nt][3]); *(v2u*)(dst + 16 * nt + 4 * c4) = w; }
        if (kind >= 1) { const int g = head >> 2, j4 = head & 3, kv = kind - 1, keep = 128 << (2 * g), r2 = row - MP, b = r2 >> 2, tt = r2 & 3;
            const int obs = g == 0 ? O_KV0_S : (g == 1 ? O_KV1_S : O_KV2_S);
            float* o = A.out + obs + (size_t)(((b * keep + (keep - 4 + tt)) * 2 + kv) * 4 + j4) * 64;
#pragma unroll
            for (int nt = 0; nt < 4; ++nt) *(f32x4*)(o + 16 * nt + 4 * c4) = acc[nt]; }
    }
}
__device__ __forceinline__ void sk_diffqkv(const Args& A, const bf16* Bt, const float* ss, int c0) {
    SK_WAVE_IDS; const bf16* XB = (const bf16*)(A.ws + WS_XB);
    for (int task = gwp; task < 40 * 8; task += ngw) {
        const int slot = task >> 3, rt = task & 7, row = MP + 16 * rt + r, pn = slot >> 2, wc = slot & 3, kind = slot < 24 ? 0 : (slot < 32 ? 1 : 2);
        const int nb[4] = {256 * pn + 32 * wc, 256 * pn + 32 * wc + 16, 256 * pn + 128 + 32 * wc, 256 * pn + 128 + 32 * wc + 16};
        f32x4 acc[4]; wave_gemm<4>(acc, XB + (size_t)row * DM, Bt, nb, DM, r, c4);
        const float rs = RS_OF(ss, row); float q = 0.f;
#pragma unroll
        for (int nt = 0; nt < 4; ++nt) { acc[nt] = acc[nt] * rs; q += (acc[nt][0] * acc[nt][0] + acc[nt][1] * acc[nt][1]) + (acc[nt][2] * acc[nt][2] + acc[nt][3] * acc[nt][3]); }
        if (kind < 2) { q += __shfl_xor(q, 16); q += __shfl_xor(q, 32); const float rr = rsqrtf(q * (1.0f / 64.0f) + EPS); const float* nwp = (const float*)A.in[kind == 0 ? I_DQN : I_DKN];
#pragma unroll
            for (int nt = 0; nt < 4; ++nt) acc[nt] = acc[nt] * rr * *(const f32x4*)(nwp + 16 * nt + 4 * c4); }
        bf16* dst; int cofs;
        if (kind == 0) { dst = (bf16*)(A.ws + WS_QD) + (size_t)row * DQW; cofs = slot * 64; }
        else { dst = (bf16*)(A.ws + WS_KD) + (size_t)(kind - 1) * ((WS_VD - WS_KD) / 2) + (size_t)row * DKW; cofs = (slot - (kind == 1 ? 24 : 32)) * 64; }
#pragma unroll
        for (int nt = 0; nt < 4; ++nt) { v2u w; w.x = pk2(acc[nt][0], acc[nt][1]); w.y = pk2(acc[nt][2], acc[nt][3]); *(v2u*)(dst + cofs + 16 * nt + 4 * c4) = w; }
        if (kind >= 1) { float* o = A.out + (kind == 1 ? O_DK_S : O_DV_S) + (size_t)(row - MP) * 512 + cofs;
#pragma unroll
            for (int nt = 0; nt < 4; ++nt) *(f32x4*)(o + 16 * nt + 4 * c4) = acc[nt]; }
    }
}

__device__ __forceinline__ int conv_src_col(int n0, int Nsrc, int Ndst, int maptype) {
    if (maptype == 0) return (n0 < Nsrc) ? n0 : -1;
    const int pn = n0 >> 8, r = n0 & 255;
    if (maptype == 1) return (r >> 7) * (Ndst >> 1) + 128 * pn + (r & 127);
    return 256 * pn + 64 * ((r & 127) >> 5) + 32 * (r >> 7);
}
__device__ __forceinline__ void conv_item(const float* __restrict__ W, int K, int Nsrc, int Ndst, bf16* WT, const float* __restrict__ gain, int maptype, LAS float* scr, int item, int lane) {
    const int nblk = Ndst / 64;
    const int kr = lane >> 4, nc = lane & 15;
    {
        const int kb = item / nblk, nb = item - kb * nblk, k0 = 64 * kb, n0 = 64 * nb;
        const int srcb = conv_src_col(n0 + 32 * (nc >> 3), Nsrc, Ndst, maptype);
        f32x4 v[16];
#pragma unroll
        for (int i = 0; i < 16; ++i) { v[i] = (f32x4){0.f, 0.f, 0.f, 0.f};
            if (srcb >= 0) { v[i] = *(const f32x4*)(W + (size_t)(k0 + 4 * i + kr) * Nsrc + srcb + 4 * (nc & 7)); if (gain) v[i] = v[i] * gain[k0 + 4 * i + kr]; } }
#pragma unroll
        for (int hf = 0; hf < 2; ++hf) {
#pragma unroll
            for (int i = 0; i < 8; ++i) { LAS float* d = scr + (4 * i + kr) * 65 + 4 * nc; const f32x4 x = v[8 * hf + i]; d[0] = x[0]; d[1] = x[1]; d[2] = x[2]; d[3] = x[3]; }
            LDS_WAIT(); asm volatile("" ::: "memory");
#pragma unroll
            for (int j = 0; j < 4; ++j) { const int id = j * 64 + lane, n = id >> 2, c = id & 3; const LAS float* sp = scr + (8 * c) * 65 + n;
                v4u o; o.x = pk2(sp[0 * 65], sp[1 * 65]); o.y = pk2(sp[2 * 65], sp[3 * 65]); o.z = pk2(sp[4 * 65], sp[5 * 65]); o.w = pk2(sp[6 * 65], sp[7 * 65]);
                *(v4u*)(WT + (size_t)(n0 + n) * K + k0 + 32 * hf + 8 * c) = o; }
            LDS_WAIT(); asm volatile("" ::: "memory");
        }
    }
}

__device__ __forceinline__ void cache_copy_slice(const Args& A, int part, int nparts, int c0) {
    const int tid = threadIdx.x, lane = tid & 63, wave = __builtin_amdgcn_readfirstlane(tid >> 6);
    const int nidle = (int)gridDim.x - c0, blkp = ((int)blockIdx.x - c0 + (int)gridDim.x) % (int)gridDim.x;
    if (blkp >= nidle) return;
    constexpr int R0 = NBS * 124, R1 = NBS * 508, R2 = NBS * 2044, RT = R0 + R1 + R2;
    const int lo = (int)((long)RT * part / nparts), hi = (int)((long)RT * (part + 1) / nparts);
    const int gw = blkp * NWAVES + wave, ngw = nidle * NWAVES;
    for (int it0 = lo + 4 * gw; it0 < hi; it0 += 4 * ngw) {
        f32x4 v[4][2]; float* dstp[4];
#pragma unroll
        for (int q = 0; q < 4; ++q) { const int it = it0 + q; dstp[q] = nullptr;
            if (it < hi) { int g, r; if (it < R0) { g = 0; r = it; } else if (it < R0 + R1) { g = 1; r = it - R0; } else { g = 2; r = it - R0 - R1; }
                const int lb = 128 << (2 * g), per = lb - 4, b = r / per, i = r - b * per;
                const float* src = (const float*)A.in[I_SWA0 + g] + ((size_t)(b * lb + i + 4)) * 512;
                dstp[q] = A.out + (g == 0 ? O_KV0_S : (g == 1 ? O_KV1_S : O_KV2_S)) + ((size_t)(b * lb + i)) * 512;
                v[q][0] = ((const f32x4*)src)[lane]; v[q][1] = ((const f32x4*)src)[lane + 64]; } }
#pragma unroll
        for (int q = 0; q < 4; ++q) if (dstp[q]) { ((f32x4*)dstp[q])[lane] = v[q][0]; ((f32x4*)dstp[q])[lane + 64] = v[q][1]; }
    }
}

__device__ __forceinline__ void prologue_phase(const Args& A, LAS unsigned char* lds) {
    const int tid = threadIdx.x, lane = tid & 63, wave = __builtin_amdgcn_readfirstlane(tid >> 6);
    const int gw = blockIdx.x * NWAVES + wave, ngw = gridDim.x * NWAVES;
    LAS float* scr = (LAS float*)(lds + wave * 8448);
    unsigned char* ws = A.ws;
    {
        constexpr int I0 = 16 * 84, I1 = 32 * 16, I2 = 16 * 36, I3 = 12 * 16, I4 = 16 * 40, I5 = 24 * 16, I6 = 16 * 88, I7 = 44 * 16;
        constexpr int P1 = 2 * I0, P2 = P1 + 2 * I1, P3 = P2 + I2, P4 = P3 + I3, P5 = P4 + I4, P6 = P5 + I5, P7 = P6 + 4 * I6, PT = P7 + 4 * I7;
        for (int item = gw; item < PT; item += ngw) {
            const float* W; int K, Nsrc, Ndst, mt, li; bf16* WT; const float* gain;
            if (item < P1)      { const int i = item / I0; li = item - i * I0; W = (const float*)A.in[I_SSMWIN] + (size_t)i * DM * SSMN; K = DM; Nsrc = SSMN; Ndst = SSMNP; mt = 0; WT = (bf16*)(ws + WS_WSSDIN + i * al4k(SZ_WSSDIN)); gain = (const float*)A.in[I_NMIX] + (i == 0 ? 0 : 3) * DM; }
            else if (item < P2) { const int r = item - P1, i = r / I1; li = r - i * I1; W = (const float*)A.in[I_SSMWOUT] + (size_t)i * DIN * DM; K = DIN; Nsrc = DM; Ndst = DM; mt = 0; WT = (bf16*)(ws + WS_WSSDOUT + i * al4k(SZ_WSSDOUT)); gain = nullptr; }
            else if (item < P3) { li = item - P2; W = (const float*)A.in[I_SWAQKV]; K = DM; Nsrc = 2304; Ndst = 2304; mt = 2; WT = (bf16*)(ws + WS_WSWAQKV); gain = (const float*)A.in[I_NMIX] + 1 * DM; }
            else if (item < P4) { li = item - P3; W = (const float*)A.in[I_SWAOUT]; K = SWAW; Nsrc = DM; Ndst = DM; mt = 0; WT = (bf16*)(ws + WS_WSWAOUT); gain = nullptr; }
            else if (item < P5) { li = item - P4; W = (const float*)A.in[I_DQKV]; K = DM; Nsrc = 2560; Ndst = 2560; mt = 2; WT = (bf16*)(ws + WS_WDQKV); gain = (const float*)A.in[I_NMIX] + 2 * DM; }
            else if (item < P6) { li = item - P5; W = (const float*)A.in[I_DOUT]; K = DQW; Nsrc = DM; Ndst = DM; mt = 0; WT = (bf16*)(ws + WS_WDOUT); gain = nullptr; }
            else if (item < P7) { const int r = item - P6, l = r / I6; li = r - l * I6; W = (const float*)A.in[I_FFIN] + (size_t)l * DM * 2 * DFF; K = DM; Nsrc = 2 * DFF; Ndst = 2 * DFF; mt = 1; WT = (bf16*)(ws + WS_WFFIN + l * al4k(SZ_WFFIN)); gain = (const float*)A.in[I_NFFN] + l * DM; }
            else                { const int r = item - P7, l = r / I7; li = r - l * I7; W = (const float*)A.in[I_FFOUT] + (size_t)l * DFF * DM; K = DFF; Nsrc = DM; Ndst = DM; mt = 0; WT = (bf16*)(ws + WS_WFFOUT + l * al4k(SZ_WFFOUT)); gain = nullptr; }
            conv_item(W, K, Nsrc, Ndst, WT, gain, mt, scr, li, lane);
        }
    }
    {
        bf16* XB = (bf16*)(ws + WS_XB); float* ss0 = (float*)(ws + WS_SS);
        for (int m = gw; m < MPAD; m += ngw) {
            f32x4 v[4]; float s = 0.f;
            const float* src = m < MP ? (const float*)A.in[I_XP] + (size_t)m * DM : (const float*)A.in[I_XS] + (size_t)(m - MP) * DM;
#pragma unroll
            for (int j = 0; j < 4; ++j) { v[j] = (m < MTOK) ? ((const f32x4*)src)[lane + 64 * j] : (f32x4){0.f, 0.f, 0.f, 0.f}; s += (v[j][0] * v[j][0] + v[j][1] * v[j][1]) + (v[j][2] * v[j][2] + v[j][3] * v[j][3]); }
            s = wave_sum(s);
#pragma unroll
            for (int j = 0; j < 4; ++j) { v2u w; w.x = pk2(v[j][0], v[j][1]); w.y = pk2(v[j][2], v[j][3]); ((v2u*)(XB + (size_t)m * DM))[lane + 64 * j] = w; }
            if (lane < 16) ss0[(size_t)m * 16 + lane] = (lane == 0) ? s : 0.f;
        }
    }
}

__device__ __forceinline__ void ssd_prompt_unit(const Args& A, LAS unsigned char* lds, int li, int b, int h);
__device__ __forceinline__ void ssd_scan_phase(const Args& A, LAS unsigned char* lds, int li) {
    const int tid = threadIdx.x;
    unsigned char* ws = A.ws;
    const bf16* ZX = (const bf16*)(ws + WS_ZX); const float* DT = (const float*)(ws + WS_DT); bf16* YG = (bf16*)(ws + WS_YG);
    const float* convw = (const float*)A.in[I_CONVW] + li * 4 * CONVD; const float* convb = (const float*)A.in[I_CONVB] + li * CONVD;
    const float* alog = (const float*)A.in[I_ALOG] + li * 32; const float* dsk = (const float*)A.in[I_SSMD] + li * 32;
    const float* cst = (const float*)A.in[I_CONVST] + (size_t)li * NBS * 3 * CONVD;
    const float* sst = (const float*)A.in[I_SSMST] + (size_t)li * NBS * 32 * 8192;
    float* out = A.out;
    {
        int tg = tid; asm volatile("" : "+v"(tg)); const int gt = blockIdx.x * NTHR + tg, ngt = gridDim.x * NTHR;
        for (int e = gt; e < NBP * 3 * CONVD; e += ngt) { const int b = e / (3 * CONVD), r = e - b * 3 * CONVD, j = r / CONVD, ch = r - j * CONVD;
            out[O_CONV_P + li * (NBP * 3 * CONVD) + e] = bf2f(ZX[(size_t)(b * SEQ + SEQ - 3 + j) * ZXW + 2048 + ch]); }
        for (int e = gt; e < NBS * 3 * CONVD; e += ngt) { const int b = e / (3 * CONVD), r = e - b * 3 * CONVD, j = r / CONVD, ch = r - j * CONVD;
            out[O_CONV_S + li * (NBS * 3 * CONVD) + e] = bf2f(ZX[(size_t)(MP + b * 4 + 1 + j) * ZXW + 2048 + ch]); }
    }
    for (int rep = 0; rep < REP_SCANP; ++rep)
    for (int u = blockIdx.x; u < 256; u += gridDim.x) ssd_prompt_unit(A, lds, li, u >> 5, u & 31);
    {
        int tidS = tid; asm volatile("" : "+v"(tidS));
        const int lane = tidS & 63, wave = __builtin_amdgcn_readfirstlane(tidS >> 6), G = gridDim.x;
        LAS float* bc = (LAS float*)lds + wave * 1024;
        __syncthreads();
        for (int rep = 0; rep < REP_SCANS; ++rep)
        for (int task = wave * G + (int)blockIdx.x; task < NBS * 32; task += NWAVES * G) {
            const int b = task >> 5, h = task & 31, g = h >> 3, rb = MP + b * TS;
            f32x4 H[32];
            { const f32x4* sp = (const f32x4*)(sst + ((size_t)((b * 32 + h) * 64 + lane)) * 128);
#pragma unroll
              for (int q = 0; q < 32; ++q) H[q] = sp[q]; }
            float xv[4], zv[4], dtv[4];
            {
                int cch[5] = {h * 64 + lane, 2048 + g * 128 + lane, 2048 + g * 128 + 64 + lane, 2560 + g * 128 + lane, 2560 + g * 128 + 64 + lane};
#pragma unroll
                for (int ci = 0; ci < 5; ++ci) { const int cc = cch[ci];
                    float in[7];
#pragma unroll
                    for (int k = 0; k < 3; ++k) in[k] = cst[(size_t)(b * 3 + k) * CONVD + cc];
#pragma unroll
                    for (int k = 0; k < 4; ++k) in[3 + k] = bf2f(ZX[(size_t)(rb + k) * ZXW + 2048 + cc]);
                    const float w0 = convw[cc], w1 = convw[CONVD + cc], w2 = convw[2 * CONVD + cc], w3 = convw[3 * CONVD + cc], bs = convb[cc];
#pragma unroll
                    for (int tt = 0; tt < 4; ++tt) { const float v = silu_f(bs + w0 * in[tt] + w1 * in[tt + 1] + w2 * in[tt + 2] + w3 * in[tt + 3]);
                        if (ci == 0) xv[tt] = v; else bc[tt * 256 + (ci - 1) * 64 + lane] = v; }
                }
#pragma unroll
                for (int tt = 0; tt < 4; ++tt) { zv[tt] = bf2f(ZX[(size_t)(rb + tt) * ZXW + h * 64 + lane]); dtv[tt] = DT[(size_t)(rb + tt) * 32 + h]; }
            }
            LDS_WAIT(); __builtin_amdgcn_wave_barrier();
            const float a = -__expf(alog[h]), Dh = dsk[h];
#pragma unroll
            for (int tt = 0; tt < 4; ++tt) {
                const float dt = dtv[tt], dA = __expf(dt * a), dtx = dt * xv[tt];
                const LAS f32x4* Bp = (const LAS f32x4*)(bc + tt * 256); const LAS f32x4* Cp = Bp + 32;
                float y0 = 0.f, y1 = 0.f;
#pragma unroll
                for (int q = 0; q < 32; ++q) { const f32x4 bb = Bp[q], cq = Cp[q];
                    H[q] = H[q] * dA + bb * dtx;
                    y0 += cq[0] * H[q][0] + cq[1] * H[q][1]; y1 += cq[2] * H[q][2] + cq[3] * H[q][3]; }
                const float y = (y0 + y1) + Dh * xv[tt];
                YG[(size_t)(rb + tt) * DIN + h * 64 + lane] = (bf16)f2bf(y * silu_f(zv[tt]));
            }
            { f32x4* so = (f32x4*)(out + O_SSM_S + li * (NBS * 32 * 8192) + ((size_t)((b * 32 + h) * 64 + lane)) * 128);
#pragma unroll
              for (int q = 0; q < 32; ++q) so[q] = H[q]; }
            LDS_WAIT(); __builtin_amdgcn_wave_barrier();
        }
        __syncthreads();
    }
}

__device__ __forceinline__ int pi32_pos0(int tb8) { return ((tb8 >> 2) << 5) + 16 * (tb8 & 1) + 4 * ((tb8 >> 1) & 1); }
__device__ __forceinline__ void ssd_prepass_phase(const Args& A, int li) {
    int tid = threadIdx.x; asm volatile("" : "+v"(tid));
    const int lane = tid & 63, wave = __builtin_amdgcn_readfirstlane(tid >> 6);
    const int gw = blockIdx.x * NWAVES + wave, ngw = gridDim.x * NWAVES, gt = blockIdx.x * NTHR + tid, ngt = gridDim.x * NTHR;
    const bf16* ZX = (const bf16*)(A.ws + WS_ZX); const float* DT = (const float*)(A.ws + WS_DT);
    bf16* BC = (bf16*)(A.ws + WS_BC); bf16* BT = (bf16*)(A.ws + WS_BT); f32x4* SC = (f32x4*)(A.ws + WS_SC);
    const float* convw = (const float*)A.in[I_CONVW] + li * 4 * CONVD; const float* convb = (const float*)A.in[I_CONVB] + li * CONVD;
    const float* alog = (const float*)A.in[I_ALOG] + li * 32;
    for (int task = gt; task < NBP * 128 * 1024; task += ngt) {
        const int ch = task & 1023, tb = (task >> 10) & 127, b = task >> 17, cc = 2048 + ch, t0 = tb * 16;
        const float w0 = convw[cc], w1 = convw[CONVD + cc], w2 = convw[2 * CONVD + cc], w3 = convw[3 * CONVD + cc], bs = convb[cc];
        float v[19];
#pragma unroll
        for (int k = 0; k < 19; ++k) { const int t = t0 - 3 + k; v[k] = (t >= 0) ? bf2f(ZX[(size_t)(b * SEQ + t) * ZXW + 2048 + cc]) : 0.f; }
        float o[16];
#pragma unroll
        for (int e = 0; e < 16; ++e) { o[e] = silu_f(bs + w0 * v[e] + w1 * v[e + 1] + w2 * v[e + 2] + w3 * v[e + 3]); BC[(size_t)(b * SEQ + t0 + e) * 1024 + ch] = (bf16)f2bf(o[e]); }
        if (ch < 512) { const int g = ch >> 7, n = ch & 127; bf16* rowp = BT + (size_t)((b * 4 + g) * 128 + n) * SEQ + (t0 & ~63);
#pragma unroll
            for (int hb = 0; hb < 2; ++hb) { bf16* row = rowp + pi32_pos0((2 * tb + hb) & 7);
                v2u a; a.x = pk2(o[8 * hb + 0], o[8 * hb + 1]); a.y = pk2(o[8 * hb + 2], o[8 * hb + 3]); v2u c2; c2.x = pk2(o[8 * hb + 4], o[8 * hb + 5]); c2.y = pk2(o[8 * hb + 6], o[8 * hb + 7]);
                *(v2u*)row = a; *(v2u*)(row + 8) = c2; } }
    }
    for (int task = gw; task < NBP * 32 * 32; task += ngw) {
        const int h = task & 31, ck = (task >> 5) & 31, b = task >> 10, row = b * SEQ + ck * 64 + lane;
        const float dt = DT[(size_t)row * 32 + h], a = -__expf(alog[h]);
        float x = dt * a;
#pragma unroll
        for (int o = 1; o < 64; o <<= 1) { const float y = __shfl_up(x, o); if (lane >= o) x += y; }
        const float tot = __shfl(x, 63);
        SC[(size_t)row * 32 + h] = (f32x4){x, dt, dt * __expf(tot - x), __expf(x)};
    }
}


namespace ssdk { constexpr int PX = 144, PC = 272;
    constexpr int XST = 0, XSW = XST + 64 * PX, CM = XSW + 64 * PX, BM = CM + 64 * PC, BMT = BM + 64 * PC, HB = BMT + 128 * PX, SCL = HB + 64 * PC; }
template <int NJ>
__device__ __forceinline__ void ssd_stage1(LAS unsigned char* lds, const pg8::bf16x8 (&cf)[4], const LAS float* cumL, const LAS float* dtL, int r, int c, float Dh, pg8::bf16x8 (&wf)[2]) {
    constexpr int it = NJ - 1;
    f32x4 g4[4];
#pragma unroll
    for (int jt = 0; jt < 4; ++jt) g4[jt] = (f32x4){0.f, 0.f, 0.f, 0.f};
#pragma unroll
    for (int kh = 0; kh < 2; ++kh) {
        pg8::bf16x8 bfr[NJ][2];
#pragma unroll
        for (int jt = 0; jt < NJ; ++jt)
#pragma unroll
            for (int k2 = 0; k2 < 2; ++k2) bfr[jt][k2] = *(const LAS pg8::bf16x8*)(lds + ssdk::BM + (16 * jt + r) * ssdk::PC + (32 * (2 * kh + k2) + 8 * c) * 2);
        __builtin_amdgcn_sched_barrier(0);
#pragma unroll
        for (int k2 = 0; k2 < 2; ++k2)
#pragma unroll
            for (int jt = 0; jt < NJ; ++jt) g4[jt] = __builtin_amdgcn_mfma_f32_16x16x32_bf16(bfr[jt][k2], cf[2 * kh + k2], g4[jt], 0, 0, 0);
        __builtin_amdgcn_sched_barrier(0);
    }
    f32x4 cj[NJ], dj[NJ];
#pragma unroll
    for (int jt = 0; jt < NJ; ++jt) { cj[jt] = *(const LAS f32x4*)(cumL + 16 * jt + 4 * c); dj[jt] = *(const LAS f32x4*)(dtL + 16 * jt + 4 * c); }
    const float ci = cumL[16 * it + r];
#pragma unroll
    for (int jt = 0; jt < NJ; ++jt)
#pragma unroll
        for (int q = 0; q < 4; ++q) {
            float wv = g4[jt][q] * __expf(ci - cj[jt][q]) * dj[jt][q];
            if (jt == it) { const int jl = 4 * c + q; wv = (jl <= r) ? wv : 0.f; if (jl == r) wv += Dh; }
            g4[jt][q] = wv; }
#pragma unroll
    for (int kk = 0; kk < 2; ++kk) { v4u w; w.x = pk2(g4[2 * kk][0], g4[2 * kk][1]); w.y = pk2(g4[2 * kk][2], g4[2 * kk][3]); w.z = pk2(g4[2 * kk + 1][0], g4[2 * kk + 1][1]); w.w = pk2(g4[2 * kk + 1][2], g4[2 * kk + 1][3]);
        wf[kk] = __builtin_bit_cast(pg8::bf16x8, w); }
}

__device__ __forceinline__ void ssd_prompt_unit(const Args& A, LAS unsigned char* lds, int li, int b, int h) {
    const int tid = threadIdx.x, lane = tid & 63, wave = __builtin_amdgcn_readfirstlane(tid >> 6);
    const int r = lane & 15, c = lane >> 4, it = (wave < 4) ? (wave >> 1) : 3 - ((wave - 4) >> 1), ph = wave & 1, g = h >> 3, rb = b * SEQ;
    using namespace ssdk;
    static_assert(SCL + 1024 <= RING_BYTES, "ssd LDS map");
    LAS float* cumL = (LAS float*)(lds + SCL); LAS float* dtL = cumL + 64; LAS float* ecL = cumL + 128;
    const bf16* ZX = (const bf16*)(A.ws + WS_ZX); const bf16* BC = (const bf16*)(A.ws + WS_BC); const bf16* BT = (const bf16*)(A.ws + WS_BT); const f32x4* SC = (const f32x4*)(A.ws + WS_SC);
    bf16* YG = (bf16*)(A.ws + WS_YG);
    const float* convw = (const float*)A.in[I_CONVW] + li * 4 * CONVD; const float* convb = (const float*)A.in[I_CONVB] + li * CONVD;
    const float Dh = ((const float*)A.in[I_SSMD])[li * 32 + h];
    const int xcc = h * 64 + lane;
    const float xw0 = convw[xcc], xw1 = convw[CONVD + xcc], xw2 = convw[2 * CONVD + xcc], xw3 = convw[3 * CONVD + xcc], xbs = convb[xcc];
    const int xpos = pi32_pos0(wave);
    const int crow = tid >> 4, cc16 = tid & 15, tn = tid >> 3, tc8 = tid & 7;
    const bf16* csrc = BC + (size_t)(rb + crow) * 1024 + 512 + g * 128 + cc16 * 8;
    const bf16* bsrc = BC + (size_t)(rb + crow) * 1024 + g * 128 + cc16 * 8;
    const bf16* tsrc = BT + (size_t)((b * 4 + g) * 128 + tn) * SEQ + tc8 * 8;
    const int cdst = crow * PC + cc16 * 16, tdst = tn * PX + tc8 * 16;
    f32x4 Ht[4];
#pragma unroll
    for (int i = 0; i < 4; ++i) Ht[i] = (f32x4){0.f, 0.f, 0.f, 0.f};
    struct SsdRegs { v4u pc0, pc1, pb0, pb1, pt0, pt1; f32x4 psc; unsigned xr[11]; float xwj[8]; v2u zz[2]; };
    SsdRegs R0;
    R0.psc = (f32x4){0.f, 0.f, 0.f, 0.f};
#define SSD_PREFETCH(R, ck) do { const size_t ro = (size_t)(ck) * 64 * 1024; \
        R.pc0 = *(const v4u*)(csrc + ro); R.pc1 = *(const v4u*)(csrc + ro + 32 * 1024); R.pb0 = *(const v4u*)(bsrc + ro); R.pb1 = *(const v4u*)(bsrc + ro + 32 * 1024); \
        R.pt0 = *(const v4u*)(tsrc + (ck) * 64); R.pt1 = *(const v4u*)(tsrc + (ck) * 64 + (size_t)64 * SEQ); \
        if (tid < 64) R.psc = SC[(size_t)(rb + (ck) * 64 + tid) * 32 + h]; \
        _Pragma("unroll") for (int k = 0; k < 11; ++k) { const int t = (ck) * 64 + 8 * wave - 3 + k; R.xr[k] = ZX[(size_t)(rb + (t < 0 ? 0 : t)) * ZXW + 2048 + xcc]; } \
        _Pragma("unroll") for (int e = 0; e < 8; ++e) R.xwj[e] = ((const float*)SC)[((size_t)(rb + (ck) * 64 + 8 * wave + e) * 32 + h) * 4 + 2]; \
        _Pragma("unroll") for (int pt = 0; pt < 2; ++pt) R.zz[pt] = *(const v2u*)(ZX + (size_t)(rb + (ck) * 64 + 16 * it + r) * ZXW + h * 64 + 32 * ph + 16 * pt + 4 * c); } while (0)
#define SSD_CHUNK(R, ck) do { \
        __syncthreads();                                              \
        _Pragma("unroll") for (int pt = 0; pt < 4; ++pt) { v2u w; w.x = pk2(Ht[pt][0], Ht[pt][1]); w.y = pk2(Ht[pt][2], Ht[pt][3]); *(LAS v2u*)(lds + HB + (16 * pt + r) * PC + (16 * wave + 4 * c) * 2) = w; } \
        *(LAS v4u*)(lds + CM + cdst) = R.pc0; *(LAS v4u*)(lds + CM + cdst + 32 * PC) = R.pc1; \
        *(LAS v4u*)(lds + BM + cdst) = R.pb0; *(LAS v4u*)(lds + BM + cdst + 32 * PC) = R.pb1; \
        *(LAS v4u*)(lds + BMT + tdst) = R.pt0; *(LAS v4u*)(lds + BMT + tdst + 64 * PX) = R.pt1; \
        if (tid < 64) { cumL[tid] = R.psc[0]; dtL[tid] = R.psc[1]; ecL[tid] = R.psc[3]; } \
        { float o[8]; \
            float xin[11]; \
            _Pragma("unroll") for (int k = 0; k < 11; ++k) xin[k] = ((ck) * 64 + 8 * wave - 3 + k >= 0) ? bflo(R.xr[k]) : 0.f; \
            _Pragma("unroll") for (int e = 0; e < 8; ++e) o[e] = silu_f(xbs + xw0 * xin[e] + xw1 * xin[e + 1] + xw2 * xin[e + 2] + xw3 * xin[e + 3]); \
            v2u a, a2, s1, s2; a.x = pk2(o[0], o[1]); a.y = pk2(o[2], o[3]); a2.x = pk2(o[4], o[5]); a2.y = pk2(o[6], o[7]); \
            s1.x = pk2(o[0] * R.xwj[0], o[1] * R.xwj[1]); s1.y = pk2(o[2] * R.xwj[2], o[3] * R.xwj[3]); s2.x = pk2(o[4] * R.xwj[4], o[5] * R.xwj[5]); s2.y = pk2(o[6] * R.xwj[6], o[7] * R.xwj[7]); \
            *(LAS v2u*)(lds + XST + lane * PX + xpos * 2) = a; *(LAS v2u*)(lds + XST + lane * PX + (xpos + 8) * 2) = a2; \
            *(LAS v2u*)(lds + XSW + lane * PX + xpos * 2) = s1; *(LAS v2u*)(lds + XSW + lane * PX + (xpos + 8) * 2) = s2; } \
        const v2u zc0 = R.zz[0], zc1 = R.zz[1]; \
        __syncthreads();                                              \
        const int tok = rb + (ck) * 64 + 16 * it + r; \
        if ((ck) + 1 < 32) SSD_PREFETCH(R, (ck) + 1); \
        pg8::bf16x8 cf[4]; \
        _Pragma("unroll") for (int ks = 0; ks < 4; ++ks) cf[ks] = *(const LAS pg8::bf16x8*)(lds + CM + (16 * it + r) * PC + (32 * ks + 8 * c) * 2); \
        pg8::bf16x8 wf[2]; \
        if (it == 0) ssd_stage1<1>(lds, cf, cumL, dtL, r, c, Dh, wf); else if (it == 1) ssd_stage1<2>(lds, cf, cumL, dtL, r, c, Dh, wf); \
        else if (it == 2) ssd_stage1<3>(lds, cf, cumL, dtL, r, c, Dh, wf); else ssd_stage1<4>(lds, cf, cumL, dtL, r, c, Dh, wf); \
          \
        pg8::bf16x8 hfr[2][4], xfr[2][2]; \
        _Pragma("unroll") for (int pt = 0; pt < 2; ++pt) { \
            _Pragma("unroll") for (int ks = 0; ks < 4; ++ks) hfr[pt][ks] = *(const LAS pg8::bf16x8*)(lds + HB + (32 * ph + 16 * pt + r) * PC + (32 * ks + 8 * c) * 2); \
            _Pragma("unroll") for (int kk = 0; kk < 2; ++kk) xfr[pt][kk] = *(const LAS pg8::bf16x8*)(lds + XST + (32 * ph + 16 * pt + r) * PX + (32 * kk + 8 * c) * 2); } \
        const float eci = ecL[16 * it + r], etot = ecL[63]; \
        __builtin_amdgcn_sched_barrier(0); \
        f32x4 yt[2]; yt[0] = (f32x4){0.f, 0.f, 0.f, 0.f}; yt[1] = yt[0]; \
        _Pragma("unroll") for (int ks = 0; ks < 4; ++ks) \
            _Pragma("unroll") for (int pt = 0; pt < 2; ++pt) yt[pt] = __builtin_amdgcn_mfma_f32_16x16x32_bf16(hfr[pt][ks], cf[ks], yt[pt], 0, 0, 0); \
        yt[0] = yt[0] * eci; yt[1] = yt[1] * eci; \
        _Pragma("unroll") for (int kk = 0; kk < 2; ++kk) \
            _Pragma("unroll") for (int pt = 0; pt < 2; ++pt) yt[pt] = __builtin_amdgcn_mfma_f32_16x16x32_bf16(xfr[pt][kk], wf[kk], yt[pt], 0, 0, 0); \
        _Pragma("unroll") for (int pt = 0; pt < 2; ++pt) { \
            const v2u zq = pt ? zc1 : zc0; \
            const float z0 = bflo(zq.x), z1 = bfhi(zq.x), z2 = bflo(zq.y), z3 = bfhi(zq.y); \
            v2u w; w.x = pk2(yt[pt][0] * silu_f(z0), yt[pt][1] * silu_f(z1)); w.y = pk2(yt[pt][2] * silu_f(z2), yt[pt][3] * silu_f(z3)); \
            *(v2u*)(YG + (size_t)tok * DIN + h * 64 + 32 * ph + 16 * pt + 4 * c) = w; } \
        __builtin_amdgcn_sched_barrier(0); \
          \
        pg8::bf16x8 tfr[2], sfr[2][4]; \
        _Pragma("unroll") for (int kk = 0; kk < 2; ++kk) { tfr[kk] = *(const LAS pg8::bf16x8*)(lds + BMT + (16 * wave + r) * PX + (32 * kk + 8 * c) * 2); \
            _Pragma("unroll") for (int pt = 0; pt < 4; ++pt) sfr[kk][pt] = *(const LAS pg8::bf16x8*)(lds + XSW + (16 * pt + r) * PX + (32 * kk + 8 * c) * 2); } \
        __builtin_amdgcn_sched_barrier(0); \
        _Pragma("unroll") for (int pt = 0; pt < 4; ++pt) Ht[pt] = Ht[pt] * etot; \
        _Pragma("unroll") for (int kk = 0; kk < 2; ++kk) \
            _Pragma("unroll") for (int pt = 0; pt < 4; ++pt) Ht[pt] = __builtin_amdgcn_mfma_f32_16x16x32_bf16(tfr[kk], sfr[kk][pt], Ht[pt], 0, 0, 0); \
    } while (0)
    SSD_PREFETCH(R0, 0);
#pragma unroll 1
    for (int ck = 0; ck < 32; ++ck) { SSD_CHUNK(R0, ck); }
#undef SSD_CHUNK
#undef SSD_PREFETCH
    int r2 = r, c2 = c; asm volatile("" : "+v"(r2), "+v"(c2));
    float* so = A.out + O_SSM_P + li * (NBP * 32 * 8192) + (size_t)((b * 32 + h) * 64) * 128;
#pragma unroll
    for (int pt = 0; pt < 4; ++pt) *(f32x4*)(so + (size_t)(16 * pt + r2) * 128 + 16 * wave + 4 * c2) = Ht[pt];
    __syncthreads();
}

__device__ __forceinline__ void ssd_gatenorm_phase(const Args& A, int li, bf16* YG) {
    const int tid = threadIdx.x, lane = tid & 63, wave = __builtin_amdgcn_readfirstlane(tid >> 6);
    const int gw = blockIdx.x * NWAVES + wave, ngw = gridDim.x * NWAVES;
    const float* nrm = (const float*)A.in[I_SSMNORM] + li * DIN;
    for (int r0 = gw; r0 < MTOK; r0 += 2 * ngw) {
      v4u w2[2][4];
#pragma unroll
      for (int rr = 0; rr < 2; ++rr) { const int row = r0 + rr * ngw;
#pragma unroll
        for (int g = 0; g < 4; ++g) w2[rr][g] = (row < MTOK) ? *(const v4u*)(YG + (size_t)row * DIN + g * 512 + lane * 8) : (v4u){0u, 0u, 0u, 0u}; }
#pragma unroll
      for (int rr = 0; rr < 2; ++rr) { const int row = r0 + rr * ngw; if (row >= MTOK) break;
        v4u w[4];
#pragma unroll
        for (int g = 0; g < 4; ++g) w[g] = w2[rr][g];
#pragma unroll
        for (int g = 0; g < 4; ++g) {
            float v[8] = {bflo(w[g].x), bfhi(w[g].x), bflo(w[g].y), bfhi(w[g].y), bflo(w[g].z), bfhi(w[g].z), bflo(w[g].w), bfhi(w[g].w)};
            float q = 0.f;
#pragma unroll
            for (int e = 0; e < 8; ++e) q += v[e] * v[e];
            q = wave_sum(q); const float r = rsqrtf(q * (1.0f / 512.0f) + EPS);
            const f32x4 n0 = *(const f32x4*)(nrm + g * 512 + lane * 8), n1 = *(const f32x4*)(nrm + g * 512 + lane * 8 + 4);
            v4u o; o.x = pk2(v[0] * r * n0[0], v[1] * r * n0[1]); o.y = pk2(v[2] * r * n0[2], v[3] * r * n0[3]); o.z = pk2(v[4] * r * n1[0], v[5] * r * n1[1]); o.w = pk2(v[6] * r * n1[2], v[7] * r * n1[3]);
            *(v4u*)(YG + (size_t)row * DIN + g * 512 + lane * 8) = o;
        }
      }
    }
}

__device__ __forceinline__ float dot64_bb(const v4u (&q)[8], const bf16* krow) {
    const v4u* kp = (const v4u*)krow; float acc = 0.f;
#pragma unroll
    for (int i = 0; i < 8; ++i) { const v4u k = kp[i];
        acc += bflo(q[i].x) * bflo(k.x) + bfhi(q[i].x) * bfhi(k.x) + bflo(q[i].y) * bflo(k.y) + bfhi(q[i].y) * bfhi(k.y)
             + bflo(q[i].z) * bflo(k.z) + bfhi(q[i].z) * bfhi(k.z) + bflo(q[i].w) * bflo(k.w) + bfhi(q[i].w) * bfhi(k.w); }
    return acc;
}
__device__ __forceinline__ float dot64_bf(const v4u (&q)[8], const float* krow) {
    const f32x4* kp = (const f32x4*)krow; float acc = 0.f;
#pragma unroll
    for (int i = 0; i < 8; ++i) { const f32x4 k0 = kp[2 * i], k1 = kp[2 * i + 1];
        acc += bflo(q[i].x) * k0[0] + bfhi(q[i].x) * k0[1] + bflo(q[i].y) * k0[2] + bfhi(q[i].y) * k0[3]
             + bflo(q[i].z) * k1[0] + bfhi(q[i].z) * k1[1] + bflo(q[i].w) * k1[2] + bfhi(q[i].w) * k1[3]; }
    return acc;
}


__device__ __forceinline__ void swa_prompt_mfma(const Args& A, LAS unsigned char* lds) {
    const int tid = threadIdx.x, lane = tid & 63, wave = __builtin_amdgcn_readfirstlane(tid >> 6);
    const int gw = blockIdx.x * NWAVES + wave, ngw = gridDim.x * NWAVES, l31 = lane & 31, hh = lane >> 5;
    LAS float* tab = (LAS float*)(lds + 8192);
    const bf16* QS = (const bf16*)(A.ws + WS_QS); const bf16* KS = (const bf16*)(A.ws + WS_KS); const bf16* VTS = (const bf16*)(A.ws + WS_VTS); bf16* AO = (bf16*)(A.ws + WS_AO);
    float* LSE = (float*)(A.ws + WS_LSE);
    const float* relb = (const float*)A.in[I_RELB];
    const float LOG2E = 1.4426950408889634f, c1 = 0.125f * LOG2E;
    __syncthreads();
    for (int e = tid; e < 12 * 129; e += NTHR) { const int head = e / 129, n = e - head * 129; tab[head * 132 + n] = relb[rel_bucket(n << (2 * (head >> 2))) * 12 + head] * LOG2E; }
    __syncthreads();
    for (int task = gw; task < NBP * 12 * 64; task += ngw) {
        const int blk = task & 63, bhd = task >> 6, head = bhd % 12, b = bhd / 12, g = head >> 2, lg = 2 * g;
        const int ncb = 64 >> lg, cls = blk / ncb, qb = blk - cls * ncb, ncls = SEQ >> lg;
        const int qpos = 32 * qb + l31, qtok = b * SEQ + (qpos << lg) + cls;
        pg8::bf16x8 qf[4];
#pragma unroll
        for (int ks = 0; ks < 4; ++ks) qf[ks] = *(const pg8::bf16x8*)(QS + (size_t)qtok * SWAW + head * 64 + 16 * ks + 8 * hh);
        f32x16 o[2];
#pragma unroll
        for (int i = 0; i < 2; ++i)
#pragma unroll
            for (int r = 0; r < 16; ++r) o[i][r] = 0.f;
        float m_run = -INFINITY, l_run = 0.f;
        const bf16* vbase = VTS + (size_t)((b * 12 + head) * 64 + l31) * SEQ + cls * ncls + 8 * hh;
        const LAS float* tb = tab + head * 132;
        const int kt0 = qb >= 4 ? qb - 4 : 0;
        pg8::bf16x8 kf[4], vf[2][2];
#define SWA_LOAD(kt) do { const int ktok = b * SEQ + ((32 * (kt) + l31) << lg) + cls; \
            _Pragma("unroll") for (int ks = 0; ks < 4; ++ks) kf[ks] = *(const pg8::bf16x8*)(KS + (size_t)ktok * SWAW + head * 64 + 16 * ks + 8 * hh); \
            _Pragma("unroll") for (int dvt = 0; dvt < 2; ++dvt) _Pragma("unroll") for (int s2 = 0; s2 < 2; ++s2) vf[dvt][s2] = *(const pg8::bf16x8*)(vbase + (size_t)(dvt * 32) * SEQ + 32 * (kt) + 16 * s2); } while (0)
        SWA_LOAD(kt0);
        for (int kt = kt0; kt <= qb; ++kt) {
            f32x16 S;
#pragma unroll
            for (int r = 0; r < 16; ++r) S[r] = 0.f;
#pragma unroll
            for (int ks = 0; ks < 4; ++ks) S = __builtin_amdgcn_mfma_f32_32x32x16_bf16(kf[ks], qf[ks], S, 0, 0, 0);
            pg8::bf16x8 vc[2][2];
#pragma unroll
            for (int dvt = 0; dvt < 2; ++dvt)
#pragma unroll
                for (int s2 = 0; s2 < 2; ++s2) vc[dvt][s2] = vf[dvt][s2];
            if (kt < qb) SWA_LOAD(kt + 1);
            float mx = -INFINITY;
            if (kt < qb && (kt > qb - 4)) {
                const LAS float* tq = tb + (qpos - 32 * kt - 4 * hh);
#pragma unroll
                for (int r = 0; r < 16; ++r) { const float x = S[r] * c1 + tq[-((r & 3) + 8 * (r >> 2))]; S[r] = x; mx = fmaxf(mx, x); }
            } else {
#pragma unroll
                for (int r = 0; r < 16; ++r) { const int kq = 32 * kt + (r & 3) + 8 * (r >> 2) + 4 * hh, n = qpos - kq; const bool ok = (n >= 0) && (n <= 128);
                    const float x = ok ? S[r] * c1 + tb[ok ? n : 0] : -INFINITY; S[r] = x; mx = fmaxf(mx, x); }
            }
            mx = fmaxf(mx, __shfl_xor(mx, 32));
            const float m_new = (mx > m_run + 8.0f) ? mx : m_run;
            const bool moved = __builtin_amdgcn_ballot_w64(m_new != m_run) != 0ull;
            const float alpha = __builtin_amdgcn_exp2f(m_run - m_new);
            float rs = 0.f;
#pragma unroll
            for (int r = 0; r < 16; ++r) { const float pv = __builtin_amdgcn_exp2f(S[r] - m_new); S[r] = pv; rs += pv; }
            rs += __shfl_xor(rs, 32);
            l_run = l_run * alpha + rs; m_run = m_new;
            if (moved) {
#pragma unroll
                for (int i = 0; i < 2; ++i)
#pragma unroll
                    for (int r = 0; r < 16; ++r) o[i][r] *= alpha;
            }
#pragma unroll
            for (int s2 = 0; s2 < 2; ++s2) { const int r0 = 8 * s2;
                v4u w; w.x = pk2(S[r0], S[r0 + 1]); w.y = pk2(S[r0 + 2], S[r0 + 3]); w.z = pk2(S[r0 + 4], S[r0 + 5]); w.w = pk2(S[r0 + 6], S[r0 + 7]);
                const pg8::bf16x8 pf = __builtin_bit_cast(pg8::bf16x8, w);
#pragma unroll
                for (int dvt = 0; dvt < 2; ++dvt) o[dvt] = __builtin_amdgcn_mfma_f32_32x32x16_bf16(vc[dvt][s2], pf, o[dvt], 0, 0, 0); }
        }
#undef SWA_LOAD
        const float inv = 1.0f / l_run;
        bf16* orow = AO + (size_t)qtok * SWAW + head * 64;
#pragma unroll
        for (int i = 0; i < 2; ++i)
#pragma unroll
            for (int q4 = 0; q4 < 4; ++q4) { v2u w; w.x = pk2(o[i][4 * q4] * inv, o[i][4 * q4 + 1] * inv); w.y = pk2(o[i][4 * q4 + 2] * inv, o[i][4 * q4 + 3] * inv);
                *(v2u*)(orow + i * 32 + 8 * q4 + 4 * hh) = w; }
        if (hh == 0) LSE[(size_t)qtok * 12 + head] = (m_run + log2f(l_run)) * 0.6931471805599453f;
    }
    __syncthreads();
}

__device__ __forceinline__ void swa_combine_phase(const Args& A) {
    int tg = threadIdx.x; asm volatile("" : "+v"(tg)); const int gt = blockIdx.x * NTHR + tg, ngt = gridDim.x * NTHR;
    bf16* AO = (bf16*)(A.ws + WS_AO); const float* LSE = (const float*)(A.ws + WS_LSE);
    for (int task0 = gt; task0 < MP * 12 * 8; task0 += 4 * ngt) {
        v4u w[4]; float l0[4], l1[4], l2[4]; v4u* ptr[4]; int gq[4];
#pragma unroll
        for (int q = 0; q < 4; ++q) { const int task = task0 + q * ngt; ptr[q] = nullptr;
            if (task < MP * 12 * 8) { const int ch = task & 7, head = (task >> 3) % 12, tok = task / 96, j = head & 3; gq[q] = head >> 2;
                l0[q] = LSE[(size_t)tok * 12 + j]; l1[q] = LSE[(size_t)tok * 12 + 4 + j]; l2[q] = LSE[(size_t)tok * 12 + 8 + j];
                ptr[q] = (v4u*)(AO + (size_t)tok * SWAW + head * 64 + ch * 8); w[q] = *ptr[q]; } }
#pragma unroll
        for (int q = 0; q < 4; ++q) if (ptr[q]) {
            const float mm = fmaxf(fmaxf(l0[q], l1[q]), l2[q]), a0 = __expf(l0[q] - mm), a1 = __expf(l1[q] - mm), a2 = __expf(l2[q] - mm);
            const float al = (gq[q] == 0 ? a0 : (gq[q] == 1 ? a1 : a2)) * __builtin_amdgcn_rcpf(a0 + a1 + a2);
            v4u o; o.x = pk2(bflo(w[q].x) * al, bfhi(w[q].x) * al); o.y = pk2(bflo(w[q].y) * al, bfhi(w[q].y) * al); o.z = pk2(bflo(w[q].z) * al, bfhi(w[q].z) * al); o.w = pk2(bflo(w[q].w) * al, bfhi(w[q].w) * al);
            *ptr[q] = o; }
    }
}

__device__ __forceinline__ void swa_attn_phase(const Args& A, LAS unsigned char* lds) {
    const int tid = threadIdx.x, lane = tid & 63, wave = __builtin_amdgcn_readfirstlane(tid >> 6);
    const int gw = blockIdx.x * NWAVES + wave, ngw = gridDim.x * NWAVES;
    LAS float* pw = (LAS float*)lds + wave * 192;
    const bf16* QS = (const bf16*)(A.ws + WS_QS); const bf16* KS = (const bf16*)(A.ws + WS_KS); const bf16* VS = (const bf16*)(A.ws + WS_VS); bf16* AO = (bf16*)(A.ws + WS_AO);
    const float* relb = (const float*)A.in[I_RELB];
    swa_prompt_mfma(A, lds);
    constexpr int VPIT = 68;
    LAS float* vb = (LAS float*)(lds + 16384) + (wave < 3 ? wave : 0) * (129 * VPIT + 64);
    static_assert(16384 + 3 * (129 * VPIT + 64) * 4 <= RING_BYTES, "swa sample LDS map");
    const int G = gridDim.x;
    for (int task = (wave < 3) ? wave * G + (int)blockIdx.x : (1 << 30); task < MS * 4; task += 3 * G) {
        const int r = MP + (task >> 2), j = task & 3, b = (r - MP) >> 2, t = (r - MP) & 3;
        float og[3], lseg[3];
#pragma unroll
        for (int g = 0; g < 3; ++g) {
            const int head = g * 4 + j, dil = 1 << (2 * g), lb = 128 << (2 * g);
            const float* cache = (const float*)A.in[I_SWA0 + g];
            v4u qv[8];
#pragma unroll
            for (int i = 0; i < 8; ++i) qv[i] = ((const v4u*)(QS + (size_t)r * SWAW + head * 64))[i];
            float s[3];
#pragma unroll
            for (int kk = 0; kk < 3; ++kk) {
                const int n = lane + 64 * kk; float sc = -INFINITY;
                if (n <= 128) { const int idx = lb + t - n * dil; float d;
                    if (idx >= lb) d = dot64_bb(qv, KS + (size_t)(MP + b * 4 + idx - lb) * SWAW + head * 64);
                    else d = dot64_bf(qv, cache + ((size_t)((b * lb + idx) * 2 + 0) * 4 + j) * 64);
                    sc = d * 0.125f + relb[rel_bucket(n * dil) * 12 + head]; }
                s[kk] = sc;
            }
            const float mx = wave_max(fmaxf(fmaxf(s[0], s[1]), s[2]));
            float e[3];
#pragma unroll
            for (int kk = 0; kk < 3; ++kk) e[kk] = (s[kk] == -INFINITY) ? 0.f : __expf(s[kk] - mx);
            const float sum = wave_sum(e[0] + e[1] + e[2]), inv = 1.0f / sum;
            lseg[g] = mx + __logf(sum);
#pragma unroll
            for (int kk = 0; kk < 3; ++kk) {
                const int n = lane + 64 * kk;
                if (n <= 128) { const int idx = lb + t - n * dil; const float pn = e[kk] * inv; LAS f32x4* dst = (LAS f32x4*)(vb + n * VPIT);
                    if (idx >= lb) { const v4u* vp = (const v4u*)(VS + (size_t)(MP + b * 4 + idx - lb) * SWAW + head * 64);
#pragma unroll
                        for (int i = 0; i < 8; ++i) { const v4u w = vp[i]; dst[2 * i] = (f32x4){bflo(w.x) * pn, bfhi(w.x) * pn, bflo(w.y) * pn, bfhi(w.y) * pn}; dst[2 * i + 1] = (f32x4){bflo(w.z) * pn, bfhi(w.z) * pn, bflo(w.w) * pn, bfhi(w.w) * pn}; } }
                    else { const f32x4* vp = (const f32x4*)(cache + ((size_t)((b * lb + idx) * 2 + 1) * 4 + j) * 64);
#pragma unroll
                        for (int i = 0; i < 16; ++i) dst[i] = vp[i] * pn; } }
            }
            LDS_WAIT(); __builtin_amdgcn_wave_barrier();
            float o = 0.f;
#pragma unroll 43
            for (int n = 0; n <= 128; ++n) o += vb[n * VPIT + lane];
            og[g] = o;
            LDS_WAIT(); __builtin_amdgcn_wave_barrier();
        }
        const float mm = fmaxf(fmaxf(lseg[0], lseg[1]), lseg[2]);
        const float a0 = __expf(lseg[0] - mm), a1 = __expf(lseg[1] - mm), a2 = __expf(lseg[2] - mm), inv = 1.0f / (a0 + a1 + a2);
        AO[(size_t)r * SWAW + (0 * 4 + j) * 64 + lane] = (bf16)f2bf(og[0] * a0 * inv);
        AO[(size_t)r * SWAW + (1 * 4 + j) * 64 + lane] = (bf16)f2bf(og[1] * a1 * inv);
        AO[(size_t)r * SWAW + (2 * 4 + j) * 64 + lane] = (bf16)f2bf(og[2] * a2 * inv);
    }
}

__device__ __forceinline__ float diff_lambda(const float* lp, int lane, float lam_init) {
    const float s1 = wave_sum(lp[lane] * lp[64 + lane]), s2 = wave_sum(lp[128 + lane] * lp[192 + lane]);
    return __expf(s1) - __expf(s2) + lam_init;
}

__device__ __forceinline__ void diff_attn_prompt_phase(const Args& A, LAS unsigned char* lds, float lam_init) {
    const int tid = threadIdx.x, lane = tid & 63, wave = __builtin_amdgcn_readfirstlane(tid >> 6);
    const int gw = blockIdx.x * NWAVES + wave, ngw = gridDim.x * NWAVES;
    LAS float* pw = (LAS float*)lds + wave * 128;
    const bf16* QD = (const bf16*)(A.ws + WS_QD); const bf16* KD = (const bf16*)(A.ws + WS_KD); const bf16* VD = (const bf16*)(A.ws + WS_VD); bf16* AOD = (bf16*)(A.ws + WS_AOD);
    const float* relb = (const float*)A.in[I_RELB]; const float* onorm = (const float*)A.in[I_DON];
    const float lam = diff_lambda((const float*)A.in[I_DLAM], lane, lam_init);
    const float on0 = onorm[2 * lane], on1 = onorm[2 * lane + 1];
    for (int it = gw; it < NBP * 12 * SEQ; it += ngw) {
        const int hb = it % 96, i = it / 96; const int b = hb / 12, h = hb - b * 12, g = h / 3;
        const int row = b * SEQ + i;
        v4u q0[8], q1[8];
#pragma unroll
        for (int k = 0; k < 8; ++k) { q0[k] = ((const v4u*)(QD + (size_t)row * DQW + (h * 2 + 0) * 64))[k]; q1[k] = ((const v4u*)(QD + (size_t)row * DQW + (h * 2 + 1) * 64))[k]; }
        float m0 = -INFINITY, m1 = -INFINITY, l0 = 0.f, l1 = 0.f, o00 = 0.f, o01 = 0.f, o10 = 0.f, o11 = 0.f;
#pragma unroll 1
        for (int jb = 0; jb <= (i >> 6); ++jb) {
            const int jj = jb * 64 + lane; float s0 = -INFINITY, s1 = -INFINITY;
            if (jj <= i) { const bf16* krow = KD + (size_t)(b * SEQ + jj) * DKW + g * 128; const float bias = relb[rel_bucket(i - jj) * 12 + h];
                s0 = dot64_bb(q0, krow) * 0.125f + bias; s1 = dot64_bb(q1, krow + 64) * 0.125f + bias; }
            const float mn0 = fmaxf(m0, wave_max(s0)), mn1 = fmaxf(m1, wave_max(s1));
            const float c0 = __expf(m0 - mn0), c1 = __expf(m1 - mn1);
            const float p0 = (jj <= i) ? __expf(s0 - mn0) : 0.f, p1 = (jj <= i) ? __expf(s1 - mn1) : 0.f;
            l0 = l0 * c0 + wave_sum(p0); l1 = l1 * c1 + wave_sum(p1);
            o00 *= c0; o01 *= c0; o10 *= c1; o11 *= c1; m0 = mn0; m1 = mn1;
            pw[lane] = p0; pw[64 + lane] = p1;
            LDS_WAIT(); __builtin_amdgcn_wave_barrier();
            const int nv = (i - jb * 64 + 1) < 64 ? (i - jb * 64 + 1) : 64;
#pragma unroll 4
            for (int k = 0; k < nv; ++k) { const float pp0 = pw[k], pp1 = pw[64 + k];
                const unsigned vv = *(const unsigned*)(VD + (size_t)(b * SEQ + jb * 64 + k) * DKW + g * 128 + 2 * lane);
                const float v0 = bflo(vv), v1 = bfhi(vv);
                o00 += pp0 * v0; o01 += pp0 * v1; o10 += pp1 * v0; o11 += pp1 * v1; }
            LDS_WAIT(); __builtin_amdgcn_wave_barrier();
        }
        const float i0 = 1.0f / l0, i1 = 1.0f / l1;
        const float a0 = o00 * i0 - lam * o10 * i1, a1 = o01 * i0 - lam * o11 * i1;
        const float ssq = wave_sum(a0 * a0 + a1 * a1), rr = rsqrtf(ssq * (1.0f / 128.0f) + EPS) * (1.0f - lam_init);
        *(unsigned*)(AOD + (size_t)row * DQW + h * 128 + 2 * lane) = pk2(a0 * rr * on0, a1 * rr * on1);
    }
}

__device__ __forceinline__ void diff_attn_prompt_mfma(const Args& A, LAS unsigned char* lds, float lam_init, int cidx, int ncu) {
    const int tid = threadIdx.x, lane = tid & 63, wave = __builtin_amdgcn_readfirstlane(tid >> 6);
    const int l31 = lane & 31, hh = lane >> 5, rg = wave >> 1, m = wave & 1;
    constexpr int KPITCH = 272, VPITCH = 144, KT_BYTES = 64 * KPITCH, VT_BYTES = 128 * VPITCH, BUF_BYTES = KT_BYTES + VT_BYTES;
    constexpr int VB_OFF = 2 * KT_BYTES;
    constexpr int L1_OFF = 2 * KT_BYTES + 3 * VT_BYTES;
    constexpr int CP_OFF = L1_OFF + 1024, CP_STRIDE = 2208;
    static_assert(CP_OFF + 4 * CP_STRIDE * 4 <= RING_BYTES, "diff attention LDS map");
    LAS float* cpy = (LAS float*)(lds + CP_OFF);
    LAS float* ex = (LAS float*)lds;
    LAS float* exl = (LAS float*)(lds + L1_OFF);
    const bf16* QD = (const bf16*)(A.ws + WS_QD); const bf16* KD = (const bf16*)(A.ws + WS_KD); const bf16* VTD = (const bf16*)(A.ws + WS_VTD); bf16* AOD = (bf16*)(A.ws + WS_AOD);
    const float* relb = (const float*)A.in[I_RELB]; const float* onorm = (const float*)A.in[I_DON];
    const float lam = diff_lambda((const float*)A.in[I_DLAM], lane, lam_init);
    const float LOG2E = 1.4426950408889634f, c1 = 0.125f * LOG2E;
    const int c = cidx, Gd = ncu;
    if (DATT_PRIO && wave >= 4) __builtin_amdgcn_s_setprio(DATT_PRIO);
    for (int ui = 0; ; ++ui) {
        const int rnd = ui, base = rnd * Gd; const int k = (rnd & 1) ? base + (Gd - 1 - c) : base + c;
        if (base >= 1536) break;
        __syncthreads();
        if (k < 1536) {
        const int qblk = 15 - k / 96, bh = k % 96, b = bh / 12, h = bh - b * 12, g = h / 3;
        for (int i = tid; i < 2176; i += NTHR) { const int d = 2048 - i; cpy[i] = (d >= 0 && d < 2048) ? relb[rel_bucket(d) * 12 + h] * 8.0f : 0.f; }
        __syncthreads();
        for (int n = tid; n < 3 * 2176; n += NTHR) { const int sc = 1 + n / 2176, i = n - (sc - 1) * 2176; cpy[sc * CP_STRIDE + i] = (i >= sc) ? cpy[i - sc] : 0.f; }
        const int q_abs = qblk * 128 + rg * 32 + l31, row = b * SEQ + q_abs;
        pg8::bf16x8 qf[4];
#pragma unroll
        for (int ks = 0; ks < 4; ++ks) qf[ks] = *(const pg8::bf16x8*)(QD + (size_t)row * DQW + (h * 2 + m) * 64 + 16 * ks + 8 * hh);
        f32x16 o[4];
#pragma unroll
        for (int i = 0; i < 4; ++i)
#pragma unroll
            for (int r = 0; r < 16; ++r) o[i][r] = 0.f;
        float m_run = -INFINITY, l_run = 0.f;
        const float THRU = 8.0f / c1;
        const LAS float* cb = cpy + (l31 & 3) * CP_STRIDE + ((l31 & 3) + 2048 - q_abs + 4 * hh);
        const int ntiles = 2 * qblk + 2, my_last = 2 * qblk + (rg >> 1);
        const int kkey = tid >> 4, kc = tid & 15, vdv = tid >> 3, vc = tid & 7;
        const char* ksrc = (const char*)(KD + (size_t)(b * SEQ) * DKW + g * 128);
        const char* vsrc = (const char*)(VTD + (size_t)((b * 4 + g) * 128) * SEQ);
        const unsigned koff = (unsigned)((kkey * DKW + kc * 8) * 2), voff = (unsigned)((vdv * SEQ + vc * 8) * 2);
        const int kdst = kkey * KPITCH + kc * 16, vdst = VB_OFF + vdv * VPITCH + vc * 16;
        v4u sa0, sa1, sa2, sa3;
#define DA_LOAD(R0, R1, R2, R3, t) do { const char* ks2 = ksrc + (size_t)(t) * 64 * DKW * 2; const char* vs2 = vsrc + (t) * 128; \
            R0 = *(const v4u*)(ks2 + koff); R1 = *(const v4u*)(ks2 + (size_t)32 * DKW * 2 + koff); R2 = *(const v4u*)(vs2 + voff); R3 = *(const v4u*)(vs2 + (size_t)64 * SEQ * 2 + voff); } while (0)
#define DA_STORE(R0, R1, R2, R3, t, vo) do { LAS unsigned char* nk = lds + ((t) & 1) * KT_BYTES + kdst; LAS unsigned char* nv = lds + (vo) + vdst; \
            *(LAS v4u*)(nk) = R0; *(LAS v4u*)(nk + 32 * KPITCH) = R1; *(LAS v4u*)(nv) = R2; *(LAS v4u*)(nv + 64 * VPITCH) = R3; } while (0)
#define DA_PV(vo, KK0, KK1) do { LAS unsigned char* Vb = lds + VB_OFF + (vo); \
_Pragma("unroll") \
            for (int kk = KK0; kk < KK1; ++kk) \
_Pragma("unroll") \
                for (int dvt = 0; dvt < 4; ++dvt) { const pg8::bf16x8 a = *(const LAS pg8::bf16x8*)(Vb + (dvt * 32 + l31) * VPITCH + kk * 32 + hh * 16); \
                    o[dvt] = __builtin_amdgcn_mfma_f32_32x32x16_bf16(a, pfp[kk], o[dvt], 0, 0, 0); } \
        } while (0)
#define DA_COMPUTE(kt) do { \
                DA_PV(vo_prev, 0, 2);        \
                LAS unsigned char* Kb = lds + (kt & 1) * KT_BYTES; \
                const bool offdiag = kt * 64 + 63 <= qblk * 128 + rg * 32; \
                f32x16 S[2]; \
                if (offdiag) { \
                    const LAS float* cq = cb + kt * 64; \
_Pragma("unroll") \
                    for (int sub = 0; sub < 2; ++sub) \
_Pragma("unroll") \
                        for (int j = 0; j < 4; ++j) { const f32x4 t4 = *(const LAS f32x4*)(cq + sub * 32 + 8 * j); \
                            S[sub][4 * j] = t4[0]; S[sub][4 * j + 1] = t4[1]; S[sub][4 * j + 2] = t4[2]; S[sub][4 * j + 3] = t4[3]; } \
                } else { \
_Pragma("unroll") \
                    for (int sub = 0; sub < 2; ++sub) \
_Pragma("unroll") \
                        for (int r = 0; r < 16; ++r) S[sub][r] = 0.f; \
                } \
_Pragma("unroll") \
                for (int ks = 0; ks < 4; ++ks) \
_Pragma("unroll") \
                    for (int sub = 0; sub < 2; ++sub) { const pg8::bf16x8 a = *(const LAS pg8::bf16x8*)(Kb + (sub * 32 + l31) * KPITCH + m * 128 + ks * 32 + hh * 16); \
                        S[sub] = __builtin_amdgcn_mfma_f32_32x32x16_bf16(a, qf[ks], S[sub], 0, 0, 0); } \
                if (!offdiag) { \
_Pragma("unroll") \
                    for (int sub = 0; sub < 2; ++sub) \
_Pragma("unroll") \
                        for (int r = 0; r < 16; ++r) { const int key = kt * 64 + sub * 32 + (r & 3) + 8 * (r >> 2) + 4 * hh; const int d = q_abs - key; \
                            const float x = S[sub][r] + cpy[2048 - (d < 0 ? 0 : d)]; S[sub][r] = d < 0 ? -INFINITY : x; } \
                } \
                  \
                float mx0 = -INFINITY, mx1 = -INFINITY; \
_Pragma("unroll") \
                for (int r = 0; r < 16; ++r) { mx0 = fmaxf(mx0, S[0][r]); mx1 = fmaxf(mx1, S[1][r]); } \
                float mx = fmaxf(mx0, mx1); \
                mx = fmaxf(mx, __shfl_xor(mx, 32)); \
                const float m_new = (mx > m_run + THRU) ? mx : m_run; \
                const bool moved = __builtin_amdgcn_ballot_w64(m_new != m_run) != 0ull; \
                const float alpha = __builtin_amdgcn_exp2f((m_run - m_new) * c1); \
                const float nmc = -m_new * c1; \
                DA_PV(vo_prev, 2, 4); \
                float rs0 = 0.f, rs1 = 0.f; \
_Pragma("unroll") \
                for (int r = 0; r < 16; ++r) { const float p0 = __builtin_amdgcn_exp2f(__builtin_fmaf(S[0][r], c1, nmc)); S[0][r] = p0; rs0 += p0; \
                    const float p1 = __builtin_amdgcn_exp2f(__builtin_fmaf(S[1][r], c1, nmc)); S[1][r] = p1; rs1 += p1; } \
                float rs = rs0 + rs1; \
                rs += __shfl_xor(rs, 32); \
                l_run = l_run * alpha + rs; m_run = m_new; \
_Pragma("unroll") \
                for (int kk = 0; kk < 4; ++kk) { const int sub = kk >> 1, r0 = (kk & 1) * 8; \
                    v4u w; w.x = pk2(S[sub][r0], S[sub][r0 + 1]); w.y = pk2(S[sub][r0 + 2], S[sub][r0 + 3]); w.z = pk2(S[sub][r0 + 4], S[sub][r0 + 5]); w.w = pk2(S[sub][r0 + 6], S[sub][r0 + 7]); \
                    pfp[kk] = __builtin_bit_cast(pg8::bf16x8, w); } \
                if (moved) { \
_Pragma("unroll") \
                    for (int i = 0; i < 4; ++i) \
_Pragma("unroll") \
                        for (int r = 0; r < 16; ++r) o[i][r] *= alpha; \
                } \
        } while (0)
        pg8::bf16x8 pfp[4];
#pragma unroll
        for (int kk = 0; kk < 4; ++kk) pfp[kk] = __builtin_bit_cast(pg8::bf16x8, v4u{0u, 0u, 0u, 0u});
        int vo_prev = 0, vo_cur = 0, vo_next = VT_BYTES, vo_free = 2 * VT_BYTES;
        DA_LOAD(sa0, sa1, sa2, sa3, 0); DA_STORE(sa0, sa1, sa2, sa3, 0, 0);
        __syncthreads();
#pragma unroll 1
        for (int kt = 0; kt < ntiles; ++kt) {
            if (kt + 1 < ntiles) DA_LOAD(sa0, sa1, sa2, sa3, kt + 1);
            DA_COMPUTE(kt);
            if (kt + 1 < ntiles) DA_STORE(sa0, sa1, sa2, sa3, kt + 1, vo_next);
            { const int t = (kt == 0) ? vo_free : vo_prev; vo_prev = vo_cur; vo_cur = vo_next; vo_next = t; }
            __syncthreads();
        }
        DA_PV(vo_prev, 0, 4);
        __syncthreads();
#undef DA_PV
#undef DA_COMPUTE
#undef DA_LOAD
#undef DA_STORE
        const float inv_l = 1.0f / l_run;
        if (m == 1) {
#pragma unroll
            for (int i = 0; i < 4; ++i)
#pragma unroll
                for (int r = 0; r < 16; ++r) ex[(rg * 64 + i * 16 + r) * 64 + lane] = o[i][r] * inv_l;
        }
        __syncthreads();
        if (m == 0) {
            float ssq = 0.f; float lam2 = lam; asm volatile("" : "+v"(lam2));
#pragma unroll
            for (int i = 0; i < 4; ++i)
#pragma unroll
                for (int r = 0; r < 16; ++r) { const float a = o[i][r] * inv_l - lam2 * ex[(rg * 64 + i * 16 + r) * 64 + lane]; o[i][r] = a; ssq += a * a; }
            ssq += __shfl_xor(ssq, 32);
            const float rr = rsqrtf(ssq * (1.0f / 128.0f) + EPS) * (1.0f - lam_init);
            int hh4 = 4 * hh; asm volatile("" : "+v"(hh4)); const float* onb = onorm + hh4; bf16* orow = AOD + (size_t)row * DQW + h * 128 + hh4;
#pragma unroll
            for (int i = 0; i < 4; ++i)
#pragma unroll
                for (int q4 = 0; q4 < 4; ++q4) { const int dv0 = i * 32 + 8 * q4; const f32x4 on = *(const f32x4*)(onb + dv0);
                    v2u w; w.x = pk2(o[i][4 * q4] * rr * on[0], o[i][4 * q4 + 1] * rr * on[1]); w.y = pk2(o[i][4 * q4 + 2] * rr * on[2], o[i][4 * q4 + 3] * rr * on[3]);
                    *(v2u*)(orow + dv0) = w; }
        }
        }
    }
    if (DATT_PRIO) __builtin_amdgcn_s_setprio(0);
    __syncthreads();
    (void)exl;
}

__device__ __forceinline__ void diff_sample_partial_phase(const Args& A, LAS unsigned char* lds) {
    const int tid = threadIdx.x, lane = tid & 63, wave = __builtin_amdgcn_readfirstlane(tid >> 6);
    LAS float* qs = (LAS float*)lds;
    LAS float* sc = qs + 24 * 64;
    LAS float* ml = sc + 1024 * 24;
    LAS int* pg = (LAS int*)(ml + 32);
    const bf16* QD = (const bf16*)(A.ws + WS_QD); float* PART = (float*)(A.ws + WS_PART);
    const float* ck = (const float*)A.in[I_DCK]; const float* cv = (const float*)A.in[I_DCV]; const int* pt = (const int*)A.in[I_PT];
    const float* relb = (const float*)A.in[I_RELB];
    for (int u = blockIdx.x; u < 1024; u += gridDim.x) {
        const int b = u >> 5, g = (u >> 3) & 3, c = u & 7;
        __syncthreads();
        for (int e = tid; e < 24 * 64; e += NTHR) { const int qi = e >> 6, d = e & 63, m = qi / 12, tr = qi - m * 12, t = tr / 3, r = tr - t * 3;
            qs[e] = bf2f(QD[(size_t)(MP + b * 4 + t) * DQW + ((g * 3 + r) * 2 + m) * 64 + d]); }
        if (tid < 8) pg[tid] = pt[b * 64 + c * 8 + tid];
        __syncthreads();
        {
            const int phys = pg[wave];
#pragma unroll 1
            for (int ks = 0; ks < 2; ++ks) {
                const int slot = lane + 64 * ks;
                const float* kb = ck + ((size_t)(phys * 128 + slot) * 4 + g) * 128;
                float acc[24];
#pragma unroll
                for (int q = 0; q < 24; ++q) acc[q] = 0.f;
#pragma unroll 1
                for (int dc = 0; dc < 16; ++dc) {
                    const f32x4 k0 = *(const f32x4*)(kb + 4 * dc), k1 = *(const f32x4*)(kb + 64 + 4 * dc);
#pragma unroll
                    for (int q = 0; q < 12; ++q) { const f32x4 qa = *(const LAS f32x4*)(qs + q * 64 + 4 * dc), qb = *(const LAS f32x4*)(qs + (12 + q) * 64 + 4 * dc);
                        acc[q] += (qa[0] * k0[0] + qa[1] * k0[1]) + (qa[2] * k0[2] + qa[3] * k0[3]);
                        acc[12 + q] += (qb[0] * k1[0] + qb[1] * k1[1]) + (qb[2] * k1[2] + qb[3] * k1[3]); }
                }
                const int kpos = (c * 8 + wave) * 128 + slot, kl = wave * 128 + slot;
#pragma unroll
                for (int t = 0; t < 4; ++t) { const int bk = rel_bucket(PAST + t - kpos);
#pragma unroll
                    for (int r = 0; r < 3; ++r) { const float bias = relb[bk * 12 + g * 3 + r];
                        sc[kl * 24 + t * 3 + r] = acc[t * 3 + r] * 0.125f + bias; sc[kl * 24 + 12 + t * 3 + r] = acc[12 + t * 3 + r] * 0.125f + bias; } }
            }
        }
        __syncthreads();
        for (int qi = wave; qi < 24; qi += NWAVES) {
            float mx = -INFINITY;
            for (int k = lane; k < 1024; k += 64) mx = fmaxf(mx, sc[k * 24 + qi]);
            mx = wave_max(mx);
            float sm = 0.f;
            for (int k = lane; k < 1024; k += 64) { const float p = __expf(sc[k * 24 + qi] - mx); sc[k * 24 + qi] = p; sm += p; }
            sm = wave_sum(sm);
            if (lane == 0) { PART[((size_t)u * 24 + qi) * PART_STRIDE + 128] = mx; PART[((size_t)u * 24 + qi) * PART_STRIDE + 129] = sm; }
        }
        __syncthreads();
        {
            const int dv = tid & 127, qg = tid >> 7;
            float o[6] = {0.f, 0.f, 0.f, 0.f, 0.f, 0.f};
            for (int kl = 0; kl < 1024; ++kl) {
                const int phys = pg[kl >> 7], slot = kl & 127;
                const float v = cv[((size_t)(phys * 128 + slot) * 4 + g) * 128 + dv];
                const LAS f32x2* pp = (const LAS f32x2*)(sc + kl * 24 + qg * 6);
                const f32x2 pa = pp[0], pb = pp[1], pc = pp[2];
                o[0] += pa[0] * v; o[1] += pa[1] * v; o[2] += pb[0] * v; o[3] += pb[1] * v; o[4] += pc[0] * v; o[5] += pc[1] * v;
            }
#pragma unroll
            for (int q = 0; q < 6; ++q) PART[((size_t)u * 24 + qg * 6 + q) * PART_STRIDE + dv] = o[q];
        }
    }
}


__device__ __forceinline__ void diff_sample_partial_mfma(const Args& A, LAS unsigned char* lds, int cidx, int ncu) {
    int tid = threadIdx.x; asm volatile("" : "+v"(tid));
    const int lane = tid & 63, wave = __builtin_amdgcn_readfirstlane(tid >> 6);
    const int r = lane & 15, c4 = lane >> 4;
    LAS float* ow = (LAS float*)lds;
    static_assert(8 * 24 * 132 * 4 <= RING_BYTES, "diff sample LDS map");
    const bf16* QD = (const bf16*)(A.ws + WS_QD); float* PART = (float*)(A.ws + WS_PART);
    const float* ck = (const float*)A.in[I_DCK]; const float* cv = (const float*)A.in[I_DCV]; const int* pt = (const int*)A.in[I_PT];
    const float* relb = (const float*)A.in[I_RELB];
    const int tq = r / 3, rep = r - tq * 3;
    for (int u = cidx; u < 1024; u += ncu) {
        const int b = u >> 5, g = (u >> 3) & 3, cc = u & 7, head = g * 3 + rep;
        __syncthreads();
        pg8::bf16x8 qf[2][2];
#pragma unroll
        for (int m = 0; m < 2; ++m)
#pragma unroll
            for (int ks = 0; ks < 2; ++ks) { v4u w = (v4u){0u, 0u, 0u, 0u};
                if (r < 12) w = *(const v4u*)(QD + (size_t)(MP + b * 4 + tq) * DQW + (head * 2 + m) * 64 + 16 * c4 + 8 * ks);
                qf[m][ks] = __builtin_bit_cast(pg8::bf16x8, w); }
        const int phys = pt[b * 64 + cc * 8 + wave], page_start = (cc * 8 + wave) * 128;
        const float* kp = ck + (size_t)phys * 128 * 512 + g * 128 + (size_t)r * 512 + 16 * c4;
        const float* vp = cv + (size_t)phys * 128 * 512 + g * 128 + (size_t)(4 * c4) * 512 + 8 * r;
        const bool far = (PAST - (page_start + 127)) >= 2048;
        const float bfar = (r < 12) ? relb[31 * 12 + head] : 0.f;
        f32x4 oacc[2][8];
#pragma unroll
        for (int m = 0; m < 2; ++m)
#pragma unroll
            for (int d = 0; d < 8; ++d) oacc[m][d] = (f32x4){0.f, 0.f, 0.f, 0.f};
        float m_run0 = -INFINITY, m_run1 = -INFINITY, l_run0 = 0.f, l_run1 = 0.f;
#pragma unroll 1
        for (int sb = 0; sb < 4; ++sb) {
            f32x4 S[2][2];
#pragma unroll
            for (int tt = 0; tt < 2; ++tt) { const float* kr = kp + (size_t)(sb * 32 + tt * 16) * 512;
#pragma unroll
                for (int m = 0; m < 2; ++m) { S[m][tt] = (f32x4){0.f, 0.f, 0.f, 0.f};
#pragma unroll
                    for (int ks = 0; ks < 2; ++ks) { const f32x4 a = *(const f32x4*)(kr + m * 64 + 8 * ks), a2 = *(const f32x4*)(kr + m * 64 + 8 * ks + 4);
                        v4u w; w.x = pk2(a[0], a[1]); w.y = pk2(a[2], a[3]); w.z = pk2(a2[0], a2[1]); w.w = pk2(a2[2], a2[3]);
                        S[m][tt] = __builtin_amdgcn_mfma_f32_16x16x32_bf16(__builtin_bit_cast(pg8::bf16x8, w), qf[m][ks], S[m][tt], 0, 0, 0); } } }
            float bias[2][4];
#pragma unroll
            for (int tt = 0; tt < 2; ++tt)
#pragma unroll
                for (int q = 0; q < 4; ++q) { float bv = bfar;
                    if (!far) { const int kpos = page_start + sb * 32 + tt * 16 + 4 * c4 + q; bv = (r < 12) ? relb[rel_bucket(PAST + tq - kpos) * 12 + head] : 0.f; }
                    bias[tt][q] = bv; }
            pg8::bf16x8 pf[2];
#pragma unroll
            for (int m = 0; m < 2; ++m) {
                float mx = -INFINITY;
#pragma unroll
                for (int tt = 0; tt < 2; ++tt)
#pragma unroll
                    for (int q = 0; q < 4; ++q) { const float x = S[m][tt][q] * 0.125f + bias[tt][q]; S[m][tt][q] = x; mx = fmaxf(mx, x); }
                mx = fmaxf(mx, __shfl_xor(mx, 16)); mx = fmaxf(mx, __shfl_xor(mx, 32));
                const float m_old = m ? m_run1 : m_run0, m_new = fmaxf(m_old, mx), alpha = __expf(m_old - m_new);
                float rs = 0.f;
#pragma unroll
                for (int tt = 0; tt < 2; ++tt)
#pragma unroll
                    for (int q = 0; q < 4; ++q) { const float pv = __expf(S[m][tt][q] - m_new); S[m][tt][q] = pv; rs += pv; }
                rs += __shfl_xor(rs, 16); rs += __shfl_xor(rs, 32);
                if (m) { l_run1 = l_run1 * alpha + rs; m_run1 = m_new; } else { l_run0 = l_run0 * alpha + rs; m_run0 = m_new; }
#pragma unroll
                for (int d = 0; d < 8; ++d) oacc[m][d] = oacc[m][d] * alpha;
                v4u w; w.x = pk2(S[m][0][0], S[m][0][1]); w.y = pk2(S[m][0][2], S[m][0][3]); w.z = pk2(S[m][1][0], S[m][1][1]); w.w = pk2(S[m][1][2], S[m][1][3]);
                pf[m] = __builtin_bit_cast(pg8::bf16x8, w);
            }
            const float* vr = vp + (size_t)(sb * 32) * 512;
#pragma unroll
            for (int hf = 0; hf < 2; ++hf) {
                __builtin_amdgcn_sched_barrier(0);
                f32x4 vv[8];
#pragma unroll
                for (int jj = 0; jj < 8; ++jj) vv[jj] = *(const f32x4*)(vr + (size_t)(16 * (jj >> 2) + (jj & 3)) * 512 + 4 * hf);
#pragma unroll
                for (int d = 0; d < 4; ++d) { v4u w; w.x = pk2(vv[0][d], vv[1][d]); w.y = pk2(vv[2][d], vv[3][d]); w.z = pk2(vv[4][d], vv[5][d]); w.w = pk2(vv[6][d], vv[7][d]);
                    const pg8::bf16x8 vf = __builtin_bit_cast(pg8::bf16x8, w);
                    oacc[0][4 * hf + d] = __builtin_amdgcn_mfma_f32_16x16x32_bf16(vf, pf[0], oacc[0][4 * hf + d], 0, 0, 0);
                    oacc[1][4 * hf + d] = __builtin_amdgcn_mfma_f32_16x16x32_bf16(vf, pf[1], oacc[1][4 * hf + d], 0, 0, 0); }
                __builtin_amdgcn_sched_barrier(0);
            }
        }
        if (r < 12) {
#pragma unroll
            for (int m = 0; m < 2; ++m) { LAS float* dst = ow + (wave * 24 + m * 12 + r) * 132;
#pragma unroll
                for (int q = 0; q < 4; ++q) { *(LAS f32x4*)(dst + 32 * c4 + 8 * q) = (f32x4){oacc[m][0][q], oacc[m][1][q], oacc[m][2][q], oacc[m][3][q]};
                    *(LAS f32x4*)(dst + 32 * c4 + 8 * q + 4) = (f32x4){oacc[m][4][q], oacc[m][5][q], oacc[m][6][q], oacc[m][7][q]}; }
                if (c4 == 0) { dst[128] = m ? m_run1 : m_run0; dst[129] = m ? l_run1 : l_run0; } }
        }
        __syncthreads();
        for (int idx = tid; idx < 24 * 128; idx += NTHR) { const int qi = idx >> 7, dv = idx & 127;
            float M = -INFINITY;
#pragma unroll
            for (int w = 0; w < 8; ++w) M = fmaxf(M, ow[(w * 24 + qi) * 132 + 128]);
            float o = 0.f, L = 0.f;
#pragma unroll
            for (int w = 0; w < 8; ++w) { const float e = __expf(ow[(w * 24 + qi) * 132 + 128] - M); o += ow[(w * 24 + qi) * 132 + dv] * e; L += ow[(w * 24 + qi) * 132 + 129] * e; }
            PART[((size_t)u * 24 + qi) * PART_STRIDE + dv] = o;
            if (dv == 0) { PART[((size_t)u * 24 + qi) * PART_STRIDE + 128] = M; PART[((size_t)u * 24 + qi) * PART_STRIDE + 129] = L; }
        }
    }
    __syncthreads();
}

__device__ __forceinline__ void diff_sample_combine_phase(const Args& A, float lam_init) {
    const int tid = threadIdx.x, lane = tid & 63, wave = __builtin_amdgcn_readfirstlane(tid >> 6);
    const int gw = blockIdx.x * NWAVES + wave, ngw = gridDim.x * NWAVES;
    const bf16* QD = (const bf16*)(A.ws + WS_QD); const bf16* KD = (const bf16*)(A.ws + WS_KD); const bf16* VD = (const bf16*)(A.ws + WS_VD); bf16* AOD = (bf16*)(A.ws + WS_AOD);
    const float* PART = (const float*)(A.ws + WS_PART);
    const float* relb = (const float*)A.in[I_RELB]; const float* onorm = (const float*)A.in[I_DON];
    const float lam = diff_lambda((const float*)A.in[I_DLAM], lane, lam_init);
    const float on0 = onorm[2 * lane], on1 = onorm[2 * lane + 1];
    for (int it = gw; it < NBS * 4 * 12; it += ngw) {
        const int b = it / 48, rem = it - b * 48, g = rem / 12, tr = rem - g * 12, t = tr / 3, r = tr - t * 3, h = g * 3 + r;
        const int row = MP + b * 4 + t;
        float res[2][2];
#pragma unroll
        for (int m = 0; m < 2; ++m) {
            const int qi = m * 12 + tr;
            const float qd = bf2f(QD[(size_t)row * DQW + (h * 2 + m) * 64 + lane]);
            float sn[4];
#pragma unroll
            for (int t2 = 0; t2 < 4; ++t2) { const float kd = bf2f(KD[(size_t)(MP + b * 4 + t2) * DKW + (g * 2 + m) * 64 + lane]);
                const float d = wave_sum(qd * kd); sn[t2] = (t2 <= t) ? d * 0.125f + relb[rel_bucket(t - t2) * 12 + h] : -INFINITY; }
            float M = fmaxf(fmaxf(sn[0], sn[1]), fmaxf(sn[2], sn[3]));
            float mc[8];
#pragma unroll
            for (int c = 0; c < 8; ++c) { mc[c] = PART[((size_t)((b * 4 + g) * 8 + c) * 24 + qi) * PART_STRIDE + 128]; M = fmaxf(M, mc[c]); }
            float Lsum = 0.f, o0 = 0.f, o1 = 0.f;
#pragma unroll
            for (int c = 0; c < 8; ++c) { const float* pp = PART + ((size_t)((b * 4 + g) * 8 + c) * 24 + qi) * PART_STRIDE; const float w = __expf(mc[c] - M);
                Lsum += pp[129] * w; const f32x2 ov = *(const f32x2*)(pp + 2 * lane); o0 += ov[0] * w; o1 += ov[1] * w; }
#pragma unroll
            for (int t2 = 0; t2 < 4; ++t2) { if (t2 <= t) { const float w = __expf(sn[t2] - M); Lsum += w;
                const unsigned vv = *(const unsigned*)(VD + (size_t)(MP + b * 4 + t2) * DKW + g * 128 + 2 * lane); o0 += w * bflo(vv); o1 += w * bfhi(vv); } }
            const float inv = 1.0f / Lsum; res[m][0] = o0 * inv; res[m][1] = o1 * inv;
        }
        const float a0 = res[0][0] - lam * res[1][0], a1 = res[0][1] - lam * res[1][1];
        const float ssq = wave_sum(a0 * a0 + a1 * a1), rr = rsqrtf(ssq * (1.0f / 128.0f) + EPS) * (1.0f - lam_init);
        *(unsigned*)(AOD + (size_t)row * DQW + h * 128 + 2 * lane) = pk2(a0 * rr * on0, a1 * rr * on1);
    }
}

constexpr int N_PHASES = 27;
__global__ void __launch_bounds__(NTHR, 2) hybrid_fwd(Args args) {
    extern __shared__ __attribute__((aligned(16))) unsigned char lds_raw[];
    LAS unsigned char* lds = (LAS unsigned char*)lds_raw;
    const int tid = threadIdx.x;
    volatile LAS unsigned* MISC = (volatile LAS unsigned*)(lds + MISC_OFF);
    for (int u = tid; u < (LDS_BYTES - LDSCTL_OFF) / 4; u += NTHR) ((LAS unsigned*)(lds + LDSCTL_OFF))[u] = 0u;
    __syncthreads();
    unsigned char* ws = args.ws;
    XcdBarrier bar; bar.bar = (unsigned*)(ws + WS_CTL) + CW_BAR; bar.x = 0; bar.st = nullptr;
#if !MK_PER_PHASE
    bar = xcd_barrier_post((unsigned*)(ws + WS_CTL) + CW_BAR, MISC + 8);
#endif
    const int lo = args.ph_lo, hi = args.ph_hi, G = gridDim.x, bx = blockIdx.x;
#define IN(k) (lo <= (k) && (k) < hi)
#if MK_PER_PHASE
#define SEAM(k) do { } while (0)
#else
#define SEAM(k) do { if (IN((k) + 1)) xcd_barrier(bar); } while (0)
#endif
    float* SS = (float*)(ws + WS_SS);
    bf16* XB = (bf16*)(ws + WS_XB);
    const float lam_init2 = 0.47071301f;

#define GEMM_PHASE(EPI, E, Aptr, Bptr, Ncols, Kdim) do { pg8::Gemm g_{(const pg8::bf16_t*)(Aptr), (const pg8::bf16_t*)(Bptr), MP, (Ncols), (Kdim)}; pg8::StaticOrder S_; S_.init(MP, (Ncols), G, bx); \
        pg8::gemm_phase<EPI, pg8::StaticOrder, true, true>(lds, g_, S_, E); } while (0)

    int ph = 0;
    if (IN(0)) { for (int rep = 0; rep < REP_PRO; ++rep) { prologue_phase(args, lds); __syncthreads(); } SEAM(0); for (int rep = 0; rep < PROBE_BAR; ++rep) xcd_barrier(bar); }

#define SSD_LAYER(P, LI, SSIN, SSMID, FFL, SSOUT, FIN) \
    if (IN((P) + 0)) { EpiSsdIn E{(bf16*)(ws + WS_ZX), (float*)(ws + WS_DT), SS + (SSIN) * (MPAD * 16), (const float*)args.in[I_DTB] + (LI) * 32}; \
        if (PROBE_SSDIN) GEMM_PHASE(EpiSsdIn, E, XB, ws + WS_WSSDIN + (LI) * al4k(SZ_WSSDIN), ZXW, DM); GEMM_PHASE(EpiSsdIn, E, XB, ws + WS_WSSDIN + (LI) * al4k(SZ_WSSDIN), ZXW, DM); \
        sk_ssdin(args, (const bf16*)(ws + WS_WSSDIN + (LI) * al4k(SZ_WSSDIN)), SS + (SSIN) * (MPAD * 16), (const float*)args.in[I_DTB] + (LI) * 32, (64 * 20) % G); SEAM((P) + 0); } \
    if (IN((P) + 1)) { for (int rep = 0; rep < REP_PRE; ++rep) ssd_prepass_phase(args, (LI)); SEAM((P) + 1); } \
    if (IN((P) + 2)) { for (int rep = 0; rep < REP_SCAN; ++rep) { ssd_scan_phase(args, lds, (LI)); __syncthreads(); } SEAM((P) + 2); } \
    if (IN((P) + 3)) { ssd_gatenorm_phase(args, (LI), (bf16*)(ws + WS_YG)); if (PROBE_GN) ssd_gatenorm_phase(args, (LI), (bf16*)(ws + WS_ACT)); SEAM((P) + 3); } \
    if (IN((P) + 4)) { EpiRes E{XB, SS + (SSMID) * (MPAD * 16), nullptr, XB}; GEMM_PHASE(EpiRes, E, ws + WS_YG, ws + WS_WSSDOUT + (LI) * al4k(SZ_WSSDOUT), DM, DIN); \
        sk_res(args, (const bf16*)(ws + WS_YG), DIN, (const bf16*)(ws + WS_WSSDOUT + (LI) * al4k(SZ_WSSDOUT)), SS + (SSMID) * (MPAD * 16), nullptr, 0); SEAM((P) + 4); } \
    FFN_LAYER((P) + 5, FFL, SSMID, SSOUT, FIN)
#define FFN_LAYER(P, FFL, SSMID, SSOUT, FIN) \
    if (IN((P) + 0)) { EpiSwiGlu E{(bf16*)(ws + WS_ACT), SS + (SSMID) * (MPAD * 16)}; if (PROBE_FFIN == 1) { GEMM_PHASE(EpiSwiGlu, E, XB, ws + WS_WFFIN + (FFL) * al4k(SZ_WFFIN), 2 * DFF, DM); } if (PROBE_FFIN == 2) { EpiNone EN; GEMM_PHASE(EpiNone, EN, XB, ws + WS_WFFIN + (FFL) * al4k(SZ_WFFIN), 2 * DFF, DM); } GEMM_PHASE(EpiSwiGlu, E, XB, ws + WS_WFFIN + (FFL) * al4k(SZ_WFFIN), 2 * DFF, DM); \
        for (int rep = 0; rep < REP_SKSW; ++rep) sk_swiglu(args, (const bf16*)(ws + WS_WFFIN + (FFL) * al4k(SZ_WFFIN)), SS + (SSMID) * (MPAD * 16), (64 * 22) % G); for (int rep = 0; rep < REP_COPY; ++rep) cache_copy_slice(args, (FFL), 6, (64 * 22) % G); SEAM((P) + 0); } \
    if (IN((P) + 1)) { EpiRes E{XB, SS + ((SSOUT) & 7) * (MPAD * 16), (FIN) ? args.out : nullptr, XB}; if (PROBE_FFOUT) { EpiRes E2{XB, (float*)(ws + WS_ZX + ((size_t)96 << 20)), nullptr, (bf16*)(ws + WS_YG)}; GEMM_PHASE(EpiRes, E2, ws + WS_ACT, ws + WS_WFFOUT + (FFL) * al4k(SZ_WFFOUT), DM, DFF); } GEMM_PHASE(EpiRes, E, ws + WS_ACT, ws + WS_WFFOUT + (FFL) * al4k(SZ_WFFOUT), DM, DFF); \
        sk_res(args, (const bf16*)(ws + WS_ACT), DFF, (const bf16*)(ws + WS_WFFOUT + (FFL) * al4k(SZ_WFFOUT)), SS + ((SSOUT) & 7) * (MPAD * 16), (FIN) ? args.out : nullptr, 0); SEAM((P) + 1); }

    SSD_LAYER(1, 0, 0, 1, 0, 2, false)

    if (IN(8)) { EpiSwaQkv E{(bf16*)(ws + WS_QS), (bf16*)(ws + WS_KS), (bf16*)(ws + WS_VS), (bf16*)(ws + WS_VTS), SS + 2 * (MPAD * 16), (const float*)args.in[I_SWAQN], (const float*)args.in[I_SWAKN], args.out};
        if (PROBE_QKV) GEMM_PHASE(EpiSwaQkv, E, XB, ws + WS_WSWAQKV, 2304, DM); GEMM_PHASE(EpiSwaQkv, E, XB, ws + WS_WSWAQKV, 2304, DM); sk_swaqkv(args, (const bf16*)(ws + WS_WSWAQKV), SS + 2 * (MPAD * 16), (64 * 9) % G); cache_copy_slice(args, 4, 6, (64 * 9) % G); SEAM(8); }
    if (IN(9)) { for (int rep = 0; rep < REP_SWA; ++rep) { swa_attn_phase(args, lds); __syncthreads(); } SEAM(9); }
    if (IN(10)) { swa_combine_phase(args); SEAM(10); }
    if (IN(11)) { EpiRes E{XB, SS + 3 * (MPAD * 16), nullptr, XB}; GEMM_PHASE(EpiRes, E, ws + WS_AO, ws + WS_WSWAOUT, DM, SWAW); sk_res(args, (const bf16*)(ws + WS_AO), SWAW, (const bf16*)(ws + WS_WSWAOUT), SS + 3 * (MPAD * 16), nullptr, 0); SEAM(11); }
    FFN_LAYER(12, 1, 3, 4, false)

    if (IN(14)) { EpiDiffQkv E{(bf16*)(ws + WS_QD), (bf16*)(ws + WS_KD), (bf16*)(ws + WS_VD), (bf16*)(ws + WS_VTD), SS + 4 * (MPAD * 16), (const float*)args.in[I_DQN], (const float*)args.in[I_DKN], args.out};
        if (PROBE_QKV) GEMM_PHASE(EpiDiffQkv, E, XB, ws + WS_WDQKV, 2560, DM); GEMM_PHASE(EpiDiffQkv, E, XB, ws + WS_WDQKV, 2560, DM); sk_diffqkv(args, (const bf16*)(ws + WS_WDQKV), SS + 4 * (MPAD * 16), (64 * 10) % G); cache_copy_slice(args, 5, 6, (64 * 10) % G); SEAM(14); }
    if (IN(15)) {
        if (DIFF_PARTITION && G % 32 == 0) { const int grp = bx >> 3, xl = bx & 7;
            if ((grp & 3) == 0) diff_sample_partial_mfma(args, lds, (grp >> 2) * 8 + xl, G / 4);
            else diff_attn_prompt_mfma(args, lds, lam_init2, ((grp >> 2) * 3 + (grp & 3) - 1) * 8 + xl, G - G / 4); }
        else { diff_attn_prompt_mfma(args, lds, lam_init2, bx, G); if (REP_DATT > 1) diff_attn_prompt_mfma(args, lds, lam_init2, bx, G); diff_sample_partial_mfma(args, lds, bx, G); if (REP_DSMP > 1) diff_sample_partial_mfma(args, lds, bx, G); }
        SEAM(15); }
    if (IN(16)) { diff_sample_combine_phase(args, lam_init2); SEAM(16); }
    if (IN(17)) { EpiRes E{XB, SS + 5 * (MPAD * 16), nullptr, XB}; GEMM_PHASE(EpiRes, E, ws + WS_AOD, ws + WS_WDOUT, DM, DQW); sk_res(args, (const bf16*)(ws + WS_AOD), DQW, (const bf16*)(ws + WS_WDOUT), SS + 5 * (MPAD * 16), nullptr, 0); SEAM(17); }
    FFN_LAYER(18, 2, 5, 6, false)

    SSD_LAYER(20, 1, 6, 7, 3, 8, true)
    (void)ph;
#undef IN
#undef SEAM
}

extern "C" void kernel_launch(void* const* d_in, const int* in_sizes, int n_in, void* d_out, int out_size, void* d_ws, size_t ws_size, hipStream_t stream) {
    static int grid = 0;
    if (grid == 0) {
        if (n_in != N_IN || out_size != O_TOTAL || ws_size < WS_END) { fprintf(stderr, "kernel_launch: unexpected shapes: n_in %d out %d ws %zu (need %zu)\n", n_in, out_size, ws_size, (size_t)WS_END); grid = -1; return; }
        int dev = 0, cus = 0, per_cu = 0;
        if (hipGetDevice(&dev) != hipSuccess || hipDeviceGetAttribute(&cus, hipDeviceAttributeMultiprocessorCount, dev) != hipSuccess) { grid = -1; return; }
        if (hipFuncSetAttribute((const void*)hybrid_fwd, hipFuncAttributeMaxDynamicSharedMemorySize, LDS_BYTES) != hipSuccess) { fprintf(stderr, "kernel_launch: hipFuncSetAttribute failed\n"); grid = -1; return; }
        if (hipOccupancyMaxActiveBlocksPerMultiprocessor(&per_cu, (const void*)hybrid_fwd, NTHR, LDS_BYTES) != hipSuccess || per_cu < 1) fprintf(stderr, "kernel_launch: occupancy query says %d\n", per_cu);
        (void)hipGetLastError();
        grid = cus;
    }
    if (grid < 0) return;
    if (hipMemsetAsync((char*)d_ws + WS_CTL, 0, WS_ZERO_BYTES, stream) != hipSuccess) { fprintf(stderr, "kernel_launch: memset failed\n"); return; }
    Args a{};
    for (int i = 0; i < N_IN; ++i) a.in[i] = d_in[i];
    a.out = (float*)d_out; a.ws = (unsigned char*)d_ws;
#if MK_PER_PHASE
    for (int p = 0; p < N_PHASES; ++p) { a.ph_lo = p; a.ph_hi = p + 1; hipLaunchKernelGGL(hybrid_fwd, dim3(grid), dim3(NTHR), LDS_BYTES, stream, a); }
#else
    a.ph_lo = 0; a.ph_hi = N_PHASES; hipLaunchKernelGGL(hybrid_fwd, dim3(grid), dim3(NTHR), LDS_BYTES, stream, a);
#endif
    const hipError_t le = hipPeekAtLastError();
    if (le != hipSuccess) fprintf(stderr, "kernel_launch: launch failed: %s\n", hipGetErrorName(le));
}
```

```cpp
#include <hip/hip_runtime.h>
#include <cstdio>
#include <cstdint>
#ifndef MK_PER_PHASE
#define MK_PER_PHASE 0
#endif
#ifndef REP_PRO
#define REP_PRO 1
#endif
#ifndef REP_SCAN
#define REP_SCAN 1
#endif
#ifndef REP_FFIN
#define REP_FFIN 1
#endif
#ifndef REP_SWA
#define REP_SWA 1
#endif
#ifndef REP_DATT
#define REP_DATT 1
#endif
#ifndef REP_DSMP
#define REP_DSMP 1
#endif
#ifndef REP_SCANP
#define REP_SCANP 1
#endif
#ifndef REP_SCANS
#define REP_SCANS 1
#endif
#ifndef REP_PRE
#define REP_PRE 1
#endif
#ifndef PROBE_FFIN
#define PROBE_FFIN 0
#endif
#ifndef REP_SKSW
#define REP_SKSW 1
#endif
#ifndef REP_COPY
#define REP_COPY 1
#endif
#ifndef PROBE_GN
#define PROBE_GN 0
#endif
#ifndef PROBE_FFOUT
#define PROBE_FFOUT 0
#endif
#ifndef DIFF_PARTITION
#define DIFF_PARTITION 0
#endif
#ifndef PROBE_BAR
#define PROBE_BAR 0
#endif
#ifndef PROBE_SSDIN
#define PROBE_SSDIN 0
#endif
#ifndef PROBE_QKV
#define PROBE_QKV 0
#endif
#ifndef PROBE_SST
#define PROBE_SST 0
#endif
#ifndef PROBE_SCANBAR
#define PROBE_SCANBAR 0
#endif
#ifndef PROBE_SCANT
#define PROBE_SCANT 0
#endif
#ifndef PROBE_DAT
#define PROBE_DAT 0
#endif
#ifndef DATT_XCD
#define DATT_XCD 1
#endif
#ifndef DATT_PRIO
#define DATT_PRIO 0
#endif
#ifndef PROBE_DAS
#define PROBE_DAS 0
#endif
#ifndef PROBE_SS
#define PROBE_SS 0
#endif
#ifndef PROBE_SKR
#define PROBE_SKR 0
#endif
namespace pg8 {
#define PG8_LAS __attribute__((address_space(3)))
typedef unsigned short bf16_t;
typedef short bf16x8 __attribute__((ext_vector_type(8)));
typedef float f32x4 __attribute__((ext_vector_type(4)));
typedef unsigned u32x4 __attribute__((ext_vector_type(4)));
constexpr int BM = 256, BK = 64, HALF = 128, HTB = HALF * BK * 2  , STAGE_BYTES = 8 * HTB, NXCD = 8, WGM = 8;

__host__ __device__ __forceinline__ int lds_byte(int r, int c) { const int st = (r >> 4) * 2 + (c >> 5), rr = r & 15, cc = c & 31, ob = rr * 64 + cc * 2; return st * 1024 + (ob ^ (((ob >> 9) & 1) << 5)); }
__host__ __device__ __forceinline__ void stage_rc(int b, int& R, int& C) { const int st = b / 1024, sb = b % 1024, swz = sb ^ (((sb >> 9) & 1) << 5); R = (st >> 1) * 16 + swz / 64; C = (st & 1) * 32 + (swz % 64) / 2; }
__host__ __device__ __forceinline__ int perm32(int rho) { const int n = rho >> 4, i = rho & 15; return 8 * (i >> 2) + 4 * n + (i & 3); }

struct Unit { int pm, pn; };
struct Gemm { const bf16_t* A; const bf16_t* Bt; int M, N, K; };

struct StaticOrder {
    int nM, nN, nwg, G, c;
    __host__ __device__ void init(int M, int N, int G_, int c_) { nM = M / BM; nN = N / BM; nwg = nM * nN; G = G_; c = c_; }
    __host__ __device__ bool next(int i, Unit& u) const {
        const long L = (long)i * G + c; if (L >= nwg) return false;
        int wgid = (int)L; { const int q = nwg / NXCD, r = nwg % NXCD, xcd = wgid % NXCD, off = wgid / NXCD; wgid = (xcd < r ? xcd * (q + 1) : r * (q + 1) + (xcd - r) * q) + off; }
        const int nig = WGM * nN, gid = wgid / nig, fm = gid * WGM, gsz = (nM - fm) < WGM ? (nM - fm) : WGM;
        u.pm = fm + ((wgid % nig) % gsz); u.pn = (wgid % nig) / gsz; return true;
    }
    __device__ __forceinline__ void a_ready(const Unit&) const {}
    __device__ __forceinline__ void done(const Unit&) const {}
};

__device__ __forceinline__ unsigned cvt_pk_bf16(float lo, float hi) { unsigned r; asm volatile("v_cvt_pk_bf16_f32 %0, %1, %2" : "=v"(r) : "v"(lo), "v"(hi)); return r; }
template <class Epi, class Sched, bool ALIGN_EPI = false, bool SP2 = false>
__device__ __forceinline__ void gemm_phase(PG8_LAS unsigned char* lds, const Gemm g, const Sched& S, const Epi& E) {
    const int tid = threadIdx.x, wid = __builtin_amdgcn_readfirstlane(tid >> 6), lane = tid & 63, wr = wid >> 2, wc = wid & 3, fr = lane & 15, fq = lane >> 4;
    const int K = g.K, nt = K / BK;
    unsigned voffA[2], voffB[2];
#pragma unroll
    for (int i = 0; i < 2; ++i) { int R, C; stage_rc(tid * 16 + i * 8192, R, C); const int Rb = Epi::PERM ? ((R & ~31) + perm32(R & 31)) : R;
        voffA[i] = (unsigned)(R * K + C) * 2u; voffB[i] = (unsigned)(Rb * K + C) * 2u; }
    const size_t kstep = (size_t)(BK * 2);
    const size_t hstep = (size_t)HALF * K * 2;
    const size_t tstep = 2 * hstep;
    const unsigned ldsw = (unsigned)wid * 1024u;
    const int aoff = lds_byte(wr * 64 + fr, fq * 8), boff = lds_byte(wc * 32 + fr, fq * 8);
#define PG8_SA(b, h) (((b) * 2 + (h)) * HTB)
#define PG8_SB(b, h) ((4 + (b) * 2 + (h)) * HTB)
#define PG8_STAGE(bufoff, gbase, voff) do { _Pragma("unroll") for (int _i = 0; _i < 2; ++_i) \
        __builtin_amdgcn_global_load_lds((const unsigned*)((const char*)(gbase) + (voff)[_i]), (PG8_LAS unsigned*)(lds + (bufoff) + ldsw + _i * 8192), 16, 0, 0); } while (0)
#define PG8_LDA(dst, b, h) do { _Pragma("unroll") for (int m = 0; m < 4; ++m) _Pragma("unroll") for (int k = 0; k < 2; ++k) dst[m][k] = *(const PG8_LAS bf16x8*)(lds + PG8_SA(b, h) + aoff + m * 2048 + k * 1024); } while (0)
#define PG8_LDB(dst, b, h) do { _Pragma("unroll") for (int n = 0; n < 2; ++n) _Pragma("unroll") for (int k = 0; k < 2; ++k) dst[n][k] = *(const PG8_LAS bf16x8*)(lds + PG8_SB(b, h) + boff + n * 2048 + k * 1024); } while (0)
#define PG8_MMA(ai, bj, At, Bt) do { __builtin_amdgcn_s_setprio(1); _Pragma("unroll") for (int m = 0; m < 4; ++m) _Pragma("unroll") for (int n = 0; n < 2; ++n) _Pragma("unroll") for (int k = 0; k < 2; ++k) \
        acc[ai][bj][m][n] = __builtin_amdgcn_mfma_f32_16x16x32_bf16(Bt[n][k], At[m][k], acc[ai][bj][m][n], 0, 0, 0); __builtin_amdgcn_s_setprio(0); } while (0)
#define PG8_WAIT_V(n) asm volatile("s_waitcnt vmcnt(" #n ")" ::: "memory")
#define PG8_WAIT_L(n) asm volatile("s_waitcnt lgkmcnt(" #n ")" ::: "memory")
#define PG8_BAR __builtin_amdgcn_s_barrier()
#define PG8_SCHED __builtin_amdgcn_sched_barrier(0)
    Unit cur, nxt; int ui = 0;
    if (!S.next(0, cur)) return;
    f32x4 acc[2][2][4][2];
#pragma unroll
    for (int a = 0; a < 2; ++a)
#pragma unroll
        for (int b = 0; b < 2; ++b)
#pragma unroll
            for (int m = 0; m < 4; ++m)
#pragma unroll
                for (int n = 0; n < 2; ++n) acc[a][b][m][n] = (f32x4){0.f, 0.f, 0.f, 0.f};
    bf16x8 At[4][2], B0[2][2], B1[2][2];
    const char* cA = (const char*)g.A + (size_t)cur.pm * tstep; const char* cB = (const char*)g.Bt + (size_t)cur.pn * tstep;
    S.a_ready(cur);
    if constexpr (SP2) {
        PG8_STAGE(PG8_SB(0, 0), cB, voffB); PG8_STAGE(PG8_SB(0, 1), cB + hstep, voffB); PG8_STAGE(PG8_SA(0, 0), cA, voffA); PG8_STAGE(PG8_SA(0, 1), cA + hstep, voffA);
        if (wr == 1) PG8_BAR;
        PG8_WAIT_V(2); PG8_BAR;
        PG8_STAGE(PG8_SB(1, 0), cB + kstep, voffB); PG8_STAGE(PG8_SA(1, 0), cA + kstep, voffA); PG8_STAGE(PG8_SB(1, 1), cB + hstep + kstep, voffB);
        PG8_WAIT_V(6); PG8_BAR;
    } else {
        PG8_STAGE(PG8_SB(0, 0), cB, voffB); PG8_STAGE(PG8_SA(0, 0), cA, voffA); PG8_STAGE(PG8_SB(0, 1), cB + hstep, voffB); PG8_STAGE(PG8_SA(0, 1), cA + hstep, voffA);
        if (wr == 1) PG8_BAR;
        PG8_WAIT_V(4); PG8_BAR;
        PG8_STAGE(PG8_SB(1, 0), cB + kstep, voffB); PG8_STAGE(PG8_SA(1, 0), cA + kstep, voffA); PG8_STAGE(PG8_SB(1, 1), cB + hstep + kstep, voffB);
        PG8_WAIT_V(6); PG8_BAR;
    }
    for (;;) {
        const bool has_next = S.next(ui + 1, nxt);
        const char* nA = has_next ? (const char*)g.A + (size_t)nxt.pm * tstep : cA; const char* nB = has_next ? (const char*)g.Bt + (size_t)nxt.pn * tstep : cB;
        for (int t = 0; t < nt; t += 2) {
            const bool last = (t == nt - 2);
            const char* a1 = cA + (size_t)(t + 1) * kstep;
            const char* a2 = last ? nA : cA + (size_t)(t + 2) * kstep; const char* b2 = last ? nB : cB + (size_t)(t + 2) * kstep;
            const char* a3 = a2 + kstep; const char* b3 = b2 + kstep;
            if (last && has_next) S.a_ready(nxt);
            if constexpr (SP2) {
            PG8_LDB(B0, 0, 0); PG8_LDB(B1, 0, 1); PG8_SCHED; PG8_LDA(At, 0, 0); PG8_STAGE(PG8_SA(1, 1), a1 + hstep, voffA);
            PG8_WAIT_V(8); PG8_WAIT_L(0); PG8_BAR; PG8_MMA(0, 0, At, B0); PG8_MMA(0, 1, At, B1); PG8_BAR; PG8_SCHED;
            PG8_LDA(At, 0, 1); PG8_STAGE(PG8_SB(0, 0), b2, voffB); PG8_STAGE(PG8_SB(0, 1), b2 + hstep, voffB); PG8_STAGE(PG8_SA(0, 0), a2, voffA);
            PG8_WAIT_V(8); PG8_WAIT_L(0); PG8_BAR; PG8_MMA(1, 0, At, B0); PG8_MMA(1, 1, At, B1); PG8_BAR; PG8_SCHED;
            PG8_LDB(B0, 1, 0); PG8_LDB(B1, 1, 1); PG8_SCHED; PG8_LDA(At, 1, 0); PG8_STAGE(PG8_SA(0, 1), a2 + hstep, voffA);
            PG8_WAIT_V(8); PG8_WAIT_L(0); PG8_BAR; PG8_MMA(0, 0, At, B0); PG8_MMA(0, 1, At, B1); PG8_BAR; PG8_SCHED;
            PG8_LDA(At, 1, 1); PG8_STAGE(PG8_SB(1, 0), b3, voffB); PG8_STAGE(PG8_SB(1, 1), b3 + hstep, voffB); PG8_STAGE(PG8_SA(1, 0), a3, voffA);
            PG8_WAIT_V(8); PG8_WAIT_L(0); PG8_BAR; PG8_MMA(1, 0, At, B0); PG8_MMA(1, 1, At, B1); PG8_BAR; PG8_SCHED;
            } else {
            PG8_LDB(B0, 0, 0); PG8_SCHED; PG8_LDA(At, 0, 0); PG8_STAGE(PG8_SA(1, 1), a1 + hstep, voffA);
            PG8_WAIT_L(8); PG8_BAR; PG8_WAIT_L(0); PG8_MMA(0, 0, At, B0); PG8_BAR; PG8_SCHED;
            PG8_LDB(B1, 0, 1); PG8_STAGE(PG8_SB(0, 0), b2, voffB);
            PG8_BAR; PG8_WAIT_L(0); PG8_MMA(0, 1, At, B1); PG8_BAR;
            PG8_LDA(At, 0, 1); PG8_STAGE(PG8_SA(0, 0), a2, voffA);
            PG8_BAR; PG8_WAIT_L(0); PG8_MMA(1, 0, At, B0); PG8_BAR; PG8_SCHED;
            PG8_STAGE(PG8_SB(0, 1), b2 + hstep, voffB);
            PG8_WAIT_V(6); PG8_BAR; PG8_MMA(1, 1, At, B1); PG8_BAR;
            PG8_LDB(B0, 1, 0); PG8_SCHED; PG8_LDA(At, 1, 0); PG8_STAGE(PG8_SA(0, 1), a2 + hstep, voffA);
            PG8_WAIT_L(8); PG8_BAR; PG8_WAIT_L(0); PG8_MMA(0, 0, At, B0); PG8_BAR; PG8_SCHED;
            PG8_LDB(B1, 1, 1); PG8_STAGE(PG8_SB(1, 0), b3, voffB);
            PG8_BAR; PG8_WAIT_L(0); PG8_MMA(0, 1, At, B1); PG8_BAR;
            PG8_LDA(At, 1, 1); PG8_STAGE(PG8_SA(1, 0), a3, voffA);
            PG8_BAR; PG8_WAIT_L(0); PG8_MMA(1, 0, At, B0); PG8_BAR; PG8_SCHED;
            PG8_STAGE(PG8_SB(1, 1), b3 + hstep, voffB);
            PG8_WAIT_V(6); PG8_BAR; PG8_MMA(1, 1, At, B1); PG8_BAR;
            }
        }
        if constexpr (ALIGN_EPI) { if (wr == 0) PG8_BAR; }
        if constexpr (!Epi::AFTER_DRAIN) { E(acc, cur, wr, wc, fr, fq); S.done(cur); }
        if (!has_next) break;
#pragma unroll
        for (int a = 0; a < 2; ++a)
#pragma unroll
            for (int b = 0; b < 2; ++b)
#pragma unroll
                for (int m = 0; m < 4; ++m)
#pragma unroll
                    for (int n = 0; n < 2; ++n) acc[a][b][m][n] = (f32x4){0.f, 0.f, 0.f, 0.f};
        cur = nxt; cA = nA; cB = nB; ++ui;
        if constexpr (ALIGN_EPI) { if (wr == 1) PG8_BAR; }
    }
    PG8_WAIT_V(0);
    if constexpr (!ALIGN_EPI) { if (wr == 0) PG8_BAR; }
    PG8_BAR;
    if constexpr (Epi::AFTER_DRAIN) { E.fused(acc, cur, wr, wc, fr, fq, lds, wid, lane); S.done(cur); }
#undef PG8_SA
#undef PG8_SB
#undef PG8_STAGE
#undef PG8_LDA
#undef PG8_LDB
#undef PG8_MMA
#undef PG8_WAIT_V
#undef PG8_WAIT_L
#undef PG8_BAR
#undef PG8_SCHED
}
}

constexpr int DM = 1024, SEQ = 2048, NBP = 8, NBS = 32, TS = 4, PAST = 8192;
constexpr int MP = NBP * SEQ;
constexpr int MS = NBS * TS;
constexpr int MTOK = MP + MS;
constexpr int MPAD = 16640;
constexpr int DFF = 2816, DIN = 2048, CONVD = 3072, ZXW = 5120, SSMN = 5152, SSMNP = 5376;
constexpr int SWAW = 768, DQW = 1536, DKW = 512;
constexpr float EPS = 1e-6f;
constexpr int NWAVES = 8, NTHR = 512;

enum { I_XP = 0, I_XS, I_CONVST, I_SSMST, I_SWA0, I_SWA1, I_SWA2, I_DCK, I_DCV, I_PT, I_RELB, I_NMIX, I_NFFN, I_FFIN, I_FFOUT,
       I_SSMWIN, I_CONVW, I_CONVB, I_DTB, I_ALOG, I_SSMD, I_SSMNORM, I_SSMWOUT, I_SWAQKV, I_SWAQN, I_SWAKN, I_SWAOUT,
       I_DQKV, I_DQN, I_DKN, I_DLAM, I_DON, I_DOUT, N_IN };

constexpr int O_Y_P = 0;
constexpr int O_Y_S = O_Y_P + MP * DM;
constexpr int O_CONV_P = O_Y_S + MS * DM;
constexpr int O_CONV_S = O_CONV_P + 2 * NBP * 3 * CONVD;
constexpr int O_SSM_P = O_CONV_S + 2 * NBS * 3 * CONVD;
constexpr int O_SSM_S = O_SSM_P + 2 * NBP * 32 * 64 * 128;
constexpr int O_KV0_P = O_SSM_S + 2 * NBS * 32 * 64 * 128;
constexpr int O_KV0_S = O_KV0_P + NBP * 128 * 512;
constexpr int O_KV1_P = O_KV0_S + NBS * 128 * 512;
constexpr int O_KV1_S = O_KV1_P + NBP * 512 * 512;
constexpr int O_KV2_P = O_KV1_S + NBS * 512 * 512;
constexpr int O_KV2_S = O_KV2_P + NBP * 2048 * 512;
constexpr int O_DK_P = O_KV2_S + NBS * 2048 * 512;
constexpr int O_DK_S = O_DK_P + MP * 512;
constexpr int O_DV_P = O_DK_S + MS * 512;
constexpr int O_DV_S = O_DV_P + MP * 512;
constexpr int O_TOTAL = O_DV_S + MS * 512;
static_assert(O_TOTAL == 110575616, "output size");

constexpr size_t al4k(size_t x) { return (x + 4095) & ~(size_t)4095; }
constexpr size_t WS_CTL = 0;
constexpr size_t WS_ZERO_BYTES = (size_t)1 << 20;
constexpr size_t WS_SS = (size_t)1 << 20;
constexpr size_t SZ_SS1 = (size_t)MPAD * 16 * 4;
constexpr size_t SZ_WSSDIN = (size_t)SSMNP * DM * 2, SZ_WSSDOUT = (size_t)DM * DIN * 2, SZ_WSWAQKV = (size_t)2304 * DM * 2, SZ_WSWAOUT = (size_t)DM * SWAW * 2,
                 SZ_WDQKV = (size_t)2560 * DM * 2, SZ_WDOUT = (size_t)DM * DQW * 2, SZ_WFFIN = (size_t)2 * DFF * DM * 2, SZ_WFFOUT = (size_t)DM * DFF * 2;
constexpr size_t WS_WSSDIN = WS_SS + al4k(8 * SZ_SS1);
constexpr size_t WS_WSSDOUT = WS_WSSDIN + 2 * al4k(SZ_WSSDIN);
constexpr size_t WS_WSWAQKV = WS_WSSDOUT + 2 * al4k(SZ_WSSDOUT);
constexpr size_t WS_WSWAOUT = WS_WSWAQKV + al4k(SZ_WSWAQKV);
constexpr size_t WS_WDQKV = WS_WSWAOUT + al4k(SZ_WSWAOUT);
constexpr size_t WS_WDOUT = WS_WDQKV + al4k(SZ_WDQKV);
constexpr size_t WS_WFFIN = WS_WDOUT + al4k(SZ_WDOUT);
constexpr size_t WS_WFFOUT = WS_WFFIN + 4 * al4k(SZ_WFFIN);
constexpr size_t WS_X = WS_WFFOUT + 4 * al4k(SZ_WFFOUT);
constexpr size_t WS_XB = WS_X + al4k((size_t)MPAD * DM * 4);
constexpr size_t WS_ZX = WS_XB + al4k((size_t)MPAD * DM * 2);
constexpr size_t WS_DT = WS_ZX + al4k((size_t)MPAD * ZXW * 2);
constexpr size_t WS_YG = WS_DT + al4k((size_t)MPAD * 32 * 4);
constexpr size_t WS_ACT = WS_YG + al4k((size_t)MPAD * DIN * 2);
constexpr size_t WS_QS = WS_ACT + al4k((size_t)MPAD * DFF * 2);
constexpr size_t WS_KS = WS_QS + al4k((size_t)MPAD * SWAW * 2);
constexpr size_t WS_VS = WS_KS + al4k((size_t)MPAD * SWAW * 2);
constexpr size_t WS_AO = WS_VS + al4k((size_t)MPAD * SWAW * 2);
constexpr size_t WS_QD = WS_AO + al4k((size_t)MPAD * SWAW * 2);
constexpr size_t WS_KD = WS_QD + al4k((size_t)MPAD * DQW * 2);
constexpr size_t WS_VD = WS_KD + al4k((size_t)MPAD * DKW * 2);
constexpr size_t WS_AOD = WS_VD + al4k((size_t)MPAD * DKW * 2);
constexpr size_t WS_VTD = WS_AOD + al4k((size_t)MPAD * DQW * 2);
constexpr size_t WS_BC = WS_VTD + al4k((size_t)NBP * 4 * 128 * SEQ * 2);
constexpr size_t WS_BT = WS_BC + al4k((size_t)MP * 1024 * 2);
constexpr size_t WS_SC = WS_BT + al4k((size_t)NBP * 4 * 128 * SEQ * 2);
constexpr size_t WS_VTS = WS_SC + al4k((size_t)MP * 32 * 16);
constexpr size_t WS_LSE = WS_VTS + al4k((size_t)NBP * 12 * 64 * SEQ * 2);
constexpr int PART_STRIDE = 132;
constexpr size_t WS_PART = WS_LSE + al4k((size_t)MP * 12 * 4);
constexpr size_t WS_END = WS_PART + al4k((size_t)1024 * 24 * PART_STRIDE * 4);

constexpr int CW_BAR = 4096;

constexpr int RING_BYTES = 131072;
constexpr int LDSCTL_OFF = RING_BYTES, MISC_OFF = LDSCTL_OFF + 320;
constexpr int LDS_BYTES = 147456;

#define GAS __attribute__((address_space(1)))
#define LAS __attribute__((address_space(3)))
typedef unsigned short bf16;
typedef unsigned v4u __attribute__((ext_vector_type(4)));
typedef unsigned v2u __attribute__((ext_vector_type(2)));
typedef float f32x4 __attribute__((ext_vector_type(4)));
typedef float f32x2 __attribute__((ext_vector_type(2)));
typedef float f32x16 __attribute__((ext_vector_type(16)));
typedef GAS unsigned gu32;
#define RLX_AGENT __ATOMIC_RELAXED, __HIP_MEMORY_SCOPE_AGENT
#define LDS_WAIT() asm volatile("s_waitcnt lgkmcnt(0)" ::: "memory")

__device__ __forceinline__ float bf2f(unsigned short v) { return __builtin_bit_cast(float, (unsigned)v << 16); }
__device__ __forceinline__ float bflo(unsigned w) { return __builtin_bit_cast(float, w << 16); }
__device__ __forceinline__ float bfhi(unsigned w) { return __builtin_bit_cast(float, w & 0xffff0000u); }
__device__ __forceinline__ unsigned f2bf(float f) { unsigned u = __builtin_bit_cast(unsigned, f); return (u + 0x7fffu + ((u >> 16) & 1u)) >> 16; }
__device__ __forceinline__ unsigned pk2(float lo, float hi) { return pg8::cvt_pk_bf16(lo, hi); }
__device__ __forceinline__ int opaque_tid() { int t = threadIdx.x; asm volatile("" : "+v"(t)); return t; }
__device__ __forceinline__ float wave_sum(float v) {
#pragma unroll
    for (int o = 1; o < 64; o <<= 1) v += __shfl_xor(v, o);
    return v;
}
__device__ __forceinline__ float wave_max(float v) {
#pragma unroll
    for (int o = 1; o < 64; o <<= 1) v = fmaxf(v, __shfl_xor(v, o));
    return v;
}
__device__ __forceinline__ float silu_f(float x) { return x * __builtin_amdgcn_rcpf(1.f + __expf(-x)); }
__device__ __forceinline__ float softplus_f(float x) { return x > 20.f ? x : log1pf(__expf(x)); }
__device__ __forceinline__ int rel_bucket(int d) {
    d = d < 0 ? 0 : d;
    if (d < 16) return d;
    const float v = logf((float)d / 16.0f) / 4.852030263919617f * 16.0f;
    const int l = 16 + (int)v;
    return l < 31 ? l : 31;
}

#define XB_TMO      128
#define XB_XCNT(j)  (256  + 64 * (j))
#define XB_XSUB(j)  (1280 + 64 * (j))
#define XB_XGEN(j)  (2304 + 64 * (j))
#define XB_TOP      3328
#define XB_TOPGEN   3392
#define XCD_BAR_WORDS 3456
#define XB_SPIN_CAP (1u << 18)
__device__ __forceinline__ unsigned xb_ld(unsigned* p)              { return __hip_atomic_load(p, __ATOMIC_RELAXED, __HIP_MEMORY_SCOPE_AGENT); }
__device__ __forceinline__ unsigned xb_add(unsigned* p, unsigned v) { return __hip_atomic_fetch_add(p, v, __ATOMIC_RELAXED, __HIP_MEMORY_SCOPE_AGENT); }
__device__ __forceinline__ unsigned xb_xcc_id() { return (unsigned)__builtin_amdgcn_s_getreg((3 << 11) | 20) & 0xFu; }
#define XB_SPIN(cond, bar) do { unsigned _sp = 0; while (cond) { __builtin_amdgcn_s_sleep(1); \
    if ((++_sp & 255u) == 0u) { if (xb_ld(&(bar)[XB_TMO])) break; if (_sp > XB_SPIN_CAP) { atomicAdd(&(bar)[XB_TMO], 1u); break; } } } } while (0)
struct XcdBarrier { unsigned* bar; unsigned x; volatile LAS unsigned* st; };
__device__ __forceinline__ XcdBarrier xcd_barrier_post(unsigned* bar, volatile LAS unsigned* st) {
    XcdBarrier b; b.bar = bar; b.x = xb_xcc_id(); b.st = st;
    if (threadIdx.x == 0) (void)xb_add(&bar[XB_XCNT(b.x)], 1u);
    return b;
}
__device__ __forceinline__ void xcd_barrier_complete(unsigned* bar, unsigned x, unsigned& nloc, unsigned& nx) {
    const unsigned G = gridDim.x * gridDim.y * gridDim.z;
    unsigned sum, cnt, mine, sp = 0u;
    for (;;) {
        sum = 0u; cnt = 0u; mine = 0u;
#pragma unroll
        for (unsigned j = 0; j < 16; ++j) { const unsigned c = xb_ld(&bar[XB_XCNT(j)]); sum += c; cnt += (c > 0u) ? 1u : 0u; mine = (j == x) ? c : mine; }
        if (sum == G) break;
        __builtin_amdgcn_s_sleep(1);
        if ((++sp & 255u) == 0u) { if (xb_ld(&bar[XB_TMO])) break; if (sp > XB_SPIN_CAP) { atomicAdd(&bar[XB_TMO], 1u); break; } }
    }
    nloc = mine > 0u ? mine : 1u; nx = cnt > 0u ? cnt : 1u;
}
__device__ __forceinline__ void xcd_barrier(const XcdBarrier& b) {
    asm volatile("s_waitcnt vmcnt(0)" ::: "memory");
    __syncthreads();
    if (threadIdx.x == 0) {
        unsigned* bar = b.bar;
        __builtin_amdgcn_s_waitcnt(0);
        unsigned nloc = b.st[0], nx = b.st[1];
        if (nloc == 0u) { xcd_barrier_complete(bar, b.x, nloc, nx); b.st[0] = nloc; b.st[1] = nx; }
        const unsigned old = xb_add(&bar[XB_XSUB(b.x)], 1u);
        const unsigned gen = old / nloc;
        if (old + 1u == (gen + 1u) * nloc) {
            __builtin_amdgcn_fence(__ATOMIC_RELEASE, "agent");
            asm volatile("s_waitcnt vmcnt(0)" ::: "memory");
            const unsigned og = xb_add(&bar[XB_TOP], 1u);
            const unsigned tg = og / nx;
            if (og + 1u == (tg + 1u) * nx) xb_add(&bar[XB_TOPGEN], 1u);
            else XB_SPIN(xb_ld(&bar[XB_TOPGEN]) == tg, bar);
            __builtin_amdgcn_fence(__ATOMIC_ACQUIRE, "agent");
            xb_add(&bar[XB_XGEN(b.x)], 1u);
            asm volatile("s_waitcnt vmcnt(0)" ::: "memory");
        } else {
            XB_SPIN(xb_ld(&bar[XB_XGEN(b.x)]) == gen, bar);
            __builtin_amdgcn_fence(__ATOMIC_ACQUIRE, "agent");
            asm volatile("s_waitcnt vmcnt(0)" ::: "memory");
        }
    }
    __syncthreads();
}

struct Args { const void* in[N_IN]; float* out; unsigned char* ws; int ph_lo, ph_hi; };
static_assert(sizeof(Args) == N_IN * 8 + 24, "Args has no padding");

__device__ __forceinline__ float rs_of(const float* ssp, int row) {
    const f32x4* p = (const f32x4*)(ssp + (size_t)row * 16); const f32x4 a = p[0], b = p[1], c = p[2], d = p[3];
    const float s = (((a[0] + a[1]) + (a[2] + a[3])) + ((b[0] + b[1]) + (b[2] + b[3]))) + (((c[0] + c[1]) + (c[2] + c[3])) + ((d[0] + d[1]) + (d[2] + d[3])));
    return rsqrtf(s * (1.0f / 1024.0f) + EPS);
}
#define RS_OF(ss, row) rs_of((ss), (row))

struct EpiSsdIn {
    static constexpr bool PERM = true, AFTER_DRAIN = false;
    bf16* ZX; float* DT; const float* ss; const float* dtb;
    __device__ __forceinline__ void operator()(const pg8::f32x4 (&acc)[2][2][4][2], const pg8::Unit& u, int wr, int wc, int fr, int fq) const {
        const int row0 = u.pm * 256 + wr * 64 + fr;
        {
            const int col0 = u.pn * 256 + wc * 32 + 8 * fq;
#pragma unroll
            for (int ai = 0; ai < 2; ++ai)
#pragma unroll
                for (int m = 0; m < 4; ++m) { const int row = row0 + ai * 128 + m * 16; const float rs = RS_OF(ss, row);
#pragma unroll
                    for (int bj = 0; bj < 2; ++bj) { const f32x4 v0 = acc[ai][bj][m][0] * rs, v1 = acc[ai][bj][m][1] * rs;
                        v4u w; w.x = pk2(v0[0], v0[1]); w.y = pk2(v0[2], v0[3]); w.z = pk2(v1[0], v1[1]); w.w = pk2(v1[2], v1[3]);
                        *(v4u*)(ZX + (size_t)row * ZXW + col0 + bj * 128) = w; } }
        }
    }
};

struct EpiNone { static constexpr bool PERM = true, AFTER_DRAIN = false;
    __device__ __forceinline__ void operator()(const pg8::f32x4 (&acc)[2][2][4][2], const pg8::Unit& u, int wr, int wc, int fr, int fq) const { asm volatile("" :: "v"(acc[0][0][0][0][0]), "v"(acc[1][1][3][1][3])); } };
struct EpiRes {
    static constexpr bool PERM = true, AFTER_DRAIN = false;
    const bf16* XB; float* ss_out; float* fin; bf16* XBd;
    __device__ __forceinline__ void operator()(const pg8::f32x4 (&acc)[2][2][4][2], const pg8::Unit& u, int wr, int wc, int fr, int fq) const {
        const int row0 = u.pm * 256 + wr * 64 + fr, col0 = u.pn * 256 + wc * 32 + 8 * fq;
#pragma unroll
        for (int ai = 0; ai < 2; ++ai)
#pragma unroll
            for (int m = 0; m < 4; ++m) { const int row = row0 + ai * 128 + m * 16; float q = 0.f;
                const bf16* xr = XB + (size_t)row * DM + col0;
                v4u xin[2];
#pragma unroll
                for (int bj = 0; bj < 2; ++bj) xin[bj] = *(const v4u*)(xr + bj * 128);
#pragma unroll
                for (int bj = 0; bj < 2; ++bj) { const int co = bj * 128; const v4u xi = xin[bj];
                    const f32x4 v0 = (f32x4){bflo(xi.x), bfhi(xi.x), bflo(xi.y), bfhi(xi.y)} + acc[ai][bj][m][0];
                    const f32x4 v1 = (f32x4){bflo(xi.z), bfhi(xi.z), bflo(xi.w), bfhi(xi.w)} + acc[ai][bj][m][1];
                    if (fin) { if (row < MTOK) { *(f32x4*)(fin + (size_t)row * DM + col0 + co) = v0; *(f32x4*)(fin + (size_t)row * DM + col0 + co + 4) = v1; } }
                    else { v4u w; w.x = pk2(v0[0], v0[1]); w.y = pk2(v0[2], v0[3]); w.z = pk2(v1[0], v1[1]); w.w = pk2(v1[2], v1[3]); *(v4u*)(XBd + (size_t)row * DM + col0 + co) = w;
                           q += ((v0[0] * v0[0] + v0[1] * v0[1]) + (v0[2] * v0[2] + v0[3] * v0[3])) + ((v1[0] * v1[0] + v1[1] * v1[1]) + (v1[2] * v1[2] + v1[3] * v1[3])); } }
                if (!fin) { q += __shfl_xor(q, 16); q += __shfl_xor(q, 32);
                    if (fq == 0) ss_out[(size_t)row * 16 + u.pn * 4 + wc] = q; } }
    }
};

struct EpiSwiGlu {
    static constexpr bool PERM = true, AFTER_DRAIN = false;
    bf16* ACT; const float* ss;
    __device__ __forceinline__ void operator()(const pg8::f32x4 (&acc)[2][2][4][2], const pg8::Unit& u, int wr, int wc, int fr, int fq) const {
        const int row0 = u.pm * 256 + wr * 64 + fr, col0 = u.pn * 128 + wc * 32 + 8 * fq;
#pragma unroll
        for (int ai = 0; ai < 2; ++ai)
#pragma unroll
            for (int m = 0; m < 4; ++m) { const int row = row0 + ai * 128 + m * 16; const float rs = RS_OF(ss, row);
                f32x4 o[2];
#pragma unroll
                for (int n = 0; n < 2; ++n) { const f32x4 g = acc[ai][0][m][n] * rs, up = acc[ai][1][m][n] * rs;
#pragma unroll
                    for (int j = 0; j < 4; ++j) o[n][j] = silu_f(g[j]) * up[j]; }
                v4u w; w.x = pk2(o[0][0], o[0][1]); w.y = pk2(o[0][2], o[0][3]); w.z = pk2(o[1][0], o[1][1]); w.w = pk2(o[1][2], o[1][3]);
                *(v4u*)(ACT + (size_t)row * DFF + col0) = w; }
    }
};

struct EpiSwaQkv {
    static constexpr bool PERM = true, AFTER_DRAIN = false;
    bf16 *Q, *K, *V, *VT; const float* ss; const float *qn, *kn; float* out;
    __device__ __forceinline__ void operator()(const pg8::f32x4 (&acc)[2][2][4][2], const pg8::Unit& u, int wr, int wc, int fr, int fq) const {
        const int row0 = u.pm * 256 + wr * 64 + fr;
        const int slot = u.pn * 4 + wc, kind = slot / 12, head = slot - kind * 12;
        const float* nwp = kind == 0 ? qn : kn;
        f32x4 nw[2][2];
#pragma unroll
        for (int bj = 0; bj < 2; ++bj)
#pragma unroll
            for (int n = 0; n < 2; ++n) nw[bj][n] = (kind < 2) ? *(const f32x4*)(nwp + 32 * bj + 8 * fq + 4 * n) : (f32x4){1.f, 1.f, 1.f, 1.f};
        bf16* dst = Q + (size_t)kind * ((WS_KS - WS_QS) / 2) + head * 64 + 8 * fq;
        const int g = head >> 2, j4 = head & 3, kv = kind - 1, keep = 128 << (2 * g);
        const int obp = g == 0 ? O_KV0_P : (g == 1 ? O_KV1_P : O_KV2_P), obs = g == 0 ? O_KV0_S : (g == 1 ? O_KV1_S : O_KV2_S);
#pragma unroll
        for (int ai = 0; ai < 2; ++ai)
#pragma unroll
            for (int m = 0; m < 4; ++m) { const int row = row0 + ai * 128 + m * 16; const float rs = RS_OF(ss, row);
                f32x4 v[2][2]; float q = 0.f;
#pragma unroll
                for (int bj = 0; bj < 2; ++bj)
#pragma unroll
                    for (int n = 0; n < 2; ++n) { v[bj][n] = acc[ai][bj][m][n] * rs; const f32x4 x = v[bj][n]; q += (x[0] * x[0] + x[1] * x[1]) + (x[2] * x[2] + x[3] * x[3]); }
                if (kind < 2) { q += __shfl_xor(q, 16); q += __shfl_xor(q, 32); const float r = rsqrtf(q * (1.0f / 64.0f) + EPS);
#pragma unroll
                    for (int bj = 0; bj < 2; ++bj)
#pragma unroll
                        for (int n = 0; n < 2; ++n) v[bj][n] = v[bj][n] * r * nw[bj][n]; }
                if (kind == 2 && u.pm < 64) {
                    const int b = row >> 11, t = row & 2047, pp = ((t & ((1 << (2 * g)) - 1)) << (11 - 2 * g)) + (t >> (2 * g)), tp = (pp & ~12) | ((pp & 4) << 1) | ((pp & 8) >> 1);
                    bf16* vt = VT + ((size_t)((b * 12 + head) * 64 + 8 * fq)) * SEQ + tp;
#pragma unroll
                    for (int bj = 0; bj < 2; ++bj)
#pragma unroll
                        for (int n = 0; n < 2; ++n)
#pragma unroll
                            for (int j = 0; j < 4; ++j) vt[(size_t)(32 * bj + 4 * n + j) * SEQ] = (bf16)f2bf(v[bj][n][j]);
                } else {
#pragma unroll
                for (int bj = 0; bj < 2; ++bj) { v4u w; w.x = pk2(v[bj][0][0], v[bj][0][1]); w.y = pk2(v[bj][0][2], v[bj][0][3]); w.z = pk2(v[bj][1][0], v[bj][1][1]); w.w = pk2(v[bj][1][2], v[bj][1][3]);
                    *(v4u*)(dst + (size_t)row * SWAW + 32 * bj) = w; }
                }
                if (kind >= 1 && row < MTOK) {
                    int base = -1;
                    if (row < MP) { const int b = row >> 11, t = row & 2047, t0 = 2048 - keep; if (t >= t0) base = obp + (((b * keep + (t - t0)) * 2 + kv) * 4 + j4) * 64; }
                    else { const int r2 = row - MP, b = r2 >> 2, tt = r2 & 3; base = obs + (((b * keep + (keep - 4 + tt)) * 2 + kv) * 4 + j4) * 64; }
                    if (base >= 0) {
#pragma unroll
                        for (int bj = 0; bj < 2; ++bj)
#pragma unroll
                            for (int n = 0; n < 2; ++n) *(f32x4*)(out + base + 32 * bj + 8 * fq + 4 * n) = v[bj][n]; }
                } }
    }
};

struct EpiDiffQkv {
    static constexpr bool PERM = true, AFTER_DRAIN = false;
    bf16 *Q, *K, *V, *VT; const float* ss; const float *qn, *kn; float* out;
    __device__ __forceinline__ void operator()(const pg8::f32x4 (&acc)[2][2][4][2], const pg8::Unit& u, int wr, int wc, int fr, int fq) const {
        const int row0 = u.pm * 256 + wr * 64 + fr;
        const int slot = u.pn * 4 + wc, kind = slot < 24 ? 0 : (slot < 32 ? 1 : 2);
        const float* nwp = kind == 0 ? qn : kn;
        f32x4 nw[2][2];
#pragma unroll
        for (int bj = 0; bj < 2; ++bj)
#pragma unroll
            for (int n = 0; n < 2; ++n) nw[bj][n] = (kind < 2) ? *(const f32x4*)(nwp + 32 * bj + 8 * fq + 4 * n) : (f32x4){1.f, 1.f, 1.f, 1.f};
        bf16* dst; int pitch, cofs;
        if (kind == 0) { dst = Q; pitch = DQW; cofs = slot * 64; } else { dst = K + (size_t)(kind - 1) * ((WS_VD - WS_KD) / 2); pitch = DKW; cofs = (slot - (kind == 1 ? 24 : 32)) * 64; }
        const int obp = kind == 1 ? O_DK_P : O_DV_P, obs = kind == 1 ? O_DK_S : O_DV_S;
#pragma unroll
        for (int ai = 0; ai < 2; ++ai)
#pragma unroll
            for (int m = 0; m < 4; ++m) { const int row = row0 + ai * 128 + m * 16; const float rs = RS_OF(ss, row);
                f32x4 v[2][2]; float q = 0.f;
#pragma unroll
                for (int bj = 0; bj < 2; ++bj)
#pragma unroll
                    for (int n = 0; n < 2; ++n) { v[bj][n] = acc[ai][bj][m][n] * rs; const f32x4 x = v[bj][n]; q += (x[0] * x[0] + x[1] * x[1]) + (x[2] * x[2] + x[3] * x[3]); }
                if (kind < 2) { q += __shfl_xor(q, 16); q += __shfl_xor(q, 32); const float r = rsqrtf(q * (1.0f / 64.0f) + EPS);
#pragma unroll
                    for (int bj = 0; bj < 2; ++bj)
#pragma unroll
                        for (int n = 0; n < 2; ++n) v[bj][n] = v[bj][n] * r * nw[bj][n]; }
                if (kind == 2 && u.pm < 64) {
                    const int b = row >> 11, t = row & 2047, tp = (t & ~12) | ((t & 4) << 1) | ((t & 8) >> 1), gg = (slot - 32) >> 1, half = (slot - 32) & 1;
                    bf16* vt = VT + ((size_t)((b * 4 + gg) * 128 + half * 64 + 8 * fq)) * SEQ + tp;
#pragma unroll
                    for (int bj = 0; bj < 2; ++bj)
#pragma unroll
                        for (int n = 0; n < 2; ++n)
#pragma unroll
                            for (int j = 0; j < 4; ++j) vt[(size_t)(32 * bj + 4 * n + j) * SEQ] = (bf16)f2bf(v[bj][n][j]);
                } else {
#pragma unroll
                for (int bj = 0; bj < 2; ++bj) { v4u w; w.x = pk2(v[bj][0][0], v[bj][0][1]); w.y = pk2(v[bj][0][2], v[bj][0][3]); w.z = pk2(v[bj][1][0], v[bj][1][1]); w.w = pk2(v[bj][1][2], v[bj][1][3]);
                    *(v4u*)(dst + (size_t)row * pitch + cofs + 32 * bj + 8 * fq) = w; }
                }
                if (kind >= 1 && row < MTOK) {
                    const int base = (row < MP ? obp + row * 512 : obs + (row - MP) * 512) + cofs;
#pragma unroll
                    for (int bj = 0; bj < 2; ++bj)
#pragma unroll
                        for (int n = 0; n < 2; ++n) *(f32x4*)(out + base + 32 * bj + 8 * fq + 4 * n) = v[bj][n];
                } }
    }
};


template <int NT>
__device__ __forceinline__ void wave_gemm(f32x4 (&acc)[NT], const bf16* Arow, const bf16* Bt, const int (&nb)[NT], int K, int r, int c4) {
    const bf16* ap = Arow + 8 * c4;
    const bf16* bp[NT];
#pragma unroll
    for (int nt = 0; nt < NT; ++nt) { bp[nt] = Bt + (size_t)(nb[nt] + r) * K + 8 * c4; acc[nt] = (f32x4){0.f, 0.f, 0.f, 0.f}; }
#pragma unroll 1
    for (int k0 = 0; k0 < K; k0 += 256) {
        pg8::bf16x8 af[8], bf_[NT][8];
#pragma unroll
        for (int s2 = 0; s2 < 8; ++s2) { af[s2] = *(const pg8::bf16x8*)(ap + k0 + 32 * s2);
#pragma unroll
            for (int nt = 0; nt < NT; ++nt) bf_[nt][s2] = *(const pg8::bf16x8*)(bp[nt] + k0 + 32 * s2); }
#pragma unroll
        for (int s2 = 0; s2 < 8; ++s2)
#pragma unroll
            for (int nt = 0; nt < NT; ++nt) acc[nt] = __builtin_amdgcn_mfma_f32_16x16x32_bf16(bf_[nt][s2], af[s2], acc[nt], 0, 0, 0);
    }
}
#define SK_WAVE_IDS const int tid = threadIdx.x, lane = tid & 63, wave = __builtin_amdgcn_readfirstlane(tid >> 6), r = lane & 15, c4 = lane >> 4; \
    const int nidle = (int)gridDim.x - c0, blkp = ((int)blockIdx.x - c0 + (int)gridDim.x) % (int)gridDim.x, ngw = nidle * NWAVES; \
    const int gwp = (blkp < nidle) ? wave * nidle + blkp : (1 << 30)

__device__ __forceinline__ void sk_res(const Args& A, const bf16* Aact, int K, const bf16* Bt, float* ss_out, float* fin, int c0) {
    SK_WAVE_IDS; bf16* XB = (bf16*)(A.ws + WS_XB);
    for (int task = gwp; task < 16 * 8; task += ngw) {
        const int it = task >> 3, rt = task & 7, row = MP + 16 * rt + r;
        const int nb[4] = {64 * it, 64 * it + 16, 64 * it + 32, 64 * it + 48};
        f32x4 acc[4]; wave_gemm<4>(acc, Aact + (size_t)row * K, Bt, nb, K, r, c4);
        float q = 0.f;
#pragma unroll
        for (int nt = 0; nt < 4; ++nt) { const int col = nb[nt] + 4 * c4; const v2u xi = *(const v2u*)(XB + (size_t)row * DM + col);
            const f32x4 v = (f32x4){bflo(xi.x), bfhi(xi.x), bflo(xi.y), bfhi(xi.y)} + acc[nt];
            if (fin) *(f32x4*)(fin + (size_t)row * DM + col) = v;
            else { v2u w; w.x = pk2(v[0], v[1]); w.y = pk2(v[2], v[3]); *(v2u*)(XB + (size_t)row * DM + col) = w; q += (v[0] * v[0] + v[1] * v[1]) + (v[2] * v[2] + v[3] * v[3]); } }
        if (!fin) { q += __shfl_xor(q, 16); q += __shfl_xor(q, 32); if (c4 == 0) ss_out[(size_t)row * 16 + it] = q; }
    }
}
__device__ __forceinline__ void sk_swiglu(const Args& A, const bf16* Bt, const float* ss, int c0) {
    SK_WAVE_IDS; const bf16* XB = (const bf16*)(A.ws + WS_XB); bf16* ACT = (bf16*)(A.ws + WS_ACT);
    for (int task = gwp; task < 88 * 8; task += ngw) {
        const int it = task >> 3, rt = task & 7, row = MP + 16 * rt + r, pn = it >> 2, i0 = (it & 3) * 32;
        const int nb[4] = {256 * pn + i0, 256 * pn + i0 + 16, 256 * pn + 128 + i0, 256 * pn + 128 + i0 + 16};
        f32x4 acc[4]; wave_gemm<4>(acc, XB + (size_t)row * DM, Bt, nb, DM, r, c4);
        const float rs = RS_OF(ss, row);
#pragma unroll
        for (int h2 = 0; h2 < 2; ++h2) { const f32x4 g = acc[h2] * rs, up = acc[2 + h2] * rs;
            v2u w; w.x = pk2(silu_f(g[0]) * up[0], silu_f(g[1]) * up[1]); w.y = pk2(silu_f(g[2]) * up[2], silu_f(g[3]) * up[3]);
            *(v2u*)(ACT + (size_t)row * DFF + 128 * pn + i0 + 16 * h2 + 4 * c4) = w; }
    }
}
__device__ __forceinline__ void sk_ssdin(const Args& A, const bf16* Bt, const float* ss, const float* dtb, int c0) {
    SK_WAVE_IDS; const bf16* XB = (const bf16*)(A.ws + WS_XB); bf16* ZX = (bf16*)(A.ws + WS_ZX); float* DT = (float*)(A.ws + WS_DT);
    for (int task = gwp; task < 80 * 8; task += ngw) {
        const int it = task >> 3, rt = task & 7, row = MP + 16 * rt + r;
        const int nb[4] = {64 * it, 64 * it + 16, 64 * it + 32, 64 * it + 48};
        f32x4 acc[4]; wave_gemm<4>(acc, XB + (size_t)row * DM, Bt, nb, DM, r, c4);
        const float rs = RS_OF(ss, row);
#pragma unroll
        for (int nt = 0; nt < 4; ++nt) { const f32x4 v = acc[nt] * rs; v2u w; w.x = pk2(v[0], v[1]); w.y = pk2(v[2], v[3]); *(v2u*)(ZX + (size_t)row * ZXW + nb[nt] + 4 * c4) = w; }
    }
    for (int task = (gwp < (1 << 30)) ? (gwp + ngw - (640 % ngw)) % ngw : gwp; task < (MP + MS) / 16; task += ngw) {
        const int row = 16 * task + r;
        const int nb[2] = {5120, 5136};
        f32x4 acc[2]; wave_gemm<2>(acc, XB + (size_t)row * DM, Bt, nb, DM, r, c4);
        const float rs = RS_OF(ss, row);
#pragma unroll
        for (int nt = 0; nt < 2; ++nt) { f32x4 v = acc[nt] * rs + *(const f32x4*)(dtb + 16 * nt + 4 * c4);
#pragma unroll
            for (int j = 0; j < 4; ++j) v[j] = softplus_f(v[j]);
            *(f32x4*)(DT + (size_t)row * 32 + 16 * nt + 4 * c4) = v; }
    }
}
__device__ __forceinline__ void sk_swaqkv(const Args& A, const bf16* Bt, const float* ss, int c0) {
    SK_WAVE_IDS; const bf16* XB = (const bf16*)(A.ws + WS_XB); bf16* Q = (bf16*)(A.ws + WS_QS);
    for (int task = gwp; task < 36 * 8; task += ngw) {
        const int slot = task >> 3, rt = task & 7, row = MP + 16 * rt + r, pn = slot >> 2, wc = slot & 3, kind = slot / 12, head = slot - kind * 12;
        const int nb[4] = {256 * pn + 32 * wc, 256 * pn + 32 * wc + 16, 256 * pn + 128 + 32 * wc, 256 * pn + 128 + 32 * wc + 16};
        f32x4 acc[4]; wave_gemm<4>(acc, XB + (size_t)row * DM, Bt, nb, DM, r, c4);
        const float rs = RS_OF(ss, row); float q = 0.f;
#pragma unroll
        for (int nt = 0; nt < 4; ++nt) { acc[nt] = acc[nt] * rs; q += (acc[nt][0] * acc[nt][0] + acc[nt][1] * acc[nt][1]) + (acc[nt][2] * acc[nt][2] + acc[nt][3] * acc[nt][3]); }
        if (kind < 2) { q += __shfl_xor(q, 16); q += __shfl_xor(q, 32); const float rr = rsqrtf(q * (1.0f / 64.0f) + EPS); const float* nwp = (const float*)A.in[kind == 0 ? I_SWAQN : I_SWAKN];
#pragma unroll
            for (int nt = 0; nt < 4; ++nt) acc[nt] = acc[nt] * rr * *(const f32x4*)(nwp + 16 * nt + 4 * c4); }
        bf16* dst = Q + (size_t)kind * ((WS_KS - WS_QS) / 2) + (size_t)row * SWAW + head * 64;
#pragma unroll
        for (int nt = 0; nt < 4; ++nt) { v2u w; w.x = pk2(acc[nt][0], acc[nt][1]); w.y = pk2(acc[nt][2], acc[nt][3]); *(v2u*)(dst + 16 * nt + 4 * c4) = w; }
        if (kind >= 1) { const int g = head >> 2, j4 = head & 3, kv = kind - 1, keep = 128 << (2 * g), r2 = row - MP, b = r2 >> 2, tt = r2 & 3;
            const int obs = g == 0 ? O_KV0_S : (g == 1 ? O_KV1_S : O_KV2_S);
            float* o = A.out + obs + (size_t)(((b * keep + (keep - 4 + tt)) * 2 + kv) * 4 + j4) * 64;
#pragma unroll
            for (int nt = 0; nt < 4; ++nt) *(f32x4*)(o + 16 * nt + 4 * c4) = acc[nt]; }
    }
}
__device__ __forceinline__ void sk_diffqkv(const Args& A, const bf16* Bt, const float* ss, int c0) {
    SK_WAVE_IDS; const bf16* XB = (const bf16*)(A.ws + WS_XB);
    for (int task = gwp; task < 40 * 8; task += ngw) {
        const int slot = task >> 3, rt = task & 7, row = MP + 16 * rt + r, pn = slot >> 2, wc = slot & 3, kind = slot < 24 ? 0 : (slot < 32 ? 1 : 2);
        const int nb[4] = {256 * pn + 32 * wc, 256 * pn + 32 * wc + 16, 256 * pn + 128 + 32 * wc, 256 * pn + 128 + 32 * wc + 16};
        f32x4 acc[4]; wave_gemm<4>(acc, XB + (size_t)row * DM, Bt, nb, DM, r, c4);
        const float rs = RS_OF(ss, row); float q = 0.f;
#pragma unroll
        for (int nt = 0; nt < 4; ++nt) { acc[nt] = acc[nt] * rs; q += (acc[nt][0] * acc[nt][0] + acc[nt][1] * acc[nt][1]) + (acc[nt][2] * acc[nt][2] + acc[nt][3] * acc[nt][3]); }
        if (kind < 2) { q += __shfl_xor(q, 16); q += __shfl_xor(q, 32); const float rr = rsqrtf(q * (1.0f / 64.0f) + EPS); const float* nwp = (const float*)A.in[kind == 0 ? I_DQN : I_DKN];
#pragma unroll
            for (int nt = 0; nt < 4; ++nt) acc[nt] = acc[nt] * rr * *(const f32x4*)(nwp + 16 * nt + 4 * c4); }
        bf16* dst; int cofs;
        if (kind == 0) { dst = (bf16*)(A.ws + WS_QD) + (size_t)row * DQW; cofs = slot * 64; }
        else { dst = (bf16*)(A.ws + WS_KD) + (size_t)(kind - 1) * ((WS_VD - WS_KD) / 2) + (size_t)row * DKW; cofs = (slot - (kind == 1 ? 24 : 32)) * 64; }
#pragma unroll
        for (int nt = 0; nt < 4; ++nt) { v2u w; w.x = pk2(acc[nt][0], acc[nt][1]); w.y = pk2(acc[nt][2], acc[nt][3]); *(v2u*)(dst + cofs + 16 * nt + 4 * c4) = w; }
        if (kind >= 1) { float* o = A.out + (kind == 1 ? O_DK_S : O_DV_S) + (size_t)(row - MP) * 512 + cofs;
#pragma unroll
            for (int nt = 0; nt < 4; ++nt) *(f32x4*)(o + 16 * nt + 4 * c4) = acc[nt]; }
    }
}

__device__ __forceinline__ int conv_src_col(int n0, int Nsrc, int Ndst, int maptype) {
    if (maptype == 0) return (n0 < Nsrc) ? n0 : -1;
    const int pn = n0 >> 8, r = n0 & 255;
    if (maptype == 1) return (r >> 7) * (Ndst >> 1) + 128 * pn + (r & 127);
    return 256 * pn + 64 * ((r & 127) >> 5) + 32 * (r >> 7);
}
__device__ __forceinline__ void conv_item(const float* __restrict__ W, int K, int Nsrc, int Ndst, bf16* WT, const float* __restrict__ gain, int maptype, LAS float* scr, int item, int lane) {
    const int nblk = Ndst / 64;
    const int kr = lane >> 4, nc = lane & 15;
    {
        const int kb = item / nblk, nb = item - kb * nblk, k0 = 64 * kb, n0 = 64 * nb;
        const int srcb = conv_src_col(n0 + 32 * (nc >> 3), Nsrc, Ndst, maptype);
        f32x4 v[16];
#pragma unroll
        for (int i = 0; i < 16; ++i) { v[i] = (f32x4){0.f, 0.f, 0.f, 0.f};
            if (srcb >= 0) { v[i] = *(const f32x4*)(W + (size_t)(k0 + 4 * i + kr) * Nsrc + srcb + 4 * (nc & 7)); if (gain) v[i] = v[i] * gain[k0 + 4 * i + kr]; } }
#pragma unroll
        for (int hf = 0; hf < 2; ++hf) {
#pragma unroll
            for (int i = 0; i < 8; ++i) { LAS float* d = scr + (4 * i + kr) * 65 + 4 * nc; const f32x4 x = v[8 * hf + i]; d[0] = x[0]; d[1] = x[1]; d[2] = x[2]; d[3] = x[3]; }
            LDS_WAIT(); asm volatile("" ::: "memory");
#pragma unroll
            for (int j = 0; j < 4; ++j) { const int id = j * 64 + lane, n = id >> 2, c = id & 3; const LAS float* sp = scr + (8 * c) * 65 + n;
                v4u o; o.x = pk2(sp[0 * 65], sp[1 * 65]); o.y = pk2(sp[2 * 65], sp[3 * 65]); o.z = pk2(sp[4 * 65], sp[5 * 65]); o.w = pk2(sp[6 * 65], sp[7 * 65]);
                *(v4u*)(WT + (size_t)(n0 + n) * K + k0 + 32 * hf + 8 * c) = o; }
            LDS_WAIT(); asm volatile("" ::: "memory");
        }
    }
}

__device__ __forceinline__ void cache_copy_slice(const Args& A, int part, int nparts, int c0) {
    const int tid = threadIdx.x, lane = tid & 63, wave = __builtin_amdgcn_readfirstlane(tid >> 6);
    const int nidle = (int)gridDim.x - c0, blkp = ((int)blockIdx.x - c0 + (int)gridDim.x) % (int)gridDim.x;
    if (blkp >= nidle) return;
    constexpr int R0 = NBS * 124, R1 = NBS * 508, R2 = NBS * 2044, RT = R0 + R1 + R2;
    const int lo = (int)((long)RT * part / nparts), hi = (int)((long)RT * (part + 1) / nparts);
    const int gw = blkp * NWAVES + wave, ngw = nidle * NWAVES;
    for (int it0 = lo + 4 * gw; it0 < hi; it0 += 4 * ngw) {
        f32x4 v[4][2]; float* dstp[4];
#pragma unroll
        for (int q = 0; q < 4; ++q) { const int it = it0 + q; dstp[q] = nullptr;
            if (it < hi) { int g, r; if (it < R0) { g = 0; r = it; } else if (it < R0 + R1) { g = 1; r = it - R0; } else { g = 2; r = it - R0 - R1; }
                const int lb = 128 << (2 * g), per = lb - 4, b = r / per, i = r - b * per;
                const float* src = (const float*)A.in[I_SWA0 + g] + ((size_t)(b * lb + i + 4)) * 512;
                dstp[q] = A.out + (g == 0 ? O_KV0_S : (g == 1 ? O_KV1_S : O_KV2_S)) + ((size_t)(b * lb + i)) * 512;
                v[q][0] = ((const f32x4*)src)[lane]; v[q][1] = ((const f32x4*)src)[lane + 64]; } }
#pragma unroll
        for (int q = 0; q < 4; ++q) if (dstp[q]) { ((f32x4*)dstp[q])[lane] = v[q][0]; ((f32x4*)dstp[q])[lane + 64] = v[q][1]; }
    }
}

__device__ __forceinline__ void prologue_phase(const Args& A, LAS unsigned char* lds) {
    const int tid = threadIdx.x, lane = tid & 63, wave = __builtin_amdgcn_readfirstlane(tid >> 6);
    const int gw = blockIdx.x * NWAVES + wave, ngw = gridDim.x * NWAVES;
    LAS float* scr = (LAS float*)(lds + wave * 8448);
    unsigned char* ws = A.ws;
    {
        constexpr int I0 = 16 * 84, I1 = 32 * 16, I2 = 16 * 36, I3 = 12 * 16, I4 = 16 * 40, I5 = 24 * 16, I6 = 16 * 88, I7 = 44 * 16;
        constexpr int P1 = 2 * I0, P2 = P1 + 2 * I1, P3 = P2 + I2, P4 = P3 + I3, P5 = P4 + I4, P6 = P5 + I5, P7 = P6 + 4 * I6, PT = P7 + 4 * I7;
        for (int item = gw; item < PT; item += ngw) {
            const float* W; int K, Nsrc, Ndst, mt, li; bf16* WT; const float* gain;
            if (item < P1)      { const int i = item / I0; li = item - i * I0; W = (const float*)A.in[I_SSMWIN] + (size_t)i * DM * SSMN; K = DM; Nsrc = SSMN; Ndst = SSMNP; mt = 0; WT = (bf16*)(ws + WS_WSSDIN + i * al4k(SZ_WSSDIN)); gain = (const float*)A.in[I_NMIX] + (i == 0 ? 0 : 3) * DM; }
            else if (item < P2) { const int r = item - P1, i = r / I1; li = r - i * I1; W = (const float*)A.in[I_SSMWOUT] + (size_t)i * DIN * DM; K = DIN; Nsrc = DM; Ndst = DM; mt = 0; WT = (bf16*)(ws + WS_WSSDOUT + i * al4k(SZ_WSSDOUT)); gain = nullptr; }
            else if (item < P3) { li = item - P2; W = (const float*)A.in[I_SWAQKV]; K = DM; Nsrc = 2304; Ndst = 2304; mt = 2; WT = (bf16*)(ws + WS_WSWAQKV); gain = (const float*)A.in[I_NMIX] + 1 * DM; }
            else if (item < P4) { li = item - P3; W = (const float*)A.in[I_SWAOUT]; K = SWAW; Nsrc = DM; Ndst = DM; mt = 0; WT = (bf16*)(ws + WS_WSWAOUT); gain = nullptr; }
            else if (item < P5) { li = item - P4; W = (const float*)A.in[I_DQKV]; K = DM; Nsrc = 2560; Ndst = 2560; mt = 2; WT = (bf16*)(ws + WS_WDQKV); gain = (const float*)A.in[I_NMIX] + 2 * DM; }
            else if (item < P6) { li = item - P5; W = (const float*)A.in[I_DOUT]; K = DQW; Nsrc = DM; Ndst = DM; mt = 0; WT = (bf16*)(ws + WS_WDOUT); gain = nullptr; }
            else if (item < P7) { const int r = item - P6, l = r / I6; li = r - l * I6; W = (const float*)A.in[I_FFIN] + (size_t)l * DM * 2 * DFF; K = DM; Nsrc = 2 * DFF; Ndst = 2 * DFF; mt = 1; WT = (bf16*)(ws + WS_WFFIN + l * al4k(SZ_WFFIN)); gain = (const float*)A.in[I_NFFN] + l * DM; }
            else                { const int r = item - P7, l = r / I7; li = r - l * I7; W = (const float*)A.in[I_FFOUT] + (size_t)l * DFF * DM; K = DFF; Nsrc = DM; Ndst = DM; mt = 0; WT = (bf16*)(ws + WS_WFFOUT + l * al4k(SZ_WFFOUT)); gain = nullptr; }
            conv_item(W, K, Nsrc, Ndst, WT, gain, mt, scr, li, lane);
        }
    }
    {
        bf16* XB = (bf16*)(ws + WS_XB); float* ss0 = (float*)(ws + WS_SS);
        for (int m = gw; m < MPAD; m += ngw) {
            f32x4 v[4]; float s = 0.f;
            const float* src = m < MP ? (const float*)A.in[I_XP] + (size_t)m * DM : (const float*)A.in[I_XS] + (size_t)(m - MP) * DM;
#pragma unroll
            for (int j = 0; j < 4; ++j) { v[j] = (m < MTOK) ? ((const f32x4*)src)[lane + 64 * j] : (f32x4){0.f, 0.f, 0.f, 0.f}; s += (v[j][0] * v[j][0] + v[j][1] * v[j][1]) + (v[j][2] * v[j][2] + v[j][3] * v[j][3]); }
            s = wave_sum(s);
#pragma unroll
            for (int j = 0; j < 4; ++j) { v2u w; w.x = pk2(v[j][0], v[j][1]); w.y = pk2(v[j][2], v[j][3]); ((v2u*)(XB + (size_t)m * DM))[lane + 64 * j] = w; }
            if (lane < 16) ss0[(size_t)m * 16 + lane] = (lane == 0) ? s : 0.f;
        }
    }
}

__device__ __forceinline__ void ssd_prompt_unit(const Args& A, LAS unsigned char* lds, int li, int b, int h);
__device__ __forceinline__ void ssd_scan_phase(const Args& A, LAS unsigned char* lds, int li) {
    const int tid = threadIdx.x;
    unsigned char* ws = A.ws;
    const bf16* ZX = (const bf16*)(ws + WS_ZX); const float* DT = (const float*)(ws + WS_DT); bf16* YG = (bf16*)(ws + WS_YG);
    const float* convw = (const float*)A.in[I_CONVW] + li * 4 * CONVD; const float* convb = (const float*)A.in[I_CONVB] + li * CONVD;
    const float* alog = (const float*)A.in[I_ALOG] + li * 32; const float* dsk = (const float*)A.in[I_SSMD] + li * 32;
    const float* cst = (const float*)A.in[I_CONVST] + (size_t)li * NBS * 3 * CONVD;
    const float* sst = (const float*)A.in[I_SSMST] + (size_t)li * NBS * 32 * 8192;
    float* out = A.out;
    {
        int tg = tid; asm volatile("" : "+v"(tg)); const int gt = blockIdx.x * NTHR + tg, ngt = gridDim.x * NTHR;
        for (int e = gt; e < NBP * 3 * CONVD; e += ngt) { const int b = e / (3 * CONVD), r = e - b * 3 * CONVD, j = r / CONVD, ch = r - j * CONVD;
            out[O_CONV_P + li * (NBP * 3 * CONVD) + e] = bf2f(ZX[(size_t)(b * SEQ + SEQ - 3 + j) * ZXW + 2048 + ch]); }
        for (int e = gt; e < NBS * 3 * CONVD; e += ngt) { const int b = e / (3 * CONVD), r = e - b * 3 * CONVD, j = r / CONVD, ch = r - j * CONVD;
            out[O_CONV_S + li * (NBS * 3 * CONVD) + e] = bf2f(ZX[(size_t)(MP + b * 4 + 1 + j) * ZXW + 2048 + ch]); }
    }
    for (int rep = 0; rep < REP_SCANP; ++rep)
    for (int u = blockIdx.x; u < 256; u += gridDim.x) ssd_prompt_unit(A, lds, li, u >> 5, u & 31);
    {
        int tidS = tid; asm volatile("" : "+v"(tidS));
        const int lane = tidS & 63, wave = __builtin_amdgcn_readfirstlane(tidS >> 6), G = gridDim.x;
        LAS float* bc = (LAS float*)lds + wave * 1024;
        __syncthreads();
        for (int rep = 0; rep < REP_SCANS; ++rep)
        for (int task = wave * G + (int)blockIdx.x; task < NBS * 32; task += NWAVES * G) {
            const int b = task >> 5, h = task & 31, g = h >> 3, rb = MP + b * TS;
            f32x4 H[32];
            { const f32x4* sp = (const f32x4*)(sst + ((size_t)((b * 32 + h) * 64 + lane)) * 128);
#pragma unroll
              for (int q = 0; q < 32; ++q) H[q] = sp[q]; }
            float xv[4], zv[4], dtv[4];
            {
                int cch[5] = {h * 64 + lane, 2048 + g * 128 + lane, 2048 + g * 128 + 64 + lane, 2560 + g * 128 + lane, 2560 + g * 128 + 64 + lane};
#pragma unroll
                for (int ci = 0; ci < 5; ++ci) { const int cc = cch[ci];
                    float in[7];
#pragma unroll
                    for (int k = 0; k < 3; ++k) in[k] = cst[(size_t)(b * 3 + k) * CONVD + cc];
#pragma unroll
                    for (int k = 0; k < 4; ++k) in[3 + k] = bf2f(ZX[(size_t)(rb + k) * ZXW + 2048 + cc]);
                    const float w0 = convw[cc], w1 = convw[CONVD + cc], w2 = convw[2 * CONVD + cc], w3 = convw[3 * CONVD + cc], bs = convb[cc];
#pragma unroll
                    for (int tt = 0; tt < 4; ++tt) { const float v = silu_f(bs + w0 * in[tt] + w1 * in[tt + 1] + w2 * in[tt + 2] + w3 * in[tt + 3]);
                        if (ci == 0) xv[tt] = v; else bc[tt * 256 + (ci - 1) * 64 + lane] = v; }
                }
#pragma unroll
                for (int tt = 0; tt < 4; ++tt) { zv[tt] = bf2f(ZX[(size_t)(rb + tt) * ZXW + h * 64 + lane]); dtv[tt] = DT[(size_t)(rb + tt) * 32 + h]; }
            }
            LDS_WAIT(); __builtin_amdgcn_wave_barrier();
            const float a = -__expf(alog[h]), Dh = dsk[h];
#pragma unroll
            for (int tt = 0; tt < 4; ++tt) {
                const float dt = dtv[tt], dA = __expf(dt * a), dtx = dt * xv[tt];
                const LAS f32x4* Bp = (const LAS f32x4*)(bc + tt * 256); const LAS f32x4* Cp = Bp + 32;
                float y0 = 0.f, y1 = 0.f;
#pragma unroll
                for (int q = 0; q < 32; ++q) { const f32x4 bb = Bp[q], cq = Cp[q];
                    H[q] = H[q] * dA + bb * dtx;
                    y0 += cq[0] * H[q][0] + cq[1] * H[q][1]; y1 += cq[2] * H[q][2] + cq[3] * H[q][3]; }
                const float y = (y0 + y1) + Dh * xv[tt];
                YG[(size_t)(rb + tt) * DIN + h * 64 + lane] = (bf16)f2bf(y * silu_f(zv[tt]));
            }
            { f32x4* so = (f32x4*)(out + O_SSM_S + li * (NBS * 32 * 8192) + ((size_t)((b * 32 + h) * 64 + lane)) * 128);
#pragma unroll
              for (int q = 0; q < 32; ++q) so[q] = H[q]; }
            LDS_WAIT(); __builtin_amdgcn_wave_barrier();
        }
        __syncthreads();
    }
}

__device__ __forceinline__ int pi32_pos0(int tb8) { return ((tb8 >> 2) << 5) + 16 * (tb8 & 1) + 4 * ((tb8 >> 1) & 1); }
__device__ __forceinline__ void ssd_prepass_phase(const Args& A, int li) {
    int tid = threadIdx.x; asm volatile("" : "+v"(tid));
    const int lane = tid & 63, wave = __builtin_amdgcn_readfirstlane(tid >> 6);
    const int gw = blockIdx.x * NWAVES + wave, ngw = gridDim.x * NWAVES, gt = blockIdx.x * NTHR + tid, ngt = gridDim.x * NTHR;
    const bf16* ZX = (const bf16*)(A.ws + WS_ZX); const float* DT = (const float*)(A.ws + WS_DT);
    bf16* BC = (bf16*)(A.ws + WS_BC); bf16* BT = (bf16*)(A.ws + WS_BT); f32x4* SC = (f32x4*)(A.ws + WS_SC);
    const float* convw = (const float*)A.in[I_CONVW] + li * 4 * CONVD; const float* convb = (const float*)A.in[I_CONVB] + li * CONVD;
    const float* alog = (const float*)A.in[I_ALOG] + li * 32;
    for (int task = gt; task < NBP * 128 * 1024; task += ngt) {
        const int ch = task & 1023, tb = (task >> 10) & 127, b = task >> 17, cc = 2048 + ch, t0 = tb * 16;
        const float w0 = convw[cc], w1 = convw[CONVD + cc], w2 = convw[2 * CONVD + cc], w3 = convw[3 * CONVD + cc], bs = convb[cc];
        float v[19];
#pragma unroll
        for (int k = 0; k < 19; ++k) { const int t = t0 - 3 + k; v[k] = (t >= 0) ? bf2f(ZX[(size_t)(b * SEQ + t) * ZXW + 2048 + cc]) : 0.f; }
        float o[16];
#pragma unroll
        for (int e = 0; e < 16; ++e) { o[e] = silu_f(bs + w0 * v[e] + w1 * v[e + 1] + w2 * v[e + 2] + w3 * v[e + 3]); BC[(size_t)(b * SEQ + t0 + e) * 1024 + ch] = (bf16)f2bf(o[e]); }
        if (ch < 512) { const int g = ch >> 7, n = ch & 127; bf16* rowp = BT + (size_t)((b * 4 + g) * 128 + n) * SEQ + (t0 & ~63);
#pragma unroll
            for (int hb = 0; hb < 2; ++hb) { bf16* row = rowp + pi32_pos0((2 * tb + hb) & 7);
                v2u a; a.x = pk2(o[8 * hb + 0], o[8 * hb + 1]); a.y = pk2(o[8 * hb + 2], o[8 * hb + 3]); v2u c2; c2.x = pk2(o[8 * hb + 4], o[8 * hb + 5]); c2.y = pk2(o[8 * hb + 6], o[8 * hb + 7]);
                *(v2u*)row = a; *(v2u*)(row + 8) = c2; } }
    }
    for (int task = gw; task < NBP * 32 * 32; task += ngw) {
        const int h = task & 31, ck = (task >> 5) & 31, b = task >> 10, row = b * SEQ + ck * 64 + lane;
        const float dt = DT[(size_t)row * 32 + h], a = -__expf(alog[h]);
        float x = dt * a;
#pragma unroll
        for (int o = 1; o < 64; o <<= 1) { const float y = __shfl_up(x, o); if (lane >= o) x += y; }
        const float tot = __shfl(x, 63);
        SC[(size_t)row * 32 + h] = (f32x4){x, dt, dt * __expf(tot - x), __expf(x)};
    }
}


namespace ssdk { constexpr int PX = 144, PC = 272;
    constexpr int XST = 0, XSW = XST + 64 * PX, CM = XSW + 64 * PX, BM = CM + 64 * PC, BMT = BM + 64 * PC, HB = BMT + 128 * PX, SCL = HB + 64 * PC; }
template <int NJ>
__device__ __forceinline__ void ssd_stage1(LAS unsigned char* lds, const pg8::bf16x8 (&cf)[4], const LAS float* cumL, const LAS float* dtL, int r, int c, float Dh, pg8::bf16x8 (&wf)[2]) {
    constexpr int it = NJ - 1;
    f32x4 g4[4];
#pragma unroll
    for (int jt = 0; jt < 4; ++jt) g4[jt] = (f32x4){0.f, 0.f, 0.f, 0.f};
#pragma unroll
    for (int kh = 0; kh < 2; ++kh) {
        pg8::bf16x8 bfr[NJ][2];
#pragma unroll
        for (int jt = 0; jt < NJ; ++jt)
#pragma unroll
            for (int k2 = 0; k2 < 2; ++k2) bfr[jt][k2] = *(const LAS pg8::bf16x8*)(lds + ssdk::BM + (16 * jt + r) * ssdk::PC + (32 * (2 * kh + k2) + 8 * c) * 2);
        __builtin_amdgcn_sched_barrier(0);
#pragma unroll
        for (int k2 = 0; k2 < 2; ++k2)
#pragma unroll
            for (int jt = 0; jt < NJ; ++jt) g4[jt] = __builtin_amdgcn_mfma_f32_16x16x32_bf16(bfr[jt][k2], cf[2 * kh + k2], g4[jt], 0, 0, 0);
        __builtin_amdgcn_sched_barrier(0);
    }
    f32x4 cj[NJ], dj[NJ];
#pragma unroll
    for (int jt = 0; jt < NJ; ++jt) { cj[jt] = *(const LAS f32x4*)(cumL + 16 * jt + 4 * c); dj[jt] = *(const LAS f32x4*)(dtL + 16 * jt + 4 * c); }
    const float ci = cumL[16 * it + r];
#pragma unroll
    for (int jt = 0; jt < NJ; ++jt)
#pragma unroll
        for (int q = 0; q < 4; ++q) {
            float wv = g4[jt][q] * __expf(ci - cj[jt][q]) * dj[jt][q];
            if (jt == it) { const int jl = 4 * c + q; wv = (jl <= r) ? wv : 0.f; if (jl == r) wv += Dh; }
            g4[jt][q] = wv; }
#pragma unroll
    for (int kk = 0; kk < 2; ++kk) { v4u w; w.x = pk2(g4[2 * kk][0], g4[2 * kk][1]); w.y = pk2(g4[2 * kk][2], g4[2 * kk][3]); w.z = pk2(g4[2 * kk + 1][0], g4[2 * kk + 1][1]); w.w = pk2(g4[2 * kk + 1][2], g4[2 * kk + 1][3]);
        wf[kk] = __builtin_bit_cast(pg8::bf16x8, w); }
}

__device__ __forceinline__ void ssd_prompt_unit(const Args& A, LAS unsigned char* lds, int li, int b, int h) {
    const int tid = threadIdx.x, lane = tid & 63, wave = __builtin_amdgcn_readfirstlane(tid >> 6);
    const int r = lane & 15, c = lane >> 4, it = (wave < 4) ? (wave >> 1) : 3 - ((wave - 4) >> 1), ph = wave & 1, g = h >> 3, rb = b * SEQ;
    using namespace ssdk;
    static_assert(SCL + 1024 <= RING_BYTES, "ssd LDS map");
    LAS float* cumL = (LAS float*)(lds + SCL); LAS float* dtL = cumL + 64; LAS float* ecL = cumL + 128;
    const bf16* ZX = (const bf16*)(A.ws + WS_ZX); const bf16* BC = (const bf16*)(A.ws + WS_BC); const bf16* BT = (const bf16*)(A.ws + WS_BT); const f32x4* SC = (const f32x4*)(A.ws + WS_SC);
    bf16* YG = (bf16*)(A.ws + WS_YG);
    const float* convw = (const float*)A.in[I_CONVW] + li * 4 * CONVD; const float* convb = (const float*)A.in[I_CONVB] + li * CONVD;
    const float Dh = ((const float*)A.in[I_SSMD])[li * 32 + h];
    const int xcc = h * 64 + lane;
    const float xw0 = convw[xcc], xw1 = convw[CONVD + xcc], xw2 = convw[2 * CONVD + xcc], xw3 = convw[3 * CONVD + xcc], xbs = convb[xcc];
    const int xpos = pi32_pos0(wave);
    const int crow = tid >> 4, cc16 = tid & 15, tn = tid >> 3, tc8 = tid & 7;
    const bf16* csrc = BC + (size_t)(rb + crow) * 1024 + 512 + g * 128 + cc16 * 8;
    const bf16* bsrc = BC + (size_t)(rb + crow) * 1024 + g * 128 + cc16 * 8;
    const bf16* tsrc = BT + (size_t)((b * 4 + g) * 128 + tn) * SEQ + tc8 * 8;
    const int cdst = crow * PC + cc16 * 16, tdst = tn * PX + tc8 * 16;
    f32x4 Ht[4];
#pragma unroll
    for (int i = 0; i < 4; ++i) Ht[i] = (f32x4){0.f, 0.f, 0.f, 0.f};
    struct SsdRegs { v4u pc0, pc1, pb0, pb1, pt0, pt1; f32x4 psc; unsigned xr[11]; float xwj[8]; v2u zz[2]; };
    SsdRegs R0;
    R0.psc = (f32x4){0.f, 0.f, 0.f, 0.f};
#define SSD_PREFETCH(R, ck) do { const size_t ro = (size_t)(ck) * 64 * 1024; \
        R.pc0 = *(const v4u*)(csrc + ro); R.pc1 = *(const v4u*)(csrc + ro + 32 * 1024); R.pb0 = *(const v4u*)(bsrc + ro); R.pb1 = *(const v4u*)(bsrc + ro + 32 * 1024); \
        R.pt0 = *(const v4u*)(tsrc + (ck) * 64); R.pt1 = *(const v4u*)(tsrc + (ck) * 64 + (size_t)64 * SEQ); \
        if (tid < 64) R.psc = SC[(size_t)(rb + (ck) * 64 + tid) * 32 + h]; \
        _Pragma("unroll") for (int k = 0; k < 11; ++k) { const int t = (ck) * 64 + 8 * wave - 3 + k; R.xr[k] = ZX[(size_t)(rb + (t < 0 ? 0 : t)) * ZXW + 2048 + xcc]; } \
        _Pragma("unroll") for (int e = 0; e < 8; ++e) R.xwj[e] = ((const float*)SC)[((size_t)(rb + (ck) * 64 + 8 * wave + e) * 32 + h) * 4 + 2]; \
        _Pragma("unroll") for (int pt = 0; pt < 2; ++pt) R.zz[pt] = *(const v2u*)(ZX + (size_t)(rb + (ck) * 64 + 16 * it + r) * ZXW + h * 64 + 32 * ph + 16 * pt + 4 * c); } while (0)
#define SSD_CHUNK(R, ck) do { \
        __syncthreads();                                              \
        _Pragma("unroll") for (int pt = 0; pt < 4; ++pt) { v2u w; w.x = pk2(Ht[pt][0], Ht[pt][1]); w.y = pk2(Ht[pt][2], Ht[pt][3]); *(LAS v2u*)(lds + HB + (16 * pt + r) * PC + (16 * wave + 4 * c) * 2) = w; } \
        *(LAS v4u*)(lds + CM + cdst) = R.pc0; *(LAS v4u*)(lds + CM + cdst + 32 * PC) = R.pc1; \
        *(LAS v4u*)(lds + BM + cdst) = R.pb0; *(LAS v4u*)(lds + BM + cdst + 32 * PC) = R.pb1; \
        *(LAS v4u*)(lds + BMT + tdst) = R.pt0; *(LAS v4u*)(lds + BMT + tdst + 64 * PX) = R.pt1; \
        if (tid < 64) { cumL[tid] = R.psc[0]; dtL[tid] = R.psc[1]; ecL[tid] = R.psc[3]; } \
        { float o[8]; \
            float xin[11]; \
            _Pragma("unroll") for (int k = 0; k < 11; ++k) xin[k] = ((ck) * 64 + 8 * wave - 3 + k >= 0) ? bflo(R.xr[k]) : 0.f; \
            _Pragma("unroll") for (int e = 0; e < 8; ++e) o[e] = silu_f(xbs + xw0 * xin[e] + xw1 * xin[e + 1] + xw2 * xin[e + 2] + xw3 * xin[e + 3]); \
            v2u a, a2, s1, s2; a.x = pk2(o[0], o[1]); a.y = pk2(o[2], o[3]); a2.x = pk2(o[4], o[5]); a2.y = pk2(o[6], o[7]); \
            s1.x = pk2(o[0] * R.xwj[0], o[1] * R.xwj[1]); s1.y = pk2(o[2] * R.xwj[2], o[3] * R.xwj[3]); s2.x = pk2(o[4] * R.xwj[4], o[5] * R.xwj[5]); s2.y = pk2(o[6] * R.xwj[6], o[7] * R.xwj[7]); \
            *(LAS v2u*)(lds + XST + lane * PX + xpos * 2) = a; *(LAS v2u*)(lds + XST + lane * PX + (xpos + 8) * 2) = a2; \
            *(LAS v2u*)(lds + XSW + lane * PX + xpos * 2) = s1; *(LAS v2u*)(lds + XSW + lane * PX + (xpos + 8) * 2) = s2; } \
        const v2u zc0 = R.zz[0], zc1 = R.zz[1]; \
        __syncthreads();                                              \
        const int tok = rb + (ck) * 64 + 16 * it + r; \
        if ((ck) + 1 < 32) SSD_PREFETCH(R, (ck) + 1); \
        pg8::bf16x8 cf[4]; \
        _Pragma("unroll") for (int ks = 0; ks < 4; ++ks) cf[ks] = *(const LAS pg8::bf16x8*)(lds + CM + (16 * it + r) * PC + (32 * ks + 8 * c) * 2); \
        pg8::bf16x8 wf[2]; \
        if (it == 0) ssd_stage1<1>(lds, cf, cumL, dtL, r, c, Dh, wf); else if (it == 1) ssd_stage1<2>(lds, cf, cumL, dtL, r, c, Dh, wf); \
        else if (it == 2) ssd_stage1<3>(lds, cf, cumL, dtL, r, c, Dh, wf); else ssd_stage1<4>(lds, cf, cumL, dtL, r, c, Dh, wf); \
          \
        pg8::bf16x8 hfr[2][4], xfr[2][2]; \
        _Pragma("unroll") for (int pt = 0; pt < 2; ++pt) { \
            _Pragma("unroll") for (int ks = 0; ks < 4; ++ks) hfr[pt][ks] = *(const LAS pg8::bf16x8*)(lds + HB + (32 * ph + 16 * pt + r) * PC + (32 * ks + 8 * c) * 2); \
            _Pragma("unroll") for (int kk = 0; kk < 2; ++kk) xfr[pt][kk] = *(const LAS pg8::bf16x8*)(lds + XST + (32 * ph + 16 * pt + r) * PX + (32 * kk + 8 * c) * 2); } \
        const float eci = ecL[16 * it + r], etot = ecL[63]; \
        __builtin_amdgcn_sched_barrier(0); \
        f32x4 yt[2]; yt[0] = (f32x4){0.f, 0.f, 0.f, 0.f}; yt[1] = yt[0]; \
        _Pragma("unroll") for (int ks = 0; ks < 4; ++ks) \
            _Pragma("unroll") for (int pt = 0; pt < 2; ++pt) yt[pt] = __builtin_amdgcn_mfma_f32_16x16x32_bf16(hfr[pt][ks], cf[ks], yt[pt], 0, 0, 0); \
        yt[0] = yt[0] * eci; yt[1] = yt[1] * eci; \
        _Pragma("unroll") for (int kk = 0; kk < 2; ++kk) \
            _Pragma("unroll") for (int pt = 0; pt < 2; ++pt) yt[pt] = __builtin_amdgcn_mfma_f32_16x16x32_bf16(xfr[pt][kk], wf[kk], yt[pt], 0, 0, 0); \
        _Pragma("unroll") for (int pt = 0; pt < 2; ++pt) { \
            const v2u zq = pt ? zc1 : zc0; \
            const float z0 = bflo(zq.x), z1 = bfhi(zq.x), z2 = bflo(zq.y), z3 = bfhi(zq.y); \
            v2u w; w.x = pk2(yt[pt][0] * silu_f(z0), yt[pt][1] * silu_f(z1)); w.y = pk2(yt[pt][2] * silu_f(z2), yt[pt][3] * silu_f(z3)); \
            *(v2u*)(YG + (size_t)tok * DIN + h * 64 + 32 * ph + 16 * pt + 4 * c) = w; } \
        __builtin_amdgcn_sched_barrier(0); \
          \
        pg8::bf16x8 tfr[2], sfr[2][4]; \
        _Pragma("unroll") for (int kk = 0; kk < 2; ++kk) { tfr[kk] = *(const LAS pg8::bf16x8*)(lds + BMT + (16 * wave + r) * PX + (32 * kk + 8 * c) * 2); \
            _Pragma("unroll") for (int pt = 0; pt < 4; ++pt) sfr[kk][pt] = *(const LAS pg8::bf16x8*)(lds + XSW + (16 * pt + r) * PX + (32 * kk + 8 * c) * 2); } \
        __builtin_amdgcn_sched_barrier(0); \
        _Pragma("unroll") for (int pt = 0; pt < 4; ++pt) Ht[pt] = Ht[pt] * etot; \
        _Pragma("unroll") for (int kk = 0; kk < 2; ++kk) \
            _Pragma("unroll") for (int pt = 0; pt < 4; ++pt) Ht[pt] = __builtin_amdgcn_mfma_f32_16x16x32_bf16(tfr[kk], sfr[kk][pt], Ht[pt], 0, 0, 0); \
    } while (0)
    SSD_PREFETCH(R0, 0);
#pragma unroll 1
    for (int ck = 0; ck < 32; ++ck) { SSD_CHUNK(R0, ck); }
#undef SSD_CHUNK
#undef SSD_PREFETCH
    int r2 = r, c2 = c; asm volatile("" : "+v"(r2), "+v"(c2));
    float* so = A.out + O_SSM_P + li * (NBP * 32 * 8192) + (size_t)((b * 32 + h) * 64) * 128;
#pragma unroll
    for (int pt = 0; pt < 4; ++pt) *(f32x4*)(so + (size_t)(16 * pt + r2) * 128 + 16 * wave + 4 * c2) = Ht[pt];
    __syncthreads();
}

__device__ __forceinline__ void ssd_gatenorm_phase(const Args& A, int li, bf16* YG) {
    const int tid = threadIdx.x, lane = tid & 63, wave = __builtin_amdgcn_readfirstlane(tid >> 6);
    const int gw = blockIdx.x * NWAVES + wave, ngw = gridDim.x * NWAVES;
    const float* nrm = (const float*)A.in[I_SSMNORM] + li * DIN;
    for (int r0 = gw; r0 < MTOK; r0 += 2 * ngw) {
      v4u w2[2][4];
#pragma unroll
      for (int rr = 0; rr < 2; ++rr) { const int row = r0 + rr * ngw;
#pragma unroll
        for (int g = 0; g < 4; ++g) w2[rr][g] = (row < MTOK) ? *(const v4u*)(YG + (size_t)row * DIN + g * 512 + lane * 8) : (v4u){0u, 0u, 0u, 0u}; }
#pragma unroll
      for (int rr = 0; rr < 2; ++rr) { const int row = r0 + rr * ngw; if (row >= MTOK) break;
        v4u w[4];
#pragma unroll
        for (int g = 0; g < 4; ++g) w[g] = w2[rr][g];
#pragma unroll
        for (int g = 0; g < 4; ++g) {
            float v[8] = {bflo(w[g].x), bfhi(w[g].x), bflo(w[g].y), bfhi(w[g].y), bflo(w[g].z), bfhi(w[g].z), bflo(w[g].w), bfhi(w[g].w)};
            float q = 0.f;
#pragma unroll
            for (int e = 0; e < 8; ++e) q += v[e] * v[e];
            q = wave_sum(q); const float r = rsqrtf(q * (1.0f / 512.0f) + EPS);
            const f32x4 n0 = *(const f32x4*)(nrm + g * 512 + lane * 8), n1 = *(const f32x4*)(nrm + g * 512 + lane * 8 + 4);
            v4u o; o.x = pk2(v[0] * r * n0[0], v[1] * r * n0[1]); o.y = pk2(v[2] * r * n0[2], v[3] * r * n0[3]); o.z = pk2(v[4] * r * n1[0], v[5] * r * n1[1]); o.w = pk2(v[6] * r * n1[2], v[7] * r * n1[3]);
            *(v4u*)(YG + (size_t)row * DIN + g * 512 + lane * 8) = o;
        }
      }
    }
}

__device__ __forceinline__ float dot64_bb(const v4u (&q)[8], const bf16* krow) {
    const v4u* kp = (const v4u*)krow; float acc = 0.f;
#pragma unroll
    for (int i = 0; i < 8; ++i) { const v4u k = kp[i];
        acc += bflo(q[i].x) * bflo(k.x) + bfhi(q[i].x) * bfhi(k.x) + bflo(q[i].y) * bflo(k.y) + bfhi(q[i].y) * bfhi(k.y)
             + bflo(q[i].z) * bflo(k.z) + bfhi(q[i].z) * bfhi(k.z) + bflo(q[i].w) * bflo(k.w) + bfhi(q[i].w) * bfhi(k.w); }
    return acc;
}
__device__ __forceinline__ float dot64_bf(const v4u (&q)[8], const float* krow) {
    const f32x4* kp = (const f32x4*)krow; float acc = 0.f;
#pragma unroll
    for (int i = 0; i < 8; ++i) { const f32x4 k0 = kp[2 * i], k1 = kp[2 * i + 1];
        acc += bflo(q[i].x) * k0[0] + bfhi(q[i].x) * k0[1] + bflo(q[i].y) * k0[2] + bfhi(q[i].y) * k0[3]
             + bflo(q[i].z) * k1[0] + bfhi(q[i].z) * k1[1] + bflo(q[i].w) * k1[2] + bfhi(q[i].w) * k1[3]; }
    return acc;
}


__device__ __forceinline__ void swa_prompt_mfma(const Args& A, LAS unsigned char* lds) {
    const int tid = threadIdx.x, lane = tid & 63, wave = __builtin_amdgcn_readfirstlane(tid >> 6);
    const int gw = blockIdx.x * NWAVES + wave, ngw = gridDim.x * NWAVES, l31 = lane & 31, hh = lane >> 5;
    LAS float* tab = (LAS float*)(lds + 8192);
    const bf16* QS = (const bf16*)(A.ws + WS_QS); const bf16* KS = (const bf16*)(A.ws + WS_KS); const bf16* VTS = (const bf16*)(A.ws + WS_VTS); bf16* AO = (bf16*)(A.ws + WS_AO);
    float* LSE = (float*)(A.ws + WS_LSE);
    const float* relb = (const float*)A.in[I_RELB];
    const float LOG2E = 1.4426950408889634f, c1 = 0.125f * LOG2E;
    __syncthreads();
    for (int e = tid; e < 12 * 129; e += NTHR) { const int head = e / 129, n = e - head * 129; tab[head * 132 + n] = relb[rel_bucket(n << (2 * (head >> 2))) * 12 + head] * LOG2E; }
    __syncthreads();
    for (int task = gw; task < NBP * 12 * 64; task += ngw) {
        const int blk = task & 63, bhd = task >> 6, head = bhd % 12, b = bhd / 12, g = head >> 2, lg = 2 * g;
        const int ncb = 64 >> lg, cls = blk / ncb, qb = blk - cls * ncb, ncls = SEQ >> lg;
        const int qpos = 32 * qb + l31, qtok = b * SEQ + (qpos << lg) + cls;
        pg8::bf16x8 qf[4];
#pragma unroll
        for (int ks = 0; ks < 4; ++ks) qf[ks] = *(const pg8::bf16x8*)(QS + (size_t)qtok * SWAW + head * 64 + 16 * ks + 8 * hh);
        f32x16 o[2];
#pragma unroll
        for (int i = 0; i < 2; ++i)
#pragma unroll
            for (int r = 0; r < 16; ++r) o[i][r] = 0.f;
        float m_run = -INFINITY, l_run = 0.f;
        const bf16* vbase = VTS + (size_t)((b * 12 + head) * 64 + l31) * SEQ + cls * ncls + 8 * hh;
        const LAS float* tb = tab + head * 132;
        const int kt0 = qb >= 4 ? qb - 4 : 0;
        pg8::bf16x8 kf[4], vf[2][2];
#define SWA_LOAD(kt) do { const int ktok = b * SEQ + ((32 * (kt) + l31) << lg) + cls; \
            _Pragma("unroll") for (int ks = 0; ks < 4; ++ks) kf[ks] = *(const pg8::bf16x8*)(KS + (size_t)ktok * SWAW + head * 64 + 16 * ks + 8 * hh); \
            _Pragma("unroll") for (int dvt = 0; dvt < 2; ++dvt) _Pragma("unroll") for (int s2 = 0; s2 < 2; ++s2) vf[dvt][s2] = *(const pg8::bf16x8*)(vbase + (size_t)(dvt * 32) * SEQ + 32 * (kt) + 16 * s2); } while (0)
        SWA_LOAD(kt0);
        for (int kt = kt0; kt <= qb; ++kt) {
            f32x16 S;
#pragma unroll
            for (int r = 0; r < 16; ++r) S[r] = 0.f;
#pragma unroll
            for (int ks = 0; ks < 4; ++ks) S = __builtin_amdgcn_mfma_f32_32x32x16_bf16(kf[ks], qf[ks], S, 0, 0, 0);
            pg8::bf16x8 vc[2][2];
#pragma unroll
            for (int dvt = 0; dvt < 2; ++dvt)
#pragma unroll
                for (int s2 = 0; s2 < 2; ++s2) vc[dvt][s2] = vf[dvt][s2];
            if (kt < qb) SWA_LOAD(kt + 1);
            float mx = -INFINITY;
            if (kt < qb && (kt > qb - 4)) {
                const LAS float* tq = tb + (qpos - 32 * kt - 4 * hh);
#pragma unroll
                for (int r = 0; r < 16; ++r) { const float x = S[r] * c1 + tq[-((r & 3) + 8 * (r >> 2))]; S[r] = x; mx = fmaxf(mx, x); }
            } else {
#pragma unroll
                for (int r = 0; r < 16; ++r) { const int kq = 32 * kt + (r & 3) + 8 * (r >> 2) + 4 * hh, n = qpos - kq; const bool ok = (n >= 0) && (n <= 128);
                    const float x = ok ? S[r] * c1 + tb[ok ? n : 0] : -INFINITY; S[r] = x; mx = fmaxf(mx, x); }
            }
            mx = fmaxf(mx, __shfl_xor(mx, 32));
            const float m_new = (mx > m_run + 8.0f) ? mx : m_run;
            const bool moved = __builtin_amdgcn_ballot_w64(m_new != m_run) != 0ull;
            const float alpha = __builtin_amdgcn_exp2f(m_run - m_new);
            float rs = 0.f;
#pragma unroll
            for (int r = 0; r < 16; ++r) { const float pv = __builtin_amdgcn_exp2f(S[r] - m_new); S[r] = pv; rs += pv; }
            rs += __shfl_xor(rs, 32);
            l_run = l_run * alpha + rs; m_run = m_new;
            if (moved) {
#pragma unroll
                for (int i = 0; i < 2; ++i)
#pragma unroll
                    for (int r = 0; r < 16; ++r) o[i][r] *= alpha;
            }
#pragma unroll
            for (int s2 = 0; s2 < 2; ++s2) { const int r0 = 8 * s2;
                v4u w; w.x = pk2(S[r0], S[r0 + 1]); w.y = pk2(S[r0 + 2], S[r0 + 3]); w.z = pk2(S[r0 + 4], S[r0 + 5]); w.w = pk2(S[r0 + 6], S[r0 + 7]);
                const pg8::bf16x8 pf = __builtin_bit_cast(pg8::bf16x8, w);
#pragma unroll
                for (int dvt = 0; dvt < 2; ++dvt) o[dvt] = __builtin_amdgcn_mfma_f32_32x32x16_bf16(vc[dvt][s2], pf, o[dvt], 0, 0, 0); }
        }
#undef SWA_LOAD
        const float inv = 1.0f / l_run;
        bf16* orow = AO + (size_t)qtok * SWAW + head * 64;
#pragma unroll
        for (int i = 0; i < 2; ++i)
#pragma unroll
            for (int q4 = 0; q4 < 4; ++q4) { v2u w; w.x = pk2(o[i][4 * q4] * inv, o[i][4 * q4 + 1] * inv); w.y = pk2(o[i][4 * q4 + 2] * inv, o[i][4 * q4 + 3] * inv);
                *(v2u*)(orow + i * 32 + 8 * q4 + 4 * hh) = w; }
        if (hh == 0) LSE[(size_t)qtok * 12 + head] = (m_run + log2f(l_run)) * 0.6931471805599453f;
    }
    __syncthreads();
}

__device__ __forceinline__ void swa_combine_phase(const Args& A) {
    int tg = threadIdx.x; asm volatile("" : "+v"(tg)); const int gt = blockIdx.x * NTHR + tg, ngt = gridDim.x * NTHR;
    bf16* AO = (bf16*)(A.ws + WS_AO); const float* LSE = (const float*)(A.ws + WS_LSE);
    for (int task0 = gt; task0 < MP * 12 * 8; task0 += 4 * ngt) {
        v4u w[4]; float l0[4], l1[4], l2[4]; v4u* ptr[4]; int gq[4];
#pragma unroll
        for (int q = 0; q < 4; ++q) { const int task = task0 + q * ngt; ptr[q] = nullptr;
            if (task < MP * 12 * 8) { const int ch = task & 7, head = (task >> 3) % 12, tok = task / 96, j = head & 3; gq[q] = head >> 2;
                l0[q] = LSE[(size_t)tok * 12 + j]; l1[q] = LSE[(size_t)tok * 12 + 4 + j]; l2[q] = LSE[(size_t)tok * 12 + 8 + j];
                ptr[q] = (v4u*)(AO + (size_t)tok * SWAW + head * 64 + ch * 8); w[q] = *ptr[q]; } }
#pragma unroll
        for (int q = 0; q < 4; ++q) if (ptr[q]) {
            const float mm = fmaxf(fmaxf(l0[q], l1[q]), l2[q]), a0 = __expf(l0[q] - mm), a1 = __expf(l1[q] - mm), a2 = __expf(l2[q] - mm);
            const float al = (gq[q] == 0 ? a0 : (gq[q] == 1 ? a1 : a2)) * __builtin_amdgcn_rcpf(a0 + a1 + a2);
            v4u o; o.x = pk2(bflo(w[q].x) * al, bfhi(w[q].x) * al); o.y = pk2(bflo(w[q].y) * al, bfhi(w[q].y) * al); o.z = pk2(bflo(w[q].z) * al, bfhi(w[q].z) * al); o.w = pk2(bflo(w[q].w) * al, bfhi(w[q].w) * al);
            *ptr[q] = o; }
    }
}

__device__ __forceinline__ void swa_attn_phase(const Args& A, LAS unsigned char* lds) {
    const int tid = threadIdx.x, lane = tid & 63, wave = __builtin_amdgcn_readfirstlane(tid >> 6);
    const int gw = blockIdx.x * NWAVES + wave, ngw = gridDim.x * NWAVES;
    LAS float* pw = (LAS float*)lds + wave * 192;
    const bf16* QS = (const bf16*)(A.ws + WS_QS); const bf16* KS = (const bf16*)(A.ws + WS_KS); const bf16* VS = (const bf16*)(A.ws + WS_VS); bf16* AO = (bf16*)(A.ws + WS_AO);
    const float* relb = (const float*)A.in[I_RELB];
    swa_prompt_mfma(A, lds);
    constexpr int VPIT = 68;
    LAS float* vb = (LAS float*)(lds + 16384) + (wave < 3 ? wave : 0) * (129 * VPIT + 64);
    static_assert(16384 + 3 * (129 * VPIT + 64) * 4 <= RING_BYTES, "swa sample LDS map");
    const int G = gridDim.x;
    for (int task = (wave < 3) ? wave * G + (int)blockIdx.x : (1 << 30); task < MS * 4; task += 3 * G) {
        const int r = MP + (task >> 2), j = task & 3, b = (r - MP) >> 2, t = (r - MP) & 3;
        float og[3], lseg[3];
#pragma unroll
        for (int g = 0; g < 3; ++g) {
            const int head = g * 4 + j, dil = 1 << (2 * g), lb = 128 << (2 * g);
            const float* cache = (const float*)A.in[I_SWA0 + g];
            v4u qv[8];
#pragma unroll
            for (int i = 0; i < 8; ++i) qv[i] = ((const v4u*)(QS + (size_t)r * SWAW + head * 64))[i];
            float s[3];
#pragma unroll
            for (int kk = 0; kk < 3; ++kk) {
                const int n = lane + 64 * kk; float sc = -INFINITY;
                if (n <= 128) { const int idx = lb + t - n * dil; float d;
                    if (idx >= lb) d = dot64_bb(qv, KS + (size_t)(MP + b * 4 + idx - lb) * SWAW + head * 64);
                    else d = dot64_bf(qv, cache + ((size_t)((b * lb + idx) * 2 + 0) * 4 + j) * 64);
                    sc = d * 0.125f + relb[rel_bucket(n * dil) * 12 + head]; }
                s[kk] = sc;
            }
            const float mx = wave_max(fmaxf(fmaxf(s[0], s[1]), s[2]));
            float e[3];
#pragma unroll
            for (int kk = 0; kk < 3; ++kk) e[kk] = (s[kk] == -INFINITY) ? 0.f : __expf(s[kk] - mx);
            const float sum = wave_sum(e[0] + e[1] + e[2]), inv = 1.0f / sum;
            lseg[g] = mx + __logf(sum);
#pragma unroll
            for (int kk = 0; kk < 3; ++kk) {
                const int n = lane + 64 * kk;
                if (n <= 128) { const int idx = lb + t - n * dil; const float pn = e[kk] * inv; LAS f32x4* dst = (LAS f32x4*)(vb + n * VPIT);
                    if (idx >= lb) { const v4u* vp = (const v4u*)(VS + (size_t)(MP + b * 4 + idx - lb) * SWAW + head * 64);
#pragma unroll
                        for (int i = 0; i < 8; ++i) { const v4u w = vp[i]; dst[2 * i] = (f32x4){bflo(w.x) * pn, bfhi(w.x) * pn, bflo(w.y) * pn, bfhi(w.y) * pn}; dst[2 * i + 1] = (f32x4){bflo(w.z) * pn, bfhi(w.z) * pn, bflo(w.w) * pn, bfhi(w.w) * pn}; } }
                    else { const f32x4* vp = (const f32x4*)(cache + ((size_t)((b * lb + idx) * 2 + 1) * 4 + j) * 64);
#pragma unroll
                        for (int i = 0; i < 16; ++i) dst[i] = vp[i] * pn; } }
            }
            LDS_WAIT(); __builtin_amdgcn_wave_barrier();
            float o = 0.f;
#pragma unroll 43
            for (int n = 0; n <= 128; ++n) o += vb[n * VPIT + lane];
            og[g] = o;
            LDS_WAIT(); __builtin_amdgcn_wave_barrier();
        }
        const float mm = fmaxf(fmaxf(lseg[0], lseg[1]), lseg[2]);
        const float a0 = __expf(lseg[0] - mm), a1 = __expf(lseg[1] - mm), a2 = __expf(lseg[2] - mm), inv = 1.0f / (a0 + a1 + a2);
        AO[(size_t)r * SWAW + (0 * 4 + j) * 64 + lane] = (bf16)f2bf(og[0] * a0 * inv);
        AO[(size_t)r * SWAW + (1 * 4 + j) * 64 + lane] = (bf16)f2bf(og[1] * a1 * inv);
        AO[(size_t)r * SWAW + (2 * 4 + j) * 64 + lane] = (bf16)f2bf(og[2] * a2 * inv);
    }
}

__device__ __forceinline__ float diff_lambda(const float* lp, int lane, float lam_init) {
    const float s1 = wave_sum(lp[lane] * lp[64 + lane]), s2 = wave_sum(lp[128 + lane] * lp[192 + lane]);
    return __expf(s1) - __expf(s2) + lam_init;
}

__device__ __forceinline__ void diff_attn_prompt_phase(const Args& A, LAS unsigned char* lds, float lam_init) {
    const int tid = threadIdx.x, lane = tid & 63, wave = __builtin_amdgcn_readfirstlane(tid >> 6);
    const int gw = blockIdx.x * NWAVES + wave, ngw = gridDim.x * NWAVES;
    LAS float* pw = (LAS float*)lds + wave * 128;
    const bf16* QD = (const bf16*)(A.ws + WS_QD); const bf16* KD = (const bf16*)(A.ws + WS_KD); const bf16* VD = (const bf16*)(A.ws + WS_VD); bf16* AOD = (bf16*)(A.ws + WS_AOD);
    const float* relb = (const float*)A.in[I_RELB]; const float* onorm = (const float*)A.in[I_DON];
    const float lam = diff_lambda((const float*)A.in[I_DLAM], lane, lam_init);
    const float on0 = onorm[2 * lane], on1 = onorm[2 * lane + 1];
    for (int it = gw; it < NBP * 12 * SEQ; it += ngw) {
        const int hb = it % 96, i = it / 96; const int b = hb / 12, h = hb - b * 12, g = h / 3;
        const int row = b * SEQ + i;
        v4u q0[8], q1[8];
#pragma unroll
        for (int k = 0; k < 8; ++k) { q0[k] = ((const v4u*)(QD + (size_t)row * DQW + (h * 2 + 0) * 64))[k]; q1[k] = ((const v4u*)(QD + (size_t)row * DQW + (h * 2 + 1) * 64))[k]; }
        float m0 = -INFINITY, m1 = -INFINITY, l0 = 0.f, l1 = 0.f, o00 = 0.f, o01 = 0.f, o10 = 0.f, o11 = 0.f;
#pragma unroll 1
        for (int jb = 0; jb <= (i >> 6); ++jb) {
            const int jj = jb * 64 + lane; float s0 = -INFINITY, s1 = -INFINITY;
            if (jj <= i) { const bf16* krow = KD + (size_t)(b * SEQ + jj) * DKW + g * 128; const float bias = relb[rel_bucket(i - jj) * 12 + h];
                s0 = dot64_bb(q0, krow) * 0.125f + bias; s1 = dot64_bb(q1, krow + 64) * 0.125f + bias; }
            const float mn0 = fmaxf(m0, wave_max(s0)), mn1 = fmaxf(m1, wave_max(s1));
            const float c0 = __expf(m0 - mn0), c1 = __expf(m1 - mn1);
            const float p0 = (jj <= i) ? __expf(s0 - mn0) : 0.f, p1 = (jj <= i) ? __expf(s1 - mn1) : 0.f;
            l0 = l0 * c0 + wave_sum(p0); l1 = l1 * c1 + wave_sum(p1);
            o00 *= c0; o01 *= c0; o10 *= c1; o11 *= c1; m0 = mn0; m1 = mn1;
            pw[lane] = p0; pw[64 + lane] = p1;
            LDS_WAIT(); __builtin_amdgcn_wave_barrier();
            const int nv = (i - jb * 64 + 1) < 64 ? (i - jb * 64 + 1) : 64;
#pragma unroll 4
            for (int k = 0; k < nv; ++k) { const float pp0 = pw[k], pp1 = pw[64 + k];
                const unsigned vv = *(const unsigned*)(VD + (size_t)(b * SEQ + jb * 64 + k) * DKW + g * 128 + 2 * lane);
                const float v0 = bflo(vv), v1 = bfhi(vv);
                o00 += pp0 * v0; o01 += pp0 * v1; o10 += pp1 * v0; o11 += pp1 * v1; }
            LDS_WAIT(); __builtin_amdgcn_wave_barrier();
        }
        const float i0 = 1.0f / l0, i1 = 1.0f / l1;
        const float a0 = o00 * i0 - lam * o10 * i1, a1 = o01 * i0 - lam * o11 * i1;
        const float ssq = wave_sum(a0 * a0 + a1 * a1), rr = rsqrtf(ssq * (1.0f / 128.0f) + EPS) * (1.0f - lam_init);
        *(unsigned*)(AOD + (size_t)row * DQW + h * 128 + 2 * lane) = pk2(a0 * rr * on0, a1 * rr * on1);
    }
}

__device__ __forceinline__ void diff_attn_prompt_mfma(const Args& A, LAS unsigned char* lds, float lam_init, int cidx, int ncu) {
    const int tid = threadIdx.x, lane = tid & 63, wave = __builtin_amdgcn_readfirstlane(tid >> 6);
    const int l31 = lane & 31, hh = lane >> 5, rg = wave >> 1, m = wave & 1;
    constexpr int KPITCH = 272, VPITCH = 144, KT_BYTES = 64 * KPITCH, VT_BYTES = 128 * VPITCH, BUF_BYTES = KT_BYTES + VT_BYTES;
    constexpr int VB_OFF = 2 * KT_BYTES;
    constexpr int L1_OFF = 2 * KT_BYTES + 3 * VT_BYTES;
    constexpr int CP_OFF = L1_OFF + 1024, CP_STRIDE = 2192;
    static_assert(CP_OFF + 4 * CP_STRIDE * 4 <= RING_BYTES, "diff attention LDS map");
    LAS float* cpy = (LAS float*)(lds + CP_OFF);
    LAS float* ex = (LAS float*)lds;
    LAS float* exl = (LAS float*)(lds + L1_OFF);
    const bf16* QD = (const bf16*)(A.ws + WS_QD); const bf16* KD = (const bf16*)(A.ws + WS_KD); const bf16* VTD = (const bf16*)(A.ws + WS_VTD); bf16* AOD = (bf16*)(A.ws + WS_AOD);
    const float* relb = (const float*)A.in[I_RELB]; const float* onorm = (const float*)A.in[I_DON];
    const float lam = diff_lambda((const float*)A.in[I_DLAM], lane, lam_init);
    const float LOG2E = 1.4426950408889634f, c1 = 0.125f * LOG2E;
    const int c = cidx, Gd = ncu;
    for (int ui = 0; ; ++ui) {
        const int rnd = ui, base = rnd * Gd; const int k = (rnd & 1) ? base + (Gd - 1 - c) : base + c;
        if (base >= 1536) break;
        __syncthreads();
        if (k < 1536) {
        const int qblk = 15 - k / 96, bh = k % 96, b = bh / 12, h = bh - b * 12, g = h / 3;
        for (int i = tid; i < 2176; i += NTHR) { const int d = 2048 - i; cpy[i] = (d >= 0 && d < 2048) ? relb[rel_bucket(d) * 12 + h] * 8.0f : 0.f; }
        __syncthreads();
        for (int n = tid; n < 3 * 2176; n += NTHR) { const int sc = 1 + n / 2176, i = n - (sc - 1) * 2176; cpy[sc * CP_STRIDE + i] = (i >= sc) ? cpy[i - sc] : 0.f; }
        const int q_abs = qblk * 128 + rg * 32 + l31, row = b * SEQ + q_abs;
        pg8::bf16x8 qf[4];
#pragma unroll
        for (int ks = 0; ks < 4; ++ks) qf[ks] = *(const pg8::bf16x8*)(QD + (size_t)row * DQW + (h * 2 + m) * 64 + 16 * ks + 8 * hh);
        f32x16 o[4];
#pragma unroll
        for (int i = 0; i < 4; ++i)
#pragma unroll
            for (int r = 0; r < 16; ++r) o[i][r] = 0.f;
        float m_run = -INFINITY, l_run = 0.f;
        const float THRU = 8.0f / c1;
        const LAS float* cb = cpy + (l31 & 3) * CP_STRIDE + ((l31 & 3) + 2048 - q_abs + 4 * hh);
        const int ntiles = 2 * qblk + 2, my_last = 2 * qblk + (rg >> 1);
        const int kkey = tid >> 4, kc = tid & 15, vdv = tid >> 3, vc = tid & 7;
        const char* ksrc = (const char*)(KD + (size_t)(b * SEQ) * DKW + g * 128);
        const char* vsrc = (const char*)(VTD + (size_t)((b * 4 + g) * 128) * SEQ);
        const unsigned koff = (unsigned)((kkey * DKW + kc * 8) * 2), voff = (unsigned)((vdv * SEQ + vc * 8) * 2);
        const int kdst = kkey * KPITCH + kc * 16, vdst = VB_OFF + vdv * VPITCH + vc * 16;
        v4u sa0, sa1, sa2, sa3;
#define DA_LOAD(R0, R1, R2, R3, t) do { const char* ks2 = ksrc + (size_t)(t) * 64 * DKW * 2; const char* vs2 = vsrc + (t) * 128; \
            R0 = *(const v4u*)(ks2 + koff); R1 = *(const v4u*)(ks2 + (size_t)32 * DKW * 2 + koff); R2 = *(const v4u*)(vs2 + voff); R3 = *(const v4u*)(vs2 + (size_t)64 * SEQ * 2 + voff); } while (0)
#define DA_STORE(R0, R1, R2, R3, t, vo) do { LAS unsigned char* nk = lds + ((t) & 1) * KT_BYTES + kdst; LAS unsigned char* nv = lds + (vo) + vdst; \
            *(LAS v4u*)(nk) = R0; *(LAS v4u*)(nk + 32 * KPITCH) = R1; *(LAS v4u*)(nv) = R2; *(LAS v4u*)(nv + 64 * VPITCH) = R3; } while (0)
#define DA_PV(vo) do { LAS unsigned char* Vb = lds + VB_OFF + (vo); \
_Pragma("unroll") \
            for (int kk = 0; kk < 4; ++kk) \
_Pragma("unroll") \
                for (int dvt = 0; dvt < 4; ++dvt) { const pg8::bf16x8 a = *(const LAS pg8::bf16x8*)(Vb + (dvt * 32 + l31) * VPITCH + kk * 32 + hh * 16); \
                    o[dvt] = __builtin_amdgcn_mfma_f32_32x32x16_bf16(a, pfp[kk], o[dvt], 0, 0, 0); } \
        } while (0)
#define DA_COMPUTE(kt) do { \
                LAS unsigned char* Kb = lds + (kt & 1) * KT_BYTES; \
                const bool offdiag = kt * 64 + 63 <= qblk * 128 + rg * 32; \
                f32x16 S[2]; \
                { const LAS float* cq = cb + kt * 64;        \
_Pragma("unroll") \
                    for (int sub = 0; sub < 2; ++sub) \
_Pragma("unroll") \
                        for (int j = 0; j < 4; ++j) { const f32x4 t4 = *(const LAS f32x4*)(cq + sub * 32 + 8 * j); \
                            S[sub][4 * j] = t4[0]; S[sub][4 * j + 1] = t4[1]; S[sub][4 * j + 2] = t4[2]; S[sub][4 * j + 3] = t4[3]; } \
                } \
_Pragma("unroll") \
                for (int ks = 0; ks < 4; ++ks) \
_Pragma("unroll") \
                    for (int sub = 0; sub < 2; ++sub) { const pg8::bf16x8 a = *(const LAS pg8::bf16x8*)(Kb + (sub * 32 + l31) * KPITCH + m * 128 + ks * 32 + hh * 16); \
                        S[sub] = __builtin_amdgcn_mfma_f32_32x32x16_bf16(a, qf[ks], S[sub], 0, 0, 0); } \
                if (!offdiag) { \
_Pragma("unroll") \
                    for (int sub = 0; sub < 2; ++sub) \
_Pragma("unroll") \
                        for (int r = 0; r < 16; ++r) { const int key = kt * 64 + sub * 32 + (r & 3) + 8 * (r >> 2) + 4 * hh; const int d = q_abs - key; \
                            S[sub][r] = d < 0 ? -INFINITY : S[sub][r]; } \
                } \
                  \
                float mx0 = -INFINITY, mx1 = -INFINITY; \
_Pragma("unroll") \
                for (int r = 0; r < 16; ++r) { mx0 = fmaxf(mx0, S[0][r]); mx1 = fmaxf(mx1, S[1][r]); } \
                float mx = fmaxf(mx0, mx1); \
                mx = fmaxf(mx, __shfl_xor(mx, 32)); \
                const float m_new = (mx > m_run + THRU) ? mx : m_run; \
                const bool moved = __builtin_amdgcn_ballot_w64(m_new != m_run) != 0ull; \
                const float alpha = __builtin_amdgcn_exp2f((m_run - m_new) * c1); \
                const float nmc = -m_new * c1; \
                DA_PV(vo_prev); \
                float rs0 = 0.f, rs1 = 0.f; \
_Pragma("unroll") \
                for (int r = 0; r < 16; ++r) { const float p0 = __builtin_amdgcn_exp2f(__builtin_fmaf(S[0][r], c1, nmc)); S[0][r] = p0; rs0 += p0; \
                    const float p1 = __builtin_amdgcn_exp2f(__builtin_fmaf(S[1][r], c1, nmc)); S[1][r] = p1; rs1 += p1; } \
                float rs = rs0 + rs1; \
                rs += __shfl_xor(rs, 32); \
                l_run = l_run * alpha + rs; m_run = m_new; \
_Pragma("unroll") \
                for (int kk = 0; kk < 4; ++kk) { const int sub = kk >> 1, r0 = (kk & 1) * 8; \
                    v4u w; w.x = pk2(S[sub][r0], S[sub][r0 + 1]); w.y = pk2(S[sub][r0 + 2], S[sub][r0 + 3]); w.z = pk2(S[sub][r0 + 4], S[sub][r0 + 5]); w.w = pk2(S[sub][r0 + 6], S[sub][r0 + 7]); \
                    pfp[kk] = __builtin_bit_cast(pg8::bf16x8, w); } \
                if (moved) { \
_Pragma("unroll") \
                    for (int i = 0; i < 4; ++i) \
_Pragma("unroll") \
                        for (int r = 0; r < 16; ++r) o[i][r] *= alpha; \
                } \
        } while (0)
        pg8::bf16x8 pfp[4];
#pragma unroll
        for (int kk = 0; kk < 4; ++kk) pfp[kk] = __builtin_bit_cast(pg8::bf16x8, v4u{0u, 0u, 0u, 0u});
        int vo_prev = 0, vo_cur = 0, vo_next = VT_BYTES, vo_free = 2 * VT_BYTES;
        DA_LOAD(sa0, sa1, sa2, sa3, 0); DA_STORE(sa0, sa1, sa2, sa3, 0, 0);
        __syncthreads();
#pragma unroll 1
        for (int kt = 0; kt < ntiles; ++kt) {
            if (kt + 1 < ntiles) DA_LOAD(sa0, sa1, sa2, sa3, kt + 1);
            DA_COMPUTE(kt);
            if (kt + 1 < ntiles) DA_STORE(sa0, sa1, sa2, sa3, kt + 1, vo_next);
            { const int t = (kt == 0) ? vo_free : vo_prev; vo_prev = vo_cur; vo_cur = vo_next; vo_next = t; }
            __syncthreads();
        }
        DA_PV(vo_prev);
        __syncthreads();
#undef DA_PV
#undef DA_COMPUTE
#undef DA_LOAD
#undef DA_STORE
        const float inv_l = 1.0f / l_run;
        if (m == 1) {
#pragma unroll
            for (int i = 0; i < 4; ++i)
#pragma unroll
                for (int r = 0; r < 16; ++r) ex[(rg * 64 + i * 16 + r) * 64 + lane] = o[i][r] * inv_l;
        }
        __syncthreads();
        if (m == 0) {
            float ssq = 0.f; float lam2 = lam; asm volatile("" : "+v"(lam2));
#pragma unroll
            for (int i = 0; i < 4; ++i)
#pragma unroll
                for (int r = 0; r < 16; ++r) { const float a = o[i][r] * inv_l - lam2 * ex[(rg * 64 + i * 16 + r) * 64 + lane]; o[i][r] = a; ssq += a * a; }
            ssq += __shfl_xor(ssq, 32);
            const float rr = rsqrtf(ssq * (1.0f / 128.0f) + EPS) * (1.0f - lam_init);
            int hh4 = 4 * hh; asm volatile("" : "+v"(hh4)); const float* onb = onorm + hh4; bf16* orow = AOD + (size_t)row * DQW + h * 128 + hh4;
#pragma unroll
            for (int i = 0; i < 4; ++i)
#pragma unroll
                for (int q4 = 0; q4 < 4; ++q4) { const int dv0 = i * 32 + 8 * q4; const f32x4 on = *(const f32x4*)(onb + dv0);
                    v2u w; w.x = pk2(o[i][4 * q4] * rr * on[0], o[i][4 * q4 + 1] * rr * on[1]); w.y = pk2(o[i][4 * q4 + 2] * rr * on[2], o[i][4 * q4 + 3] * rr * on[3]);
                    *(v2u*)(orow + dv0) = w; }
        }
        }
    }
    __syncthreads();
    (void)exl;
}

__device__ __forceinline__ void diff_sample_partial_phase(const Args& A, LAS unsigned char* lds) {
    const int tid = threadIdx.x, lane = tid & 63, wave = __builtin_amdgcn_readfirstlane(tid >> 6);
    LAS float* qs = (LAS float*)lds;
    LAS float* sc = qs + 24 * 64;
    LAS float* ml = sc + 1024 * 24;
    LAS int* pg = (LAS int*)(ml + 32);
    const bf16* QD = (const bf16*)(A.ws + WS_QD); float* PART = (float*)(A.ws + WS_PART);
    const float* ck = (const float*)A.in[I_DCK]; const float* cv = (const float*)A.in[I_DCV]; const int* pt = (const int*)A.in[I_PT];
    const float* relb = (const float*)A.in[I_RELB];
    for (int u = blockIdx.x; u < 1024; u += gridDim.x) {
        const int b = u >> 5, g = (u >> 3) & 3, c = u & 7;
        __syncthreads();
        for (int e = tid; e < 24 * 64; e += NTHR) { const int qi = e >> 6, d = e & 63, m = qi / 12, tr = qi - m * 12, t = tr / 3, r = tr - t * 3;
            qs[e] = bf2f(QD[(size_t)(MP + b * 4 + t) * DQW + ((g * 3 + r) * 2 + m) * 64 + d]); }
        if (tid < 8) pg[tid] = pt[b * 64 + c * 8 + tid];
        __syncthreads();
        {
            const int phys = pg[wave];
#pragma unroll 1
            for (int ks = 0; ks < 2; ++ks) {
                const int slot = lane + 64 * ks;
                const float* kb = ck + ((size_t)(phys * 128 + slot) * 4 + g) * 128;
                float acc[24];
#pragma unroll
                for (int q = 0; q < 24; ++q) acc[q] = 0.f;
#pragma unroll 1
                for (int dc = 0; dc < 16; ++dc) {
                    const f32x4 k0 = *(const f32x4*)(kb + 4 * dc), k1 = *(const f32x4*)(kb + 64 + 4 * dc);
#pragma unroll
                    for (int q = 0; q < 12; ++q) { const f32x4 qa = *(const LAS f32x4*)(qs + q * 64 + 4 * dc), qb = *(const LAS f32x4*)(qs + (12 + q) * 64 + 4 * dc);
                        acc[q] += (qa[0] * k0[0] + qa[1] * k0[1]) + (qa[2] * k0[2] + qa[3] * k0[3]);
                        acc[12 + q] += (qb[0] * k1[0] + qb[1] * k1[1]) + (qb[2] * k1[2] + qb[3] * k1[3]); }
                }
                const int kpos = (c * 8 + wave) * 128 + slot, kl = wave * 128 + slot;
#pragma unroll
                for (int t = 0; t < 4; ++t) { const int bk = rel_bucket(PAST + t - kpos);
#pragma unroll
                    for (int r = 0; r < 3; ++r) { const float bias = relb[bk * 12 + g * 3 + r];
                        sc[kl * 24 + t * 3 + r] = acc[t * 3 + r] * 0.125f + bias; sc[kl * 24 + 12 + t * 3 + r] = acc[12 + t * 3 + r] * 0.125f + bias; } }
            }
        }
        __syncthreads();
        for (int qi = wave; qi < 24; qi += NWAVES) {
            float mx = -INFINITY;
            for (int k = lane; k < 1024; k += 64) mx = fmaxf(mx, sc[k * 24 + qi]);
            mx = wave_max(mx);
            float sm = 0.f;
            for (int k = lane; k < 1024; k += 64) { const float p = __expf(sc[k * 24 + qi] - mx); sc[k * 24 + qi] = p; sm += p; }
            sm = wave_sum(sm);
            if (lane == 0) { PART[((size_t)u * 24 + qi) * PART_STRIDE + 128] = mx; PART[((size_t)u * 24 + qi) * PART_STRIDE + 129] = sm; }
        }
        __syncthreads();
        {
            const int dv = tid & 127, qg = tid >> 7;
            float o[6] = {0.f, 0.f, 0.f, 0.f, 0.f, 0.f};
            for (int kl = 0; kl < 1024; ++kl) {
                const int phys = pg[kl >> 7], slot = kl & 127;
                const float v = cv[((size_t)(phys * 128 + slot) * 4 + g) * 128 + dv];
                const LAS f32x2* pp = (const LAS f32x2*)(sc + kl * 24 + qg * 6);
                const f32x2 pa = pp[0], pb = pp[1], pc = pp[2];
                o[0] += pa[0] * v; o[1] += pa[1] * v; o[2] += pb[0] * v; o[3] += pb[1] * v; o[4] += pc[0] * v; o[5] += pc[1] * v;
            }
#pragma unroll
            for (int q = 0; q < 6; ++q) PART[((size_t)u * 24 + qg * 6 + q) * PART_STRIDE + dv] = o[q];
        }
    }
}


__device__ __forceinline__ void diff_sample_partial_mfma(const Args& A, LAS unsigned char* lds, int cidx, int ncu) {
    int tid = threadIdx.x; asm volatile("" : "+v"(tid));
    const int lane = tid & 63, wave = __builtin_amdgcn_readfirstlane(tid >> 6);
    const int r = lane & 15, c4 = lane >> 4;
    LAS float* ow = (LAS float*)lds;
    static_assert(8 * 24 * 132 * 4 <= RING_BYTES, "diff sample LDS map");
    const bf16* QD = (const bf16*)(A.ws + WS_QD); float* PART = (float*)(A.ws + WS_PART);
    const float* ck = (const float*)A.in[I_DCK]; const float* cv = (const float*)A.in[I_DCV]; const int* pt = (const int*)A.in[I_PT];
    const float* relb = (const float*)A.in[I_RELB];
    const int tq = r / 3, rep = r - tq * 3;
    for (int u = cidx; u < 1024; u += ncu) {
        const int b = u >> 5, g = (u >> 3) & 3, cc = u & 7, head = g * 3 + rep;
        __syncthreads();
        pg8::bf16x8 qf[2][2];
#pragma unroll
        for (int m = 0; m < 2; ++m)
#pragma unroll
            for (int ks = 0; ks < 2; ++ks) { v4u w = (v4u){0u, 0u, 0u, 0u};
                if (r < 12) w = *(const v4u*)(QD + (size_t)(MP + b * 4 + tq) * DQW + (head * 2 + m) * 64 + 16 * c4 + 8 * ks);
                qf[m][ks] = __builtin_bit_cast(pg8::bf16x8, w); }
        const int phys = pt[b * 64 + cc * 8 + wave], page_start = (cc * 8 + wave) * 128;
        const float* kp = ck + (size_t)phys * 128 * 512 + g * 128 + (size_t)r * 512 + 16 * c4;
        const float* vp = cv + (size_t)phys * 128 * 512 + g * 128 + (size_t)(4 * c4) * 512 + 8 * r;
        const bool far = (PAST - (page_start + 127)) >= 2048;
        const float bfar = (r < 12) ? relb[31 * 12 + head] : 0.f;
        f32x4 oacc[2][8];
#pragma unroll
        for (int m = 0; m < 2; ++m)
#pragma unroll
            for (int d = 0; d < 8; ++d) oacc[m][d] = (f32x4){0.f, 0.f, 0.f, 0.f};
        float m_run0 = -INFINITY, m_run1 = -INFINITY, l_run0 = 0.f, l_run1 = 0.f;
#pragma unroll 1
        for (int sb = 0; sb < 4; ++sb) {
            f32x4 S[2][2];
#pragma unroll
            for (int tt = 0; tt < 2; ++tt) { const float* kr = kp + (size_t)(sb * 32 + tt * 16) * 512;
#pragma unroll
                for (int m = 0; m < 2; ++m) { S[m][tt] = (f32x4){0.f, 0.f, 0.f, 0.f};
#pragma unroll
                    for (int ks = 0; ks < 2; ++ks) { const f32x4 a = *(const f32x4*)(kr + m * 64 + 8 * ks), a2 = *(const f32x4*)(kr + m * 64 + 8 * ks + 4);
                        v4u w; w.x = pk2(a[0], a[1]); w.y = pk2(a[2], a[3]); w.z = pk2(a2[0], a2[1]); w.w = pk2(a2[2], a2[3]);
                        S[m][tt] = __builtin_amdgcn_mfma_f32_16x16x32_bf16(__builtin_bit_cast(pg8::bf16x8, w), qf[m][ks], S[m][tt], 0, 0, 0); } } }
            float bias[2][4];
#pragma unroll
            for (int tt = 0; tt < 2; ++tt)
#pragma unroll
                for (int q = 0; q < 4; ++q) { float bv = bfar;
                    if (!far) { const int kpos = page_start + sb * 32 + tt * 16 + 4 * c4 + q; bv = (r < 12) ? relb[rel_bucket(PAST + tq - kpos) * 12 + head] : 0.f; }
                    bias[tt][q] = bv; }
            pg8::bf16x8 pf[2];
#pragma unroll
            for (int m = 0; m < 2; ++m) {
                float mx = -INFINITY;
#pragma unroll
                for (int tt = 0; tt < 2; ++tt)
#pragma unroll
                    for (int q = 0; q < 4; ++q) { const float x = S[m][tt][q] * 0.125f + bias[tt][q]; S[m][tt][q] = x; mx = fmaxf(mx, x); }
                mx = fmaxf(mx, __shfl_xor(mx, 16)); mx = fmaxf(mx, __shfl_xor(mx, 32));
                const float m_old = m ? m_run1 : m_run0, m_new = fmaxf(m_old, mx), alpha = __expf(m_old - m_new);
                float rs = 0.f;
#pragma unroll
                for (int tt = 0; tt < 2; ++tt)
#pragma unroll
                    for (int q = 0; q < 4; ++q) { const float pv = __expf(S[m][tt][q] - m_new); S[m][tt][q] = pv; rs += pv; }
                rs += __shfl_xor(rs, 16); rs += __shfl_xor(rs, 32);
                if (m) { l_run1 = l_run1 * alpha + rs; m_run1 = m_new; } else { l_run0 = l_run0 * alpha + rs; m_run0 = m_new; }
#pragma unroll
                for (int d = 0; d < 8; ++d) oacc[m][d] = oacc[m][d] * alpha;
                v4u w; w.x = pk2(S[m][0][0], S[m][0][1]); w.y = pk2(S[m][0][2], S[m][0][3]); w.z = pk2(S[m][1][0], S[m][1][1]); w.w = pk2(S[m][1][2], S[m][1][3]);
                pf[m] = __builtin_bit_cast(pg8::bf16x8, w);
            }
            const float* vr = vp + (size_t)(sb * 32) * 512;
#pragma unroll
            for (int hf = 0; hf < 2; ++hf) {
                __builtin_amdgcn_sched_barrier(0);
                f32x4 vv[8];
#pragma unroll
                for (int jj = 0; jj < 8; ++jj) vv[jj] = *(const f32x4*)(vr + (size_t)(16 * (jj >> 2) + (jj & 3)) * 512 + 4 * hf);
#pragma unroll
                for (int d = 0; d < 4; ++d) { v4u w; w.x = pk2(vv[0][d], vv[1][d]); w.y = pk2(vv[2][d], vv[3][d]); w.z = pk2(vv[4][d], vv[5][d]); w.w = pk2(vv[6][d], vv[7][d]);
                    const pg8::bf16x8 vf = __builtin_bit_cast(pg8::bf16x8, w);
                    oacc[0][4 * hf + d] = __builtin_amdgcn_mfma_f32_16x16x32_bf16(vf, pf[0], oacc[0][4 * hf + d], 0, 0, 0);
                    oacc[1][4 * hf + d] = __builtin_amdgcn_mfma_f32_16x16x32_bf16(vf, pf[1], oacc[1][4 * hf + d], 0, 0, 0); }
                __builtin_amdgcn_sched_barrier(0);
            }
        }
        if (r < 12) {
#pragma unroll
            for (int m = 0; m < 2; ++m) { LAS float* dst = ow + (wave * 24 + m * 12 + r) * 132;
#pragma unroll
                for (int q = 0; q < 4; ++q) { *(LAS f32x4*)(dst + 32 * c4 + 8 * q) = (f32x4){oacc[m][0][q], oacc[m][1][q], oacc[m][2][q], oacc[m][3][q]};
                    *(LAS f32x4*)(dst + 32 * c4 + 8 * q + 4) = (f32x4){oacc[m][4][q], oacc[m][5][q], oacc[m][6][q], oacc[m][7][q]}; }
                if (c4 == 0) { dst[128] = m ? m_run1 : m_run0; dst[129] = m ? l_run1 : l_run0; } }
        }
        __syncthreads();
        for (int idx = tid; idx < 24 * 128; idx += NTHR) { const int qi = idx >> 7, dv = idx & 127;
            float M = -INFINITY;
#pragma unroll
            for (int w = 0; w < 8; ++w) M = fmaxf(M, ow[(w * 24 + qi) * 132 + 128]);
            float o = 0.f, L = 0.f;
#pragma unroll
            for (int w = 0; w < 8; ++w) { const float e = __expf(ow[(w * 24 + qi) * 132 + 128] - M); o += ow[(w * 24 + qi) * 132 + dv] * e; L += ow[(w * 24 + qi) * 132 + 129] * e; }
            PART[((size_t)u * 24 + qi) * PART_STRIDE + dv] = o;
            if (dv == 0) { PART[((size_t)u * 24 + qi) * PART_STRIDE + 128] = M; PART[((size_t)u * 24 + qi) * PART_STRIDE + 129] = L; }
        }
    }
    __syncthreads();
}

__device__ __forceinline__ void diff_sample_combine_phase(const Args& A, float lam_init) {
    const int tid = threadIdx.x, lane = tid & 63, wave = __builtin_amdgcn_readfirstlane(tid >> 6);
    const int gw = blockIdx.x * NWAVES + wave, ngw = gridDim.x * NWAVES;
    const bf16* QD = (const bf16*)(A.ws + WS_QD); const bf16* KD = (const bf16*)(A.ws + WS_KD); const bf16* VD = (const bf16*)(A.ws + WS_VD); bf16* AOD = (bf16*)(A.ws + WS_AOD);
    const float* PART = (const float*)(A.ws + WS_PART);
    const float* relb = (const float*)A.in[I_RELB]; const float* onorm = (const float*)A.in[I_DON];
    const float lam = diff_lambda((const float*)A.in[I_DLAM], lane, lam_init);
    const float on0 = onorm[2 * lane], on1 = onorm[2 * lane + 1];
    for (int it = gw; it < NBS * 4 * 12; it += ngw) {
        const int b = it / 48, rem = it - b * 48, g = rem / 12, tr = rem - g * 12, t = tr / 3, r = tr - t * 3, h = g * 3 + r;
        const int row = MP + b * 4 + t;
        float res[2][2];
#pragma unroll
        for (int m = 0; m < 2; ++m) {
            const int qi = m * 12 + tr;
            const float qd = bf2f(QD[(size_t)row * DQW + (h * 2 + m) * 64 + lane]);
            float sn[4];
#pragma unroll
            for (int t2 = 0; t2 < 4; ++t2) { const float kd = bf2f(KD[(size_t)(MP + b * 4 + t2) * DKW + (g * 2 + m) * 64 + lane]);
                const float d = wave_sum(qd * kd); sn[t2] = (t2 <= t) ? d * 0.125f + relb[rel_bucket(t - t2) * 12 + h] : -INFINITY; }
            float M = fmaxf(fmaxf(sn[0], sn[1]), fmaxf(sn[2], sn[3]));
            float mc[8];
#pragma unroll
            for (int c = 0; c < 8; ++c) { mc[c] = PART[((size_t)((b * 4 + g) * 8 + c) * 24 + qi) * PART_STRIDE + 128]; M = fmaxf(M, mc[c]); }
            float Lsum = 0.f, o0 = 0.f, o1 = 0.f;
#pragma unroll
            for (int c = 0; c < 8; ++c) { const float* pp = PART + ((size_t)((b * 4 + g) * 8 + c) * 24 + qi) * PART_STRIDE; const float w = __expf(mc[c] - M);
                Lsum += pp[129] * w; const f32x2 ov = *(const f32x2*)(pp + 2 * lane); o0 += ov[0] * w; o1 += ov[1] * w; }
#pragma unroll
            for (int t2 = 0; t2 < 4; ++t2) { if (t2 <= t) { const float w = __expf(sn[t2] - M); Lsum += w;
                const unsigned vv = *(const unsigned*)(VD + (size_t)(MP + b * 4 + t2) * DKW + g * 128 + 2 * lane); o0 += w * bflo(vv); o1 += w * bfhi(vv); } }
            const float inv = 1.0f / Lsum; res[m][0] = o0 * inv; res[m][1] = o1 * inv;
        }
        const float a0 = res[0][0] - lam * res[1][0], a1 = res[0][1] - lam * res[1][1];
        const float ssq = wave_sum(a0 * a0 + a1 * a1), rr = rsqrtf(ssq * (1.0f / 128.0f) + EPS) * (1.0f - lam_init);
        *(unsigned*)(AOD + (size_t)row * DQW + h * 128 + 2 * lane) = pk2(a0 * rr * on0, a1 * rr * on1);
    }
}

constexpr int N_PHASES = 27;
__global__ void __launch_bounds__(NTHR, 2) hybrid_fwd(Args args) {
    extern __shared__ __attribute__((aligned(16))) unsigned char lds_raw[];
    LAS unsigned char* lds = (LAS unsigned char*)lds_raw;
    const int tid = threadIdx.x;
    volatile LAS unsigned* MISC = (volatile LAS unsigned*)(lds + MISC_OFF);
    for (int u = tid; u < (LDS_BYTES - LDSCTL_OFF) / 4; u += NTHR) ((LAS unsigned*)(lds + LDSCTL_OFF))[u] = 0u;
    __syncthreads();
    unsigned char* ws = args.ws;
    XcdBarrier bar; bar.bar = (unsigned*)(ws + WS_CTL) + CW_BAR; bar.x = 0; bar.st = nullptr;
#if !MK_PER_PHASE
    bar = xcd_barrier_post((unsigned*)(ws + WS_CTL) + CW_BAR, MISC + 8);
#endif
    const int lo = args.ph_lo, hi = args.ph_hi, G = gridDim.x, bx = blockIdx.x;
#define IN(k) (lo <= (k) && (k) < hi)
#if MK_PER_PHASE
#define SEAM(k) do { } while (0)
#else
#define SEAM(k) do { if (IN((k) + 1)) xcd_barrier(bar); } while (0)
#endif
    float* SS = (float*)(ws + WS_SS);
    bf16* XB = (bf16*)(ws + WS_XB);
    const float lam_init2 = 0.47071301f;

#define GEMM_PHASE(EPI, E, Aptr, Bptr, Ncols, Kdim) do { pg8::Gemm g_{(const pg8::bf16_t*)(Aptr), (const pg8::bf16_t*)(Bptr), MP, (Ncols), (Kdim)}; pg8::StaticOrder S_; S_.init(MP, (Ncols), G, bx); \
        pg8::gemm_phase<EPI, pg8::StaticOrder, true, true>(lds, g_, S_, E); } while (0)

    int ph = 0;
    if (IN(0)) { for (int rep = 0; rep < REP_PRO; ++rep) { prologue_phase(args, lds); __syncthreads(); } SEAM(0); for (int rep = 0; rep < PROBE_BAR; ++rep) xcd_barrier(bar); }

#define SSD_LAYER(P, LI, SSIN, SSMID, FFL, SSOUT, FIN) \
    if (IN((P) + 0)) { EpiSsdIn E{(bf16*)(ws + WS_ZX), (float*)(ws + WS_DT), SS + (SSIN) * (MPAD * 16), (const float*)args.in[I_DTB] + (LI) * 32}; \
        if (PROBE_SSDIN) GEMM_PHASE(EpiSsdIn, E, XB, ws + WS_WSSDIN + (LI) * al4k(SZ_WSSDIN), ZXW, DM); GEMM_PHASE(EpiSsdIn, E, XB, ws + WS_WSSDIN + (LI) * al4k(SZ_WSSDIN), ZXW, DM); \
        sk_ssdin(args, (const bf16*)(ws + WS_WSSDIN + (LI) * al4k(SZ_WSSDIN)), SS + (SSIN) * (MPAD * 16), (const float*)args.in[I_DTB] + (LI) * 32, (64 * 20) % G); SEAM((P) + 0); } \
    if (IN((P) + 1)) { for (int rep = 0; rep < REP_PRE; ++rep) ssd_prepass_phase(args, (LI)); SEAM((P) + 1); } \
    if (IN((P) + 2)) { for (int rep = 0; rep < REP_SCAN; ++rep) { ssd_scan_phase(args, lds, (LI)); __syncthreads(); } SEAM((P) + 2); } \
    if (IN((P) + 3)) { ssd_gatenorm_phase(args, (LI), (bf16*)(ws + WS_YG)); if (PROBE_GN) ssd_gatenorm_phase(args, (LI), (bf16*)(ws + WS_ACT)); SEAM((P) + 3); } \
    if (IN((P) + 4)) { EpiRes E{XB, SS + (SSMID) * (MPAD * 16), nullptr, XB}; GEMM_PHASE(EpiRes, E, ws + WS_YG, ws + WS_WSSDOUT + (LI) * al4k(SZ_WSSDOUT), DM, DIN); \
        sk_res(args, (const bf16*)(ws + WS_YG), DIN, (const bf16*)(ws + WS_WSSDOUT + (LI) * al4k(SZ_WSSDOUT)), SS + (SSMID) * (MPAD * 16), nullptr, 0); SEAM((P) + 4); } \
    FFN_LAYER((P) + 5, FFL, SSMID, SSOUT, FIN)
#define FFN_LAYER(P, FFL, SSMID, SSOUT, FIN) \
    if (IN((P) + 0)) { EpiSwiGlu E{(bf16*)(ws + WS_ACT), SS + (SSMID) * (MPAD * 16)}; if (PROBE_FFIN == 1) { GEMM_PHASE(EpiSwiGlu, E, XB, ws + WS_WFFIN + (FFL) * al4k(SZ_WFFIN), 2 * DFF, DM); } if (PROBE_FFIN == 2) { EpiNone EN; GEMM_PHASE(EpiNone, EN, XB, ws + WS_WFFIN + (FFL) * al4k(SZ_WFFIN), 2 * DFF, DM); } GEMM_PHASE(EpiSwiGlu, E, XB, ws + WS_WFFIN + (FFL) * al4k(SZ_WFFIN), 2 * DFF, DM); \
        for (int rep = 0; rep < REP_SKSW; ++rep) sk_swiglu(args, (const bf16*)(ws + WS_WFFIN + (FFL) * al4k(SZ_WFFIN)), SS + (SSMID) * (MPAD * 16), (64 * 22) % G); for (int rep = 0; rep < REP_COPY; ++rep) cache_copy_slice(args, (FFL), 6, (64 * 22) % G); SEAM((P) + 0); } \
    if (IN((P) + 1)) { EpiRes E{XB, SS + ((SSOUT) & 7) * (MPAD * 16), (FIN) ? args.out : nullptr, XB}; if (PROBE_FFOUT) { EpiRes E2{XB, (float*)(ws + WS_ZX + ((size_t)96 << 20)), nullptr, (bf16*)(ws + WS_YG)}; GEMM_PHASE(EpiRes, E2, ws + WS_ACT, ws + WS_WFFOUT + (FFL) * al4k(SZ_WFFOUT), DM, DFF); } GEMM_PHASE(EpiRes, E, ws + WS_ACT, ws + WS_WFFOUT + (FFL) * al4k(SZ_WFFOUT), DM, DFF); \
        sk_res(args, (const bf16*)(ws + WS_ACT), DFF, (const bf16*)(ws + WS_WFFOUT + (FFL) * al4k(SZ_WFFOUT)), SS + ((SSOUT) & 7) * (MPAD * 16), (FIN) ? args.out : nullptr, 0); SEAM((P) + 1); }

    SSD_LAYER(1, 0, 0, 1, 0, 2, false)

    if (IN(8)) { EpiSwaQkv E{(bf16*)(ws + WS_QS), (bf16*)(ws + WS_KS), (bf16*)(ws + WS_VS), (bf16*)(ws + WS_VTS), SS + 2 * (MPAD * 16), (const float*)args.in[I_SWAQN], (const float*)args.in[I_SWAKN], args.out};
        if (PROBE_QKV) GEMM_PHASE(EpiSwaQkv, E, XB, ws + WS_WSWAQKV, 2304, DM); GEMM_PHASE(EpiSwaQkv, E, XB, ws + WS_WSWAQKV, 2304, DM); sk_swaqkv(args, (const bf16*)(ws + WS_WSWAQKV), SS + 2 * (MPAD * 16), (64 * 9) % G); cache_copy_slice(args, 4, 6, (64 * 9) % G); SEAM(8); }
    if (IN(9)) { for (int rep = 0; rep < REP_SWA; ++rep) { swa_attn_phase(args, lds); __syncthreads(); } SEAM(9); }
    if (IN(10)) { swa_combine_phase(args); SEAM(10); }
    if (IN(11)) { EpiRes E{XB, SS + 3 * (MPAD * 16), nullptr, XB}; GEMM_PHASE(EpiRes, E, ws + WS_AO, ws + WS_WSWAOUT, DM, SWAW); sk_res(args, (const bf16*)(ws + WS_AO), SWAW, (const bf16*)(ws + WS_WSWAOUT), SS + 3 * (MPAD * 16), nullptr, 0); SEAM(11); }
    FFN_LAYER(12, 1, 3, 4, false)

    if (IN(14)) { EpiDiffQkv E{(bf16*)(ws + WS_QD), (bf16*)(ws + WS_KD), (bf16*)(ws + WS_VD), (bf16*)(ws + WS_VTD), SS + 4 * (MPAD * 16), (const float*)args.in[I_DQN], (const float*)args.in[I_DKN], args.out};
        if (PROBE_QKV) GEMM_PHASE(EpiDiffQkv, E, XB, ws + WS_WDQKV, 2560, DM); GEMM_PHASE(EpiDiffQkv, E, XB, ws + WS_WDQKV, 2560, DM); sk_diffqkv(args, (const bf16*)(ws + WS_WDQKV), SS + 4 * (MPAD * 16), (64 * 10) % G); cache_copy_slice(args, 5, 6, (64 * 10) % G); SEAM(14); }
    if (IN(15)) {
        if (DIFF_PARTITION && G % 32 == 0) { const int grp = bx >> 3, xl = bx & 7;
            if ((grp & 3) == 0) diff_sample_partial_mfma(args, lds, (grp >> 2) * 8 + xl, G / 4);
            else diff_attn_prompt_mfma(args, lds, lam_init2, ((grp >> 2) * 3 + (grp & 3) - 1) * 8 + xl, G - G / 4); }
        else { diff_attn_prompt_mfma(args, lds, lam_init2, bx, G); if (REP_DATT > 1) diff_attn_prompt_mfma(args, lds, lam_init2, bx, G); diff_sample_partial_mfma(args, lds, bx, G); if (REP_DSMP > 1) diff_sample_partial_mfma(args, lds, bx, G); }
        SEAM(15); }
    if (IN(16)) { diff_sample_combine_phase(args, lam_init2); SEAM(16); }
    if (IN(17)) { EpiRes E{XB, SS + 5 * (MPAD * 16), nullptr, XB}; GEMM_PHASE(EpiRes, E, ws + WS_AOD, ws + WS_WDOUT, DM, DQW); sk_res(args, (const bf16*)(ws + WS_AOD), DQW, (const bf16*)(ws + WS_WDOUT), SS + 5 * (MPAD * 16), nullptr, 0); SEAM(17); }
    FFN_LAYER(18, 2, 5, 6, false)

    SSD_LAYER(20, 1, 6, 7, 3, 8, true)
    (void)ph;
#undef IN
#undef SEAM
}

extern "C" void kernel_launch(void* const* d_in, const int* in_sizes, int n_in, void* d_out, int out_size, void* d_ws, size_t ws_size, hipStream_t stream) {
    static int grid = 0;
    if (grid == 0) {
        if (n_in != N_IN || out_size != O_TOTAL || ws_size < WS_END) { fprintf(stderr, "kernel_launch: unexpected shapes: n_in %d out %d ws %zu (need %zu)\n", n_in, out_size, ws_size, (size_t)WS_END); grid = -1; return; }
        int dev = 0, cus = 0, per_cu = 0;
        if (hipGetDevice(&dev) != hipSuccess || hipDeviceGetAttribute(&cus, hipDeviceAttributeMultiprocessorCount, dev) != hipSuccess) { grid = -1; return; }
        if (hipFuncSetAttribute((const void*)hybrid_fwd, hipFuncAttributeMaxDynamicSharedMemorySize, LDS_BYTES) != hipSuccess) { fprintf(stderr, "kernel_launch: hipFuncSetAttribute failed\n"); grid = -1; return; }
        if (hipOccupancyMaxActiveBlocksPerMultiprocessor(&per_cu, (const void*)hybrid_fwd, NTHR, LDS_BYTES) != hipSuccess || per_cu < 1) fprintf(stderr, "kernel_launch: occupancy query says %d\n", per_cu);
        (void)hipGetLastError();
        grid = cus;
    }
    if (grid < 0) return;
    if (hipMemsetAsync((char*)d_ws + WS_CTL, 0, WS_ZERO_BYTES, stream) != hipSuccess) { fprintf(stderr, "kernel_launch: memset failed\n"); return; }
    Args a{};
    for (int i = 0; i < N_IN; ++i) a.in[i] = d_in[i];
    a.out = (float*)d_out; a.ws = (unsigned char*)d_ws;
#if MK_PER_PHASE
    for (int p = 0; p < N_PHASES; ++p) { a.ph_lo = p; a.ph_hi = p + 1; hipLaunchKernelGGL(hybrid_fwd, dim3(grid), dim3(NTHR), LDS_BYTES, stream, a); }
#else
    a.ph_lo = 0; a.ph_hi = N_PHASES; hipLaunchKernelGGL(hybrid_fwd, dim3(grid), dim3(NTHR), LDS_BYTES, stream, a);
#endif
    const hipError_t le = hipPeekAtLastError();
    if (le != hipSuccess) fprintf(stderr, "kernel_launch: launch failed: %s\n", hipGetErrorName(le));
}
```

```cpp
#include <hip/hip_runtime.h>
#include <cstdio>
#include <cstdint>
#ifndef MK_PER_PHASE
#define MK_PER_PHASE 0
#endif
#ifndef REP_PRO
#define REP_PRO 1
#endif
#ifndef REP_SCAN
#define REP_SCAN 1
#endif
#ifndef REP_FFIN
#define REP_FFIN 1
#endif
#ifndef REP_SWA
#define REP_SWA 1
#endif
#ifndef REP_DATT
#define REP_DATT 1
#endif
#ifndef REP_DSMP
#define REP_DSMP 1
#endif
#ifndef REP_SCANP
#define REP_SCANP 1
#endif
#ifndef REP_SCANS
#define REP_SCANS 1
#endif
#ifndef REP_PRE
#define REP_PRE 1
#endif
#ifndef PROBE_FFIN
#define PROBE_FFIN 0
#endif
#ifndef REP_SKSW
#define REP_SKSW 1
#endif
#ifndef REP_COPY
#define REP_COPY 1
#endif
#ifndef PROBE_GN
#define PROBE_GN 0
#endif
#ifndef PROBE_FFOUT
#define PROBE_FFOUT 0
#endif
#ifndef DIFF_PARTITION
#define DIFF_PARTITION 0
#endif
#ifndef PROBE_BAR
#define PROBE_BAR 0
#endif
#ifndef PROBE_SSDIN
#define PROBE_SSDIN 0
#endif
#ifndef PROBE_QKV
#define PROBE_QKV 0
#endif
#ifndef PROBE_SST
#define PROBE_SST 0
#endif
#ifndef PROBE_SCANBAR
#define PROBE_SCANBAR 0
#endif
#ifndef PROBE_SCANT
#define PROBE_SCANT 0
#endif
#ifndef PROBE_DAT
#define PROBE_DAT 0
#endif
#ifndef DATT_XCD
#define DATT_XCD 1
#endif
#ifndef DATT_PRIO
#define DATT_PRIO 0
#endif
#ifndef PROBE_DAS
#define PROBE_DAS 0
#endif
#ifndef PROBE_SS
#define PROBE_SS 0
#endif
#ifndef PROBE_SKR
#define PROBE_SKR 0
#endif
namespace pg8 {
#define PG8_LAS __attribute__((address_space(3)))
typedef unsigned short bf16_t;
typedef short bf16x8 __attribute__((ext_vector_type(8)));
typedef float f32x4 __attribute__((ext_vector_type(4)));
typedef unsigned u32x4 __attribute__((ext_vector_type(4)));
constexpr int BM = 256, BK = 64, HALF = 128, HTB = HALF * BK * 2  , STAGE_BYTES = 8 * HTB, NXCD = 8, WGM = 8;

__host__ __device__ __forceinline__ int lds_byte(int r, int c) { const int st = (r >> 4) * 2 + (c >> 5), rr = r & 15, cc = c & 31, ob = rr * 64 + cc * 2; return st * 1024 + (ob ^ (((ob >> 9) & 1) << 5)); }
__host__ __device__ __forceinline__ void stage_rc(int b, int& R, int& C) { const int st = b / 1024, sb = b % 1024, swz = sb ^ (((sb >> 9) & 1) << 5); R = (st >> 1) * 16 + swz / 64; C = (st & 1) * 32 + (swz % 64) / 2; }
__host__ __device__ __forceinline__ int perm32(int rho) { const int n = rho >> 4, i = rho & 15; return 8 * (i >> 2) + 4 * n + (i & 3); }

struct Unit { int pm, pn; };
struct Gemm { const bf16_t* A; const bf16_t* Bt; int M, N, K; };

struct StaticOrder {
    int nM, nN, nwg, G, c;
    __host__ __device__ void init(int M, int N, int G_, int c_) { nM = M / BM; nN = N / BM; nwg = nM * nN; G = G_; c = c_; }
    __host__ __device__ bool next(int i, Unit& u) const {
        const long L = (long)i * G + c; if (L >= nwg) return false;
        int wgid = (int)L; { const int q = nwg / NXCD, r = nwg % NXCD, xcd = wgid % NXCD, off = wgid / NXCD; wgid = (xcd < r ? xcd * (q + 1) : r * (q + 1) + (xcd - r) * q) + off; }
        const int nig = WGM * nN, gid = wgid / nig, fm = gid * WGM, gsz = (nM - fm) < WGM ? (nM - fm) : WGM;
        u.pm = fm + ((wgid % nig) % gsz); u.pn = (wgid % nig) / gsz; return true;
    }
    __device__ __forceinline__ void a_ready(const Unit&) const {}
    __device__ __forceinline__ void done(const Unit&) const {}
};

__device__ __forceinline__ unsigned cvt_pk_bf16(float lo, float hi) { unsigned r; asm volatile("v_cvt_pk_bf16_f32 %0, %1, %2" : "=v"(r) : "v"(lo), "v"(hi)); return r; }
template <class Epi, class Sched, bool ALIGN_EPI = false, bool SP2 = false>
__device__ __forceinline__ void gemm_phase(PG8_LAS unsigned char* lds, const Gemm g, const Sched& S, const Epi& E) {
    const int tid = threadIdx.x, wid = __builtin_amdgcn_readfirstlane(tid >> 6), lane = tid & 63, wr = wid >> 2, wc = wid & 3, fr = lane & 15, fq = lane >> 4;
    const int K = g.K, nt = K / BK;
    unsigned voffA[2], voffB[2];
#pragma unroll
    for (int i = 0; i < 2; ++i) { int R, C; stage_rc(tid * 16 + i * 8192, R, C); const int Rb = Epi::PERM ? ((R & ~31) + perm32(R & 31)) : R;
        voffA[i] = (unsigned)(R * K + C) * 2u; voffB[i] = (unsigned)(Rb * K + C) * 2u; }
    const size_t kstep = (size_t)(BK * 2);
    const size_t hstep = (size_t)HALF * K * 2;
    const size_t tstep = 2 * hstep;
    const unsigned ldsw = (unsigned)wid * 1024u;
    const int aoff = lds_byte(wr * 64 + fr, fq * 8), boff = lds_byte(wc * 32 + fr, fq * 8);
#define PG8_SA(b, h) (((b) * 2 + (h)) * HTB)
#define PG8_SB(b, h) ((4 + (b) * 2 + (h)) * HTB)
#define PG8_STAGE(bufoff, gbase, voff) do { _Pragma("unroll") for (int _i = 0; _i < 2; ++_i) \
        __builtin_amdgcn_global_load_lds((const unsigned*)((const char*)(gbase) + (voff)[_i]), (PG8_LAS unsigned*)(lds + (bufoff) + ldsw + _i * 8192), 16, 0, 0); } while (0)
#define PG8_LDA(dst, b, h) do { _Pragma("unroll") for (int m = 0; m < 4; ++m) _Pragma("unroll") for (int k = 0; k < 2; ++k) dst[m][k] = *(const PG8_LAS bf16x8*)(lds + PG8_SA(b, h) + aoff + m * 2048 + k * 1024); } while (0)
#define PG8_LDB(dst, b, h) do { _Pragma("unroll") for (int n = 0; n < 2; ++n) _Pragma("unroll") for (int k = 0; k < 2; ++k) dst[n][k] = *(const PG8_LAS bf16x8*)(lds + PG8_SB(b, h) + boff + n * 2048 + k * 1024); } while (0)
#define PG8_MMA(ai, bj, At, Bt) do { __builtin_amdgcn_s_setprio(1); _Pragma("unroll") for (int m = 0; m < 4; ++m) _Pragma("unroll") for (int n = 0; n < 2; ++n) _Pragma("unroll") for (int k = 0; k < 2; ++k) \
        acc[ai][bj][m][n] = __builtin_amdgcn_mfma_f32_16x16x32_bf16(Bt[n][k], At[m][k], acc[ai][bj][m][n], 0, 0, 0); __builtin_amdgcn_s_setprio(0); } while (0)
#define PG8_WAIT_V(n) asm volatile("s_waitcnt vmcnt(" #n ")" ::: "memory")
#define PG8_WAIT_L(n) asm volatile("s_waitcnt lgkmcnt(" #n ")" ::: "memory")
#define PG8_BAR __builtin_amdgcn_s_barrier()
#define PG8_SCHED __builtin_amdgcn_sched_barrier(0)
    Unit cur, nxt; int ui = 0;
    if (!S.next(0, cur)) return;
    f32x4 acc[2][2][4][2];
#pragma unroll
    for (int a = 0; a < 2; ++a)
#pragma unroll
        for (int b = 0; b < 2; ++b)
#pragma unroll
            for (int m = 0; m < 4; ++m)
#pragma unroll
                for (int n = 0; n < 2; ++n) acc[a][b][m][n] = (f32x4){0.f, 0.f, 0.f, 0.f};
    bf16x8 At[4][2], B0[2][2], B1[2][2];
    const char* cA = (const char*)g.A + (size_t)cur.pm * tstep; const char* cB = (const char*)g.Bt + (size_t)cur.pn * tstep;
    S.a_ready(cur);
    if constexpr (SP2) {
        PG8_STAGE(PG8_SB(0, 0), cB, voffB); PG8_STAGE(PG8_SB(0, 1), cB + hstep, voffB); PG8_STAGE(PG8_SA(0, 0), cA, voffA); PG8_STAGE(PG8_SA(0, 1), cA + hstep, voffA);
        if (wr == 1) PG8_BAR;
        PG8_WAIT_V(2); PG8_BAR;
        PG8_STAGE(PG8_SB(1, 0), cB + kstep, voffB); PG8_STAGE(PG8_SA(1, 0), cA + kstep, voffA); PG8_STAGE(PG8_SB(1, 1), cB + hstep + kstep, voffB);
        PG8_WAIT_V(6); PG8_BAR;
    } else {
        PG8_STAGE(PG8_SB(0, 0), cB, voffB); PG8_STAGE(PG8_SA(0, 0), cA, voffA); PG8_STAGE(PG8_SB(0, 1), cB + hstep, voffB); PG8_STAGE(PG8_SA(0, 1), cA + hstep, voffA);
        if (wr == 1) PG8_BAR;
        PG8_WAIT_V(4); PG8_BAR;
        PG8_STAGE(PG8_SB(1, 0), cB + kstep, voffB); PG8_STAGE(PG8_SA(1, 0), cA + kstep, voffA); PG8_STAGE(PG8_SB(1, 1), cB + hstep + kstep, voffB);
        PG8_WAIT_V(6); PG8_BAR;
    }
    for (;;) {
        const bool has_next = S.next(ui + 1, nxt);
        const char* nA = has_next ? (const char*)g.A + (size_t)nxt.pm * tstep : cA; const char* nB = has_next ? (const char*)g.Bt + (size_t)nxt.pn * tstep : cB;
        for (int t = 0; t < nt; t += 2) {
            const bool last = (t == nt - 2);
            const char* a1 = cA + (size_t)(t + 1) * kstep;
            const char* a2 = last ? nA : cA + (size_t)(t + 2) * kstep; const char* b2 = last ? nB : cB + (size_t)(t + 2) * kstep;
            const char* a3 = a2 + kstep; const char* b3 = b2 + kstep;
            if (last && has_next) S.a_ready(nxt);
            if constexpr (SP2) {
            PG8_LDB(B0, 0, 0); PG8_LDB(B1, 0, 1); PG8_SCHED; PG8_LDA(At, 0, 0); PG8_STAGE(PG8_SA(1, 1), a1 + hstep, voffA);
            PG8_WAIT_V(8); PG8_WAIT_L(0); PG8_BAR; PG8_MMA(0, 0, At, B0); PG8_MMA(0, 1, At, B1); PG8_BAR; PG8_SCHED;
            PG8_LDA(At, 0, 1); PG8_STAGE(PG8_SB(0, 0), b2, voffB); PG8_STAGE(PG8_SB(0, 1), b2 + hstep, voffB); PG8_STAGE(PG8_SA(0, 0), a2, voffA);
            PG8_WAIT_V(8); PG8_WAIT_L(0); PG8_BAR; PG8_MMA(1, 0, At, B0); PG8_MMA(1, 1, At, B1); PG8_BAR; PG8_SCHED;
            PG8_LDB(B0, 1, 0); PG8_LDB(B1, 1, 1); PG8_SCHED; PG8_LDA(At, 1, 0); PG8_STAGE(PG8_SA(0, 1), a2 + hstep, voffA);
            PG8_WAIT_V(8); PG8_WAIT_L(0); PG8_BAR; PG8_MMA(0, 0, At, B0); PG8_MMA(0, 1, At, B1); PG8_BAR; PG8_SCHED;
            PG8_LDA(At, 1, 1); PG8_STAGE(PG8_SB(1, 0), b3, voffB); PG8_STAGE(PG8_SB(1, 1), b3 + hstep, voffB); PG8_STAGE(PG8_SA(1, 0), a3, voffA);
            PG8_WAIT_V(8); PG8_WAIT_L(0); PG8_BAR; PG8_MMA(1, 0, At, B0); PG8_MMA(1, 1, At, B1); PG8_BAR; PG8_SCHED;
            } else {
            PG8_LDB(B0, 0, 0); PG8_SCHED; PG8_LDA(At, 0, 0); PG8_STAGE(PG8_SA(1, 1), a1 + hstep, voffA);
            PG8_WAIT_L(8); PG8_BAR; PG8_WAIT_L(0); PG8_MMA(0, 0, At, B0); PG8_BAR; PG8_SCHED;
            PG8_LDB(B1, 0, 1); PG8_STAGE(PG8_SB(0, 0), b2, voffB);
            PG8_BAR; PG8_WAIT_L(0); PG8_MMA(0, 1, At, B1); PG8_BAR;
            PG8_LDA(At, 0, 1); PG8_STAGE(PG8_SA(0, 0), a2, voffA);
            PG8_BAR; PG8_WAIT_L(0); PG8_MMA(1, 0, At, B0); PG8_BAR; PG8_SCHED;
            PG8_STAGE(PG8_SB(0, 1), b2 + hstep, voffB);
            PG8_WAIT_V(6); PG8_BAR; PG8_MMA(1, 1, At, B1); PG8_BAR;
            PG8_LDB(B0, 1, 0); PG8_SCHED; PG8_LDA(At, 1, 0); PG8_STAGE(PG8_SA(0, 1), a2 + hstep, voffA);
            PG8_WAIT_L(8); PG8_BAR; PG8_WAIT_L(0); PG8_MMA(0, 0, At, B0); PG8_BAR; PG8_SCHED;
            PG8_LDB(B1, 1, 1); PG8_STAGE(PG8_SB(1, 0), b3, voffB);
            PG8_BAR; PG8_WAIT_L(0); PG8_MMA(0, 1, At, B1); PG8_BAR;
            PG8_LDA(At, 1, 1); PG8_STAGE(PG8_SA(1, 0), a3, voffA);
            PG8_BAR; PG8_WAIT_L(0); PG8_MMA(1, 0, At, B0); PG8_BAR; PG8_SCHED;
            PG8_STAGE(PG8_SB(1, 1), b3 + hstep, voffB);
            PG8_WAIT_V(6); PG8_BAR; PG8_MMA(1, 1, At, B1); PG8_BAR;
            }
        }
        if constexpr (ALIGN_EPI) { if (wr == 0) PG8_BAR; }
        if constexpr (!Epi::AFTER_DRAIN) { E(acc, cur, wr, wc, fr, fq); S.done(cur); }
        if (!has_next) break;
#pragma unroll
        for (int a = 0; a < 2; ++a)
#pragma unroll
            for (int b = 0; b < 2; ++b)
#pragma unroll
                for (int m = 0; m < 4; ++m)
#pragma unroll
                    for (int n = 0; n < 2; ++n) acc[a][b][m][n] = (f32x4){0.f, 0.f, 0.f, 0.f};
        cur = nxt; cA = nA; cB = nB; ++ui;
        if constexpr (ALIGN_EPI) { if (wr == 1) PG8_BAR; }
    }
    PG8_WAIT_V(0);
    if constexpr (!ALIGN_EPI) { if (wr == 0) PG8_BAR; }
    PG8_BAR;
    if constexpr (Epi::AFTER_DRAIN) { E.fused(acc, cur, wr, wc, fr, fq, lds, wid, lane); S.done(cur); }
#undef PG8_SA
#undef PG8_SB
#undef PG8_STAGE
#undef PG8_LDA
#undef PG8_LDB
#undef PG8_MMA
#undef PG8_WAIT_V
#undef PG8_WAIT_L
#undef PG8_BAR
#undef PG8_SCHED
}
}

constexpr int DM = 1024, SEQ = 2048, NBP = 8, NBS = 32, TS = 4, PAST = 8192;
constexpr int MP = NBP * SEQ;
constexpr int MS = NBS * TS;
constexpr int MTOK = MP + MS;
constexpr int MPAD = 16640;
constexpr int DFF = 2816, DIN = 2048, CONVD = 3072, ZXW = 5120, SSMN = 5152, SSMNP = 5376;
constexpr int SWAW = 768, DQW = 1536, DKW = 512;
constexpr float EPS = 1e-6f;
constexpr int NWAVES = 8, NTHR = 512;

enum { I_XP = 0, I_XS, I_CONVST, I_SSMST, I_SWA0, I_SWA1, I_SWA2, I_DCK, I_DCV, I_PT, I_RELB, I_NMIX, I_NFFN, I_FFIN, I_FFOUT,
       I_SSMWIN, I_CONVW, I_CONVB, I_DTB, I_ALOG, I_SSMD, I_SSMNORM, I_SSMWOUT, I_SWAQKV, I_SWAQN, I_SWAKN, I_SWAOUT,
       I_DQKV, I_DQN, I_DKN, I_DLAM, I_DON, I_DOUT, N_IN };

constexpr int O_Y_P = 0;
constexpr int O_Y_S = O_Y_P + MP * DM;
constexpr int O_CONV_P = O_Y_S + MS * DM;
constexpr int O_CONV_S = O_CONV_P + 2 * NBP * 3 * CONVD;
constexpr int O_SSM_P = O_CONV_S + 2 * NBS * 3 * CONVD;
constexpr int O_SSM_S = O_SSM_P + 2 * NBP * 32 * 64 * 128;
constexpr int O_KV0_P = O_SSM_S + 2 * NBS * 32 * 64 * 128;
constexpr int O_KV0_S = O_KV0_P + NBP * 128 * 512;
constexpr int O_KV1_P = O_KV0_S + NBS * 128 * 512;
constexpr int O_KV1_S = O_KV1_P + NBP * 512 * 512;
constexpr int O_KV2_P = O_KV1_S + NBS * 512 * 512;
constexpr int O_KV2_S = O_KV2_P + NBP * 2048 * 512;
constexpr int O_DK_P = O_KV2_S + NBS * 2048 * 512;
constexpr int O_DK_S = O_DK_P + MP * 512;
constexpr int O_DV_P = O_DK_S + MS * 512;
constexpr int O_DV_S = O_DV_P + MP * 512;
constexpr int O_TOTAL = O_DV_S + MS * 512;
static_assert(O_TOTAL == 110575616, "output size");

constexpr size_t al4k(size_t x) { return (x + 4095) & ~(size_t)4095; }
constexpr size_t WS_CTL = 0;
constexpr size_t WS_ZERO_BYTES = (size_t)1 << 20;
constexpr size_t WS_SS = (size_t)1 << 20;
constexpr size_t SZ_SS1 = (size_t)MPAD * 16 * 4;
constexpr size_t SZ_WSSDIN = (size_t)SSMNP * DM * 2, SZ_WSSDOUT = (size_t)DM * DIN * 2, SZ_WSWAQKV = (size_t)2304 * DM * 2, SZ_WSWAOUT = (size_t)DM * SWAW * 2,
                 SZ_WDQKV = (size_t)2560 * DM * 2, SZ_WDOUT = (size_t)DM * DQW * 2, SZ_WFFIN = (size_t)2 * DFF * DM * 2, SZ_WFFOUT = (size_t)DM * DFF * 2;
constexpr size_t WS_WSSDIN = WS_SS + al4k(8 * SZ_SS1);
constexpr size_t WS_WSSDOUT = WS_WSSDIN + 2 * al4k(SZ_WSSDIN);
constexpr size_t WS_WSWAQKV = WS_WSSDOUT + 2 * al4k(SZ_WSSDOUT);
constexpr size_t WS_WSWAOUT = WS_WSWAQKV + al4k(SZ_WSWAQKV);
constexpr size_t WS_WDQKV = WS_WSWAOUT + al4k(SZ_WSWAOUT);
constexpr size_t WS_WDOUT = WS_WDQKV + al4k(SZ_WDQKV);
constexpr size_t WS_WFFIN = WS_WDOUT + al4k(SZ_WDOUT);
constexpr size_t WS_WFFOUT = WS_WFFIN + 4 * al4k(SZ_WFFIN);
constexpr size_t WS_X = WS_WFFOUT + 4 * al4k(SZ_WFFOUT);
constexpr size_t WS_XB = WS_X + al4k((size_t)MPAD * DM * 4);
constexpr size_t WS_ZX = WS_XB + al4k((size_t)MPAD * DM * 2);
constexpr size_t WS_DT = WS_ZX + al4k((size_t)MPAD * ZXW * 2);
constexpr size_t WS_YG = WS_DT + al4k((size_t)MPAD * 32 * 4);
constexpr size_t WS_ACT = WS_YG + al4k((size_t)MPAD * DIN * 2);
constexpr size_t WS_QS = WS_ACT + al4k((size_t)MPAD * DFF * 2);
constexpr size_t WS_KS = WS_QS + al4k((size_t)MPAD * SWAW * 2);
constexpr size_t WS_VS = WS_KS + al4k((size_t)MPAD * SWAW * 2);
constexpr size_t WS_AO = WS_VS + al4k((size_t)MPAD * SWAW * 2);
constexpr size_t WS_QD = WS_AO + al4k((size_t)MPAD * SWAW * 2);
constexpr size_t WS_KD = WS_QD + al4k((size_t)MPAD * DQW * 2);
constexpr size_t WS_VD = WS_KD + al4k((size_t)MPAD * DKW * 2);
constexpr size_t WS_AOD = WS_VD + al4k((size_t)MPAD * DKW * 2);
constexpr size_t WS_VTD = WS_AOD + al4k((size_t)MPAD * DQW * 2);
constexpr size_t WS_BC = WS_VTD + al4k((size_t)NBP * 4 * 128 * SEQ * 2);
constexpr size_t WS_BT = WS_BC + al4k((size_t)MP * 1024 * 2);
constexpr size_t WS_SC = WS_BT + al4k((size_t)NBP * 4 * 128 * SEQ * 2);
constexpr size_t WS_VTS = WS_SC + al4k((size_t)MP * 32 * 16);
constexpr size_t WS_LSE = WS_VTS + al4k((size_t)NBP * 12 * 64 * SEQ * 2);
constexpr int PART_STRIDE = 132;
constexpr size_t WS_PART = WS_LSE + al4k((size_t)MP * 12 * 4);
constexpr size_t WS_END = WS_PART + al4k((size_t)1024 * 24 * PART_STRIDE * 4);

constexpr int CW_BAR = 4096;

constexpr int RING_BYTES = 131072;
constexpr int LDSCTL_OFF = RING_BYTES, MISC_OFF = LDSCTL_OFF + 320;
constexpr int LDS_BYTES = 147456;

#define GAS __attribute__((address_space(1)))
#define LAS __attribute__((address_space(3)))
typedef unsigned short bf16;
typedef unsigned v4u __attribute__((ext_vector_type(4)));
typedef unsigned v2u __attribute__((ext_vector_type(2)));
typedef float f32x4 __attribute__((ext_vector_type(4)));
typedef float f32x2 __attribute__((ext_vector_type(2)));
typedef float f32x16 __attribute__((ext_vector_type(16)));
typedef GAS unsigned gu32;
#define RLX_AGENT __ATOMIC_RELAXED, __HIP_MEMORY_SCOPE_AGENT
#define LDS_WAIT() asm volatile("s_waitcnt lgkmcnt(0)" ::: "memory")

__device__ __forceinline__ float bf2f(unsigned short v) { return __builtin_bit_cast(float, (unsigned)v << 16); }
__device__ __forceinline__ float bflo(unsigned w) { return __builtin_bit_cast(float, w << 16); }
__device__ __forceinline__ float bfhi(unsigned w) { return __builtin_bit_cast(float, w & 0xffff0000u); }
__device__ __forceinline__ unsigned f2bf(float f) { unsigned u = __builtin_bit_cast(unsigned, f); return (u + 0x7fffu + ((u >> 16) & 1u)) >> 16; }
__device__ __forceinline__ unsigned pk2(float lo, float hi) { return pg8::cvt_pk_bf16(lo, hi); }
__device__ __forceinline__ int opaque_tid() { int t = threadIdx.x; asm volatile("" : "+v"(t)); return t; }
__device__ __forceinline__ float wave_sum(float v) {
#pragma unroll
    for (int o = 1; o < 64; o <<= 1) v += __shfl_xor(v, o);
    return v;
}
__device__ __forceinline__ float wave_max(float v) {
#pragma unroll
    for (int o = 1; o < 64; o <<= 1) v = fmaxf(v, __shfl_xor(v, o));
    return v;
}
__device__ __forceinline__ float silu_f(float x) { return x * __builtin_amdgcn_rcpf(1.f + __expf(-x)); }
__device__ __forceinline__ float softplus_f(float x) { return x > 20.f ? x : log1pf(__expf(x)); }
__device__ __forceinline__ int rel_bucket(int d) {
    d = d < 0 ? 0 : d;
    if (d < 16) return d;
    const float v = logf((float)d / 16.0f) / 4.852030263919617f * 16.0f;
    const int l = 16 + (int)v;
    return l < 31 ? l : 31;
}

#define XB_TMO      128
#define XB_XCNT(j)  (256  + 64 * (j))
#define XB_XSUB(j)  (1280 + 64 * (j))
#define XB_XGEN(j)  (2304 + 64 * (j))
#define XB_TOP      3328
#define XB_TOPGEN   3392
#define XCD_BAR_WORDS 3456
#define XB_SPIN_CAP (1u << 18)
__device__ __forceinline__ unsigned xb_ld(unsigned* p)              { return __hip_atomic_load(p, __ATOMIC_RELAXED, __HIP_MEMORY_SCOPE_AGENT); }
__device__ __forceinline__ unsigned xb_add(unsigned* p, unsigned v) { return __hip_atomic_fetch_add(p, v, __ATOMIC_RELAXED, __HIP_MEMORY_SCOPE_AGENT); }
__device__ __forceinline__ unsigned xb_xcc_id() { return (unsigned)__builtin_amdgcn_s_getreg((3 << 11) | 20) & 0xFu; }
#define XB_SPIN(cond, bar) do { unsigned _sp = 0; while (cond) { __builtin_amdgcn_s_sleep(1); \
    if ((++_sp & 255u) == 0u) { if (xb_ld(&(bar)[XB_TMO])) break; if (_sp > XB_SPIN_CAP) { atomicAdd(&(bar)[XB_TMO], 1u); break; } } } } while (0)
struct XcdBarrier { unsigned* bar; unsigned x; volatile LAS unsigned* st; };
__device__ __forceinline__ XcdBarrier xcd_barrier_post(unsigned* bar, volatile LAS unsigned* st) {
    XcdBarrier b; b.bar = bar; b.x = xb_xcc_id(); b.st = st;
    if (threadIdx.x == 0) (void)xb_add(&bar[XB_XCNT(b.x)], 1u);
    return b;
}
__device__ __forceinline__ void xcd_barrier_complete(unsigned* bar, unsigned x, unsigned& nloc, unsigned& nx) {
    const unsigned G = gridDim.x * gridDim.y * gridDim.z;
    unsigned sum, cnt, mine, sp = 0u;
    for (;;) {
        sum = 0u; cnt = 0u; mine = 0u;
#pragma unroll
        for (unsigned j = 0; j < 16; ++j) { const unsigned c = xb_ld(&bar[XB_XCNT(j)]); sum += c; cnt += (c > 0u) ? 1u : 0u; mine = (j == x) ? c : mine; }
        if (sum == G) break;
        __builtin_amdgcn_s_sleep(1);
        if ((++sp & 255u) == 0u) { if (xb_ld(&bar[XB_TMO])) break; if (sp > XB_SPIN_CAP) { atomicAdd(&bar[XB_TMO], 1u); break; } }
    }
    nloc = mine > 0u ? mine : 1u; nx = cnt > 0u ? cnt : 1u;
}
__device__ __forceinline__ void xcd_barrier(const XcdBarrier& b) {
    asm volatile("s_waitcnt vmcnt(0)" ::: "memory");
    __syncthreads();
    if (threadIdx.x == 0) {
        unsigned* bar = b.bar;
        __builtin_amdgcn_s_waitcnt(0);
        unsigned nloc = b.st[0], nx = b.st[1];
        if (nloc == 0u) { xcd_barrier_complete(bar, b.x, nloc, nx); b.st[0] = nloc; b.st[1] = nx; }
        const unsigned old = xb_add(&bar[XB_XSUB(b.x)], 1u);
        const unsigned gen = old / nloc;
        if (old + 1u == (gen + 1u) * nloc) {
            __builtin_amdgcn_fence(__ATOMIC_RELEASE, "agent");
            asm volatile("s_waitcnt vmcnt(0)" ::: "memory");
            const unsigned og = xb_add(&bar[XB_TOP], 1u);
            const unsigned tg = og / nx;
            if (og + 1u == (tg + 1u) * nx) xb_add(&bar[XB_TOPGEN], 1u);
            else XB_SPIN(xb_ld(&bar[XB_TOPGEN]) == tg, bar);
            __builtin_amdgcn_fence(__ATOMIC_ACQUIRE, "agent");
            xb_add(&bar[XB_XGEN(b.x)], 1u);
            asm volatile("s_waitcnt vmcnt(0)" ::: "memory");
        } else {
            XB_SPIN(xb_ld(&bar[XB_XGEN(b.x)]) == gen, bar);
            __builtin_amdgcn_fence(__ATOMIC_ACQUIRE, "agent");
            asm volatile("s_waitcnt vmcnt(0)" ::: "memory");
        }
    }
    __syncthreads();
}

struct Args { const void* in[N_IN]; float* out; unsigned char* ws; int ph_lo, ph_hi; };
static_assert(sizeof(Args) == N_IN * 8 + 24, "Args has no padding");

__device__ __forceinline__ float rs_of(const float* ssp, int row) {
    const f32x4* p = (const f32x4*)(ssp + (size_t)row * 16); const f32x4 a = p[0], b = p[1], c = p[2], d = p[3];
    const float s = (((a[0] + a[1]) + (a[2] + a[3])) + ((b[0] + b[1]) + (b[2] + b[3]))) + (((c[0] + c[1]) + (c[2] + c[3])) + ((d[0] + d[1]) + (d[2] + d[3])));
    return rsqrtf(s * (1.0f / 1024.0f) + EPS);
}
#define RS_OF(ss, row) rs_of((ss), (row))

struct EpiSsdIn {
    static constexpr bool PERM = true, AFTER_DRAIN = false;
    bf16* ZX; float* DT; const float* ss; const float* dtb;
    __device__ __forceinline__ void operator()(const pg8::f32x4 (&acc)[2][2][4][2], const pg8::Unit& u, int wr, int wc, int fr, int fq) const {
        const int row0 = u.pm * 256 + wr * 64 + fr;
        {
            const int col0 = u.pn * 256 + wc * 32 + 8 * fq;
#pragma unroll
            for (int ai = 0; ai < 2; ++ai)
#pragma unroll
                for (int m = 0; m < 4; ++m) { const int row = row0 + ai * 128 + m * 16; const float rs = RS_OF(ss, row);
#pragma unroll
                    for (int bj = 0; bj < 2; ++bj) { const f32x4 v0 = acc[ai][bj][m][0] * rs, v1 = acc[ai][bj][m][1] * rs;
                        v4u w; w.x = pk2(v0[0], v0[1]); w.y = pk2(v0[2], v0[3]); w.z = pk2(v1[0], v1[1]); w.w = pk2(v1[2], v1[3]);
                        *(v4u*)(ZX + (size_t)row * ZXW + col0 + bj * 128) = w; } }
        }
    }
};

struct EpiNone { static constexpr bool PERM = true, AFTER_DRAIN = false;
    __device__ __forceinline__ void operator()(const pg8::f32x4 (&acc)[2][2][4][2], const pg8::Unit& u, int wr, int wc, int fr, int fq) const { asm volatile("" :: "v"(acc[0][0][0][0][0]), "v"(acc[1][1][3][1][3])); } };
struct EpiRes {
    static constexpr bool PERM = true, AFTER_DRAIN = false;
    const bf16* XB; float* ss_out; float* fin; bf16* XBd;
    __device__ __forceinline__ void operator()(const pg8::f32x4 (&acc)[2][2][4][2], const pg8::Unit& u, int wr, int wc, int fr, int fq) const {
        const int row0 = u.pm * 256 + wr * 64 + fr, col0 = u.pn * 256 + wc * 32 + 8 * fq;
#pragma unroll
        for (int ai = 0; ai < 2; ++ai)
#pragma unroll
            for (int m = 0; m < 4; ++m) { const int row = row0 + ai * 128 + m * 16; float q = 0.f;
                const bf16* xr = XB + (size_t)row * DM + col0;
                v4u xin[2];
#pragma unroll
                for (int bj = 0; bj < 2; ++bj) xin[bj] = *(const v4u*)(xr + bj * 128);
#pragma unroll
                for (int bj = 0; bj < 2; ++bj) { const int co = bj * 128; const v4u xi = xin[bj];
                    const f32x4 v0 = (f32x4){bflo(xi.x), bfhi(xi.x), bflo(xi.y), bfhi(xi.y)} + acc[ai][bj][m][0];
                    const f32x4 v1 = (f32x4){bflo(xi.z), bfhi(xi.z), bflo(xi.w), bfhi(xi.w)} + acc[ai][bj][m][1];
                    if (fin) { if (row < MTOK) { *(f32x4*)(fin + (size_t)row * DM + col0 + co) = v0; *(f32x4*)(fin + (size_t)row * DM + col0 + co + 4) = v1; } }
                    else { v4u w; w.x = pk2(v0[0], v0[1]); w.y = pk2(v0[2], v0[3]); w.z = pk2(v1[0], v1[1]); w.w = pk2(v1[2], v1[3]); *(v4u*)(XBd + (size_t)row * DM + col0 + co) = w;
                           q += ((v0[0] * v0[0] + v0[1] * v0[1]) + (v0[2] * v0[2] + v0[3] * v0[3])) + ((v1[0] * v1[0] + v1[1] * v1[1]) + (v1[2] * v1[2] + v1[3] * v1[3])); } }
                if (!fin) { q += __shfl_xor(q, 16); q += __shfl_xor(q, 32);
                    if (fq == 0) ss_out[(size_t)row * 16 + u.pn * 4 + wc] = q; } }
    }
};

struct EpiSwiGlu {
    static constexpr bool PERM = true, AFTER_DRAIN = false;
    bf16* ACT; const float* ss;
    __device__ __forceinline__ void operator()(const pg8::f32x4 (&acc)[2][2][4][2], const pg8::Unit& u, int wr, int wc, int fr, int fq) const {
        const int row0 = u.pm * 256 + wr * 64 + fr, col0 = u.pn * 128 + wc * 32 + 8 * fq;
#pragma unroll
        for (int ai = 0; ai < 2; ++ai)
#pragma unroll
            for (int m = 0; m < 4; ++m) { const int row = row0 + ai * 128 + m * 16; const float rs = RS_OF(ss, row);
                f32x4 o[2];
#pragma unroll
                for (int n = 0; n < 2; ++n) { const f32x4 g = acc[ai][0][m][n] * rs, up = acc[ai][1][m][n] * rs;
#pragma unroll
                    for (int j = 0; j < 4; ++j) o[n][j] = silu_f(g[j]) * up[j]; }
                v4u w; w.x = pk2(o[0][0], o[0][1]); w.y = pk2(o[0][2], o[0][3]); w.z = pk2(o[1][0], o[1][1]); w.w = pk2(o[1][2], o[1][3]);
                *(v4u*)(ACT + (size_t)row * DFF + col0) = w; }
    }
};

struct EpiSwaQkv {
    static constexpr bool PERM = true, AFTER_DRAIN = false;
    bf16 *Q, *K, *V, *VT; const float* ss; const float *qn, *kn; float* out;
    __device__ __forceinline__ void operator()(const pg8::f32x4 (&acc)[2][2][4][2], const pg8::Unit& u, int wr, int wc, int fr, int fq) const {
        const int row0 = u.pm * 256 + wr * 64 + fr;
        const int slot = u.pn * 4 + wc, kind = slot / 12, head = slot - kind * 12;
        const float* nwp = kind == 0 ? qn : kn;
        f32x4 nw[2][2];
#pragma unroll
        for (int bj = 0; bj < 2; ++bj)
#pragma unroll
            for (int n = 0; n < 2; ++n) nw[bj][n] = (kind < 2) ? *(const f32x4*)(nwp + 32 * bj + 8 * fq + 4 * n) : (f32x4){1.f, 1.f, 1.f, 1.f};
        bf16* dst = Q + (size_t)kind * ((WS_KS - WS_QS) / 2) + head * 64 + 8 * fq;
        const int g = head >> 2, j4 = head & 3, kv = kind - 1, keep = 128 << (2 * g);
        const int obp = g == 0 ? O_KV0_P : (g == 1 ? O_KV1_P : O_KV2_P), obs = g == 0 ? O_KV0_S : (g == 1 ? O_KV1_S : O_KV2_S);
#pragma unroll
        for (int ai = 0; ai < 2; ++ai)
#pragma unroll
            for (int m = 0; m < 4; ++m) { const int row = row0 + ai * 128 + m * 16; const float rs = RS_OF(ss, row);
                f32x4 v[2][2]; float q = 0.f;
#pragma unroll
                for (int bj = 0; bj < 2; ++bj)
#pragma unroll
                    for (int n = 0; n < 2; ++n) { v[bj][n] = acc[ai][bj][m][n] * rs; const f32x4 x = v[bj][n]; q += (x[0] * x[0] + x[1] * x[1]) + (x[2] * x[2] + x[3] * x[3]); }
                if (kind < 2) { q += __shfl_xor(q, 16); q += __shfl_xor(q, 32); const float r = rsqrtf(q * (1.0f / 64.0f) + EPS);
#pragma unroll
                    for (int bj = 0; bj < 2; ++bj)
#pragma unroll
                        for (int n = 0; n < 2; ++n) v[bj][n] = v[bj][n] * r * nw[bj][n]; }
                if (kind == 2 && u.pm < 64) {
                    const int b = row >> 11, t = row & 2047, pp = ((t & ((1 << (2 * g)) - 1)) << (11 - 2 * g)) + (t >> (2 * g)), tp = (pp & ~12) | ((pp & 4) << 1) | ((pp & 8) >> 1);
                    bf16* vt = VT + ((size_t)((b * 12 + head) * 64 + 8 * fq)) * SEQ + tp;
#pragma unroll
                    for (int bj = 0; bj < 2; ++bj)
#pragma unroll
                        for (int n = 0; n < 2; ++n)
#pragma unroll
                            for (int j = 0; j < 4; ++j) vt[(size_t)(32 * bj + 4 * n + j) * SEQ] = (bf16)f2bf(v[bj][n][j]);
                } else {
#pragma unroll
                for (int bj = 0; bj < 2; ++bj) { v4u w; w.x = pk2(v[bj][0][0], v[bj][0][1]); w.y = pk2(v[bj][0][2], v[bj][0][3]); w.z = pk2(v[bj][1][0], v[bj][1][1]); w.w = pk2(v[bj][1][2], v[bj][1][3]);
                    *(v4u*)(dst + (size_t)row * SWAW + 32 * bj) = w; }
                }
                if (kind >= 1 && row < MTOK) {
                    int base = -1;
                    if (row < MP) { const int b = row >> 11, t = row & 2047, t0 = 2048 - keep; if (t >= t0) base = obp + (((b * keep + (t - t0)) * 2 + kv) * 4 + j4) * 64; }
                    else { const int r2 = row - MP, b = r2 >> 2, tt = r2 & 3; base = obs + (((b * keep + (keep - 4 + tt)) * 2 + kv) * 4 + j4) * 64; }
                    if (base >= 0) {
#pragma unroll
                        for (int bj = 0; bj < 2; ++bj)
#pragma unroll
                            for (int n = 0; n < 2; ++n) *(f32x4*)(out + base + 32 * bj + 8 * fq + 4 * n) = v[bj][n]; }
                } }
    }
};

struct EpiDiffQkv {
    static constexpr bool PERM = true, AFTER_DRAIN = false;
    bf16 *Q, *K, *V, *VT; const float* ss; const float *qn, *kn; float* out;
    __device__ __forceinline__ void operator()(const pg8::f32x4 (&acc)[2][2][4][2], const pg8::Unit& u, int wr, int wc, int fr, int fq) const {
        const int row0 = u.pm * 256 + wr * 64 + fr;
        const int slot = u.pn * 4 + wc, kind = slot < 24 ? 0 : (slot < 32 ? 1 : 2);
        const float* nwp = kind == 0 ? qn : kn;
        f32x4 nw[2][2];
#pragma unroll
        for (int bj = 0; bj < 2; ++bj)
#pragma unroll
            for (int n = 0; n < 2; ++n) nw[bj][n] = (kind < 2) ? *(const f32x4*)(nwp + 32 * bj + 8 * fq + 4 * n) : (f32x4){1.f, 1.f, 1.f, 1.f};
        bf16* dst; int pitch, cofs;
        if (kind == 0) { dst = Q; pitch = DQW; cofs = slot * 64; } else { dst = K + (size_t)(kind - 1) * ((WS_VD - WS_KD) / 2); pitch = DKW; cofs = (slot - (kind == 1 ? 24 : 32)) * 64; }
        const int obp = kind == 1 ? O_DK_P : O_DV_P, obs = kind == 1 ? O_DK_S : O_DV_S;
#pragma unroll
        for (int ai = 0; ai < 2; ++ai)
#pragma unroll
            for (int m = 0; m < 4; ++m) { const int row = row0 + ai * 128 + m * 16; const float rs = RS_OF(ss, row);
                f32x4 v[2][2]; float q = 0.f;
#pragma unroll
                for (int bj = 0; bj < 2; ++bj)
#pragma unroll
                    for (int n = 0; n < 2; ++n) { v[bj][n] = acc[ai][bj][m][n] * rs; const f32x4 x = v[bj][n]; q += (x[0] * x[0] + x[1] * x[1]) + (x[2] * x[2] + x[3] * x[3]); }
                if (kind < 2) { q += __shfl_xor(q, 16); q += __shfl_xor(q, 32); const float r = rsqrtf(q * (1.0f / 64.0f) + EPS);
#pragma unroll
                    for (int bj = 0; bj < 2; ++bj)
#pragma unroll
                        for (int n = 0; n < 2; ++n) v[bj][n] = v[bj][n] * r * nw[bj][n]; }
                if (kind == 2 && u.pm < 64) {
                    const int b = row >> 11, t = row & 2047, tp = (t & ~12) | ((t & 4) << 1) | ((t & 8) >> 1), gg = (slot - 32) >> 1, half = (slot - 32) & 1;
                    bf16* vt = VT + ((size_t)((b * 4 + gg) * 128 + half * 64 + 8 * fq)) * SEQ + tp;
#pragma unroll
                    for (int bj = 0; bj < 2; ++bj)
#pragma unroll
                        for (int n = 0; n < 2; ++n)
#pragma unroll
                            for (int j = 0; j < 4; ++j) vt[(size_t)(32 * bj + 4 * n + j) * SEQ] = (bf16)f2bf(v[bj][n][j]);
                } else {
#pragma unroll
                for (int bj = 0; bj < 2; ++bj) { v4u w; w.x = pk2(v[bj][0][0], v[bj][0][1]); w.y = pk2(v[bj][0][2], v[bj][0][3]); w.z = pk2(v[bj][1][0], v[bj][1][1]); w.w = pk2(v[bj][1][2], v[bj][1][3]);
                    *(v4u*)(dst + (size_t)row * pitch + cofs + 32 * bj + 8 * fq) = w; }
                }
                if (kind >= 1 && row < MTOK) {
                    const int base = (row < MP ? obp + row * 512 : obs + (row - MP) * 512) + cofs;
#pragma unroll
                    for (int bj = 0; bj < 2; ++bj)
#pragma unroll
                        for (int n = 0; n < 2; ++n) *(f32x4*)(out + base + 32 * bj + 8 * fq + 4 * n) = v[bj][n];
                } }
    }
};


template <int NT>
__device__ __forceinline__ void wave_gemm(f32x4 (&acc)[NT], const bf16* Arow, const bf16* Bt, const int (&nb)[NT], int K, int r, int c4) {
    const bf16* ap = Arow + 8 * c4;
    const bf16* bp[NT];
#pragma unroll
    for (int nt = 0; nt < NT; ++nt) { bp[nt] = Bt + (size_t)(nb[nt] + r) * K + 8 * c4; acc[nt] = (f32x4){0.f, 0.f, 0.f, 0.f}; }
#pragma unroll 1
    for (int k0 = 0; k0 < K; k0 += 256) {
        pg8::bf16x8 af[8], bf_[NT][8];
#pragma unroll
        for (int s2 = 0; s2 < 8; ++s2) { af[s2] = *(const pg8::bf16x8*)(ap + k0 + 32 * s2);
#pragma unroll
            for (int nt = 0; nt < NT; ++nt) bf_[nt][s2] = *(const pg8::bf16x8*)(bp[nt] + k0 + 32 * s2); }
#pragma unroll
        for (int s2 = 0; s2 < 8; ++s2)
#pragma unroll
            for (int nt = 0; nt < NT; ++nt) acc[nt] = __builtin_amdgcn_mfma_f32_16x16x32_bf16(bf_[nt][s2], af[s2], acc[nt], 0, 0, 0);
    }
}
#define SK_WAVE_IDS const int tid = threadIdx.x, lane = tid & 63, wave = __builtin_amdgcn_readfirstlane(tid >> 6), r = lane & 15, c4 = lane >> 4; \
    const int nidle = (int)gridDim.x - c0, blkp = ((int)blockIdx.x - c0 + (int)gridDim.x) % (int)gridDim.x, ngw = nidle * NWAVES; \
    const int gwp = (blkp < nidle) ? wave * nidle + blkp : (1 << 30)

__device__ __forceinline__ void sk_res(const Args& A, const bf16* Aact, int K, const bf16* Bt, float* ss_out, float* fin, int c0) {
    SK_WAVE_IDS; bf16* XB = (bf16*)(A.ws + WS_XB);
    for (int task = gwp; task < 16 * 8; task += ngw) {
        const int it = task >> 3, rt = task & 7, row = MP + 16 * rt + r;
        const int nb[4] = {64 * it, 64 * it + 16, 64 * it + 32, 64 * it + 48};
        f32x4 acc[4]; wave_gemm<4>(acc, Aact + (size_t)row * K, Bt, nb, K, r, c4);
        float q = 0.f;
#pragma unroll
        for (int nt = 0; nt < 4; ++nt) { const int col = nb[nt] + 4 * c4; const v2u xi = *(const v2u*)(XB + (size_t)row * DM + col);
            const f32x4 v = (f32x4){bflo(xi.x), bfhi(xi.x), bflo(xi.y), bfhi(xi.y)} + acc[nt];
            if (fin) *(f32x4*)(fin + (size_t)row * DM + col) = v;
            else { v2u w; w.x = pk2(v[0], v[1]); w.y = pk2(v[2], v[3]); *(v2u*)(XB + (size_t)row * DM + col) = w; q += (v[0] * v[0] + v[1] * v[1]) + (v[2] * v[2] + v[3] * v[3]); } }
        if (!fin) { q += __shfl_xor(q, 16); q += __shfl_xor(q, 32); if (c4 == 0) ss_out[(size_t)row * 16 + it] = q; }
    }
}
__device__ __forceinline__ void sk_swiglu(const Args& A, const bf16* Bt, const float* ss, int c0) {
    SK_WAVE_IDS; const bf16* XB = (const bf16*)(A.ws + WS_XB); bf16* ACT = (bf16*)(A.ws + WS_ACT);
    for (int task = gwp; task < 88 * 8; task += ngw) {
        const int it = task >> 3, rt = task & 7, row = MP + 16 * rt + r, pn = it >> 2, i0 = (it & 3) * 32;
        const int nb[4] = {256 * pn + i0, 256 * pn + i0 + 16, 256 * pn + 128 + i0, 256 * pn + 128 + i0 + 16};
        f32x4 acc[4]; wave_gemm<4>(acc, XB + (size_t)row * DM, Bt, nb, DM, r, c4);
        const float rs = RS_OF(ss, row);
#pragma unroll
        for (int h2 = 0; h2 < 2; ++h2) { const f32x4 g = acc[h2] * rs, up = acc[2 + h2] * rs;
            v2u w; w.x = pk2(silu_f(g[0]) * up[0], silu_f(g[1]) * up[1]); w.y = pk2(silu_f(g[2]) * up[2], silu_f(g[3]) * up[3]);
            *(v2u*)(ACT + (size_t)row * DFF + 128 * pn + i0 + 16 * h2 + 4 * c4) = w; }
    }
}
__device__ __forceinline__ void sk_ssdin(const Args& A, const bf16* Bt, const float* ss, const float* dtb, int c0) {
    SK_WAVE_IDS; const bf16* XB = (const bf16*)(A.ws + WS_XB); bf16* ZX = (bf16*)(A.ws + WS_ZX); float* DT = (float*)(A.ws + WS_DT);
    for (int task = gwp; task < 80 * 8; task += ngw) {
        const int it = task >> 3, rt = task & 7, row = MP + 16 * rt + r;
        const int nb[4] = {64 * it, 64 * it + 16, 64 * it + 32, 64 * it + 48};
        f32x4 acc[4]; wave_gemm<4>(acc, XB + (size_t)row * DM, Bt, nb, DM, r, c4);
        const float rs = RS_OF(ss, row);
#pragma unroll
        for (int nt = 0; nt < 4; ++nt) { const f32x4 v = acc[nt] * rs; v2u w; w.x = pk2(v[0], v[1]); w.y = pk2(v[2], v[3]); *(v2u*)(ZX + (size_t)row * ZXW + nb[nt] + 4 * c4) = w; }
    }
    for (int task = (gwp < (1 << 30)) ? (gwp + ngw - (640 % ngw)) % ngw : gwp; task < (MP + MS) / 16; task += ngw) {
        const int row = 16 * task + r;
        const int nb[2] = {5120, 5136};
        f32x4 acc[2]; wave_gemm<2>(acc, XB + (size_t)row * DM, Bt, nb, DM, r, c4);
        const float rs = RS_OF(ss, row);
#pragma unroll
        for (int nt = 0; nt < 2; ++nt) { f32x4 v = acc[nt] * rs + *(const f32x4*)(dtb + 16 * nt + 4 * c4);
#pragma unroll
            for (int j = 0; j < 4; ++j) v[j] = softplus_f(v[j]);
            *(f32x4*)(DT + (size_t)row * 32 + 16 * nt + 4 * c4) = v; }
    }
}
__device__ __forceinline__ void sk_swaqkv(const Args& A, const bf16* Bt, const float* ss, int c0) {
    SK_WAVE_IDS; const bf16* XB = (const bf16*)(A.ws + WS_XB); bf16* Q = (bf16*)(A.ws + WS_QS);
    for (int task = gwp; task < 36 * 8; task += ngw) {
        const int slot = task >> 3, rt = task & 7, row = MP + 16 * rt + r, pn = slot >> 2, wc = slot & 3, kind = slot / 12, head = slot - kind * 12;
        const int nb[4] = {256 * pn + 32 * wc, 256 * pn + 32 * wc + 16, 256 * pn + 128 + 32 * wc, 256 * pn + 128 + 32 * wc + 16};
        f32x4 acc[4]; wave_gemm<4>(acc, XB + (size_t)row * DM, Bt, nb, DM, r, c4);
        const float rs = RS_OF(ss, row); float q = 0.f;
#pragma unroll
        for (int nt = 0; nt < 4; ++nt) { acc[nt] = acc[nt] * rs; q += (acc[nt][0] * acc[nt][0] + acc[nt][1] * acc[nt][1]) + (acc[nt][2] * acc[nt][2] + acc[nt][3] * acc[nt][3]); }
        if (kind < 2) { q += __shfl_xor(q, 16); q += __shfl_xor(q, 32); const float rr = rsqrtf(q * (1.0f / 64.0f) + EPS); const float* nwp = (const float*)A.in[kind == 0 ? I_SWAQN : I_SWAKN];
#pragma unroll
            for (int nt = 0; nt < 4; ++nt) acc[nt] = acc[nt] * rr * *(const f32x4*)(nwp + 16 * nt + 4 * c4); }
        bf16* dst = Q + (size_t)kind * ((WS_KS - WS_QS) / 2) + (size_t)row * SWAW + head * 64;
#pragma unroll
        for (int nt = 0; nt < 4; ++nt) { v2u w; w.x = pk2(acc[nt][0], acc[nt][1]); w.y = pk2(acc[nt][2], acc[nt][3]); *(v2u*)(dst + 16 * nt + 4 * c4) = w; }
        if (kind >= 1) { const int g = head >> 2, j4 = head & 3, kv = kind - 1, keep = 128 << (2 * g), r2 = row - MP, b = r2 >> 2, tt = r2 & 3;
            const int obs = g == 0 ? O_KV0_S : (g == 1 ? O_KV1_S : O_KV2_S);
            float* o = A.out + obs + (size_t)(((b * keep + (keep - 4 + tt)) * 2 + kv) * 4 + j4) * 64;
#pragma unroll
            for (int nt = 0; nt < 4; ++nt) *(f32x4*)(o + 16 * nt + 4 * c4) = acc[nt]; }
    }
}
__device__ __forceinline__ void sk_diffqkv(const Args& A, const bf16* Bt, const float* ss, int c0) {
    SK_WAVE_IDS; const bf16* XB = (const bf16*)(A.ws + WS_XB);
    for (int task = gwp; task < 40 * 8; task += ngw) {
        const int slot = task >> 3, rt = task & 7, row = MP + 16 * rt + r, pn = slot >> 2, wc = slot & 3, kind = slot < 24 ? 0 : (slot < 32 ? 1 : 2);
        const int nb[4] = {256 * pn + 32 * wc, 256 * pn + 32 * wc + 16, 256 * pn + 128 + 32 * wc, 256 * pn + 128 + 32 * wc + 16};
        f32x4 acc[4]; wave_gemm<4>(acc, XB + (size_t)row * DM, Bt, nb, DM, r, c4);
        const float rs = RS_OF(ss, row); float q = 0.f;
#pragma unroll
        for (int nt = 0; nt < 4; ++nt) { acc[nt] = acc[nt] * rs; q += (acc[nt][0] * acc[nt][0] + acc[nt][1] * acc[nt][1]) + (acc[nt][2] * acc[nt][2] + acc[nt][3] * acc[nt][3]); }
        if (kind < 2) { q += __shfl_xor(q, 16); q += __shfl_xor(q, 32); const float rr = rsqrtf(q * (1.0f / 64.0f) + EPS); const float* nwp = (const float*)A.in[kind == 0 ? I_DQN : I_DKN];
#pragma unroll
            for (int nt = 0; nt < 4; ++nt) acc[nt] = acc[nt] * rr * *(const f32x4*)(nwp + 16 * nt + 4 * c4); }
        bf16* dst; int cofs;
        if (kind == 0) { dst = (bf16*)(A.ws + WS_QD) + (size_t)row * DQW; cofs = slot * 64; }
        else { dst = (bf16*)(A.ws + WS_KD) + (size_t)(kind - 1) * ((WS_VD - WS_KD) / 2) + (size_t)row * DKW; cofs = (slot - (kind == 1 ? 24 : 32)) * 64; }
#pragma unroll
        for (int nt = 0; nt < 4; ++nt) { v2u w; w.x = pk2(acc[nt][0], acc[nt][1]); w.y = pk2(acc[nt][2], acc[nt][3]); *(v2u*)(dst + cofs + 16 * nt + 4 * c4) = w; }
        if (kind >= 1) { float* o = A.out + (kind == 1 ? O_DK_S : O_DV_S) + (size_t)(row - MP) * 512 + cofs;
#pragma unroll
            for (int nt = 0; nt < 4; ++nt) *(f32x4*)(o + 16 * nt + 4 * c4) = acc[nt]; }
    }
}

__device__ __forceinline__ int conv_src_col(int n0, int Nsrc, int Ndst, int maptype) {
    if (maptype == 0) return (n0 < Nsrc) ? n0 : -1;
    const int pn = n0 >> 8, r = n0 & 255;
    if (maptype == 1) return (r >> 7) * (Ndst >> 1) + 128 * pn + (r & 127);
    return 256 * pn + 64 * ((r & 127) >> 5) + 32 * (r >> 7);
}
__device__ __forceinline__ void conv_item(const float* __restrict__ W, int K, int Nsrc, int Ndst, bf16* WT, const float* __restrict__ gain, int maptype, LAS float* scr, int item, int lane) {
    const int nblk = Ndst / 64;
    const int kr = lane >> 4, nc = lane & 15;
    {
        const int kb = item / nblk, nb = item - kb * nblk, k0 = 64 * kb, n0 = 64 * nb;
        const int srcb = conv_src_col(n0 + 32 * (nc >> 3), Nsrc, Ndst, maptype);
        f32x4 v[16];
#pragma unroll
        for (int i = 0; i < 16; ++i) { v[i] = (f32x4){0.f, 0.f, 0.f, 0.f};
            if (srcb >= 0) { v[i] = *(const f32x4*)(W + (size_t)(k0 + 4 * i + kr) * Nsrc + srcb + 4 * (nc & 7)); if (gain) v[i] = v[i] * gain[k0 + 4 * i + kr]; } }
#pragma unroll
        for (int hf = 0; hf < 2; ++hf) {
#pragma unroll
            for (int i = 0; i < 8; ++i) { LAS float* d = scr + (4 * i + kr) * 65 + 4 * nc; const f32x4 x = v[8 * hf + i]; d[0] = x[0]; d[1] = x[1]; d[2] = x[2]; d[3] = x[3]; }
            LDS_WAIT(); asm volatile("" ::: "memory");
#pragma unroll
            for (int j = 0; j < 4; ++j) { const int id = j * 64 + lane, n = id >> 2, c = id & 3; const LAS float* sp = scr + (8 * c) * 65 + n;
                v4u o; o.x = pk2(sp[0 * 65], sp[1 * 65]); o.y = pk2(sp[2 * 65], sp[3 * 65]); o.z = pk2(sp[4 * 65], sp[5 * 65]); o.w = pk2(sp[6 * 65], sp[7 * 65]);
                *(v4u*)(WT + (size_t)(n0 + n) * K + k0 + 32 * hf + 8 * c) = o; }
            LDS_WAIT(); asm volatile("" ::: "memory");
        }
    }
}

__device__ __forceinline__ void cache_copy_slice(const Args& A, int part, int nparts, int c0) {
    const int tid = threadIdx.x, lane = tid & 63, wave = __builtin_amdgcn_readfirstlane(tid >> 6);
    const int nidle = (int)gridDim.x - c0, blkp = ((int)blockIdx.x - c0 + (int)gridDim.x) % (int)gridDim.x;
    if (blkp >= nidle) return;
    constexpr int R0 = NBS * 124, R1 = NBS * 508, R2 = NBS * 2044, RT = R0 + R1 + R2;
    const int lo = (int)((long)RT * part / nparts), hi = (int)((long)RT * (part + 1) / nparts);
    const int gw = blkp * NWAVES + wave, ngw = nidle * NWAVES;
    for (int it0 = lo + 4 * gw; it0 < hi; it0 += 4 * ngw) {
        f32x4 v[4][2]; float* dstp[4];
#pragma unroll
        for (int q = 0; q < 4; ++q) { const int it = it0 + q; dstp[q] = nullptr;
            if (it < hi) { int g, r; if (it < R0) { g = 0; r = it; } else if (it < R0 + R1) { g = 1; r = it - R0; } else { g = 2; r = it - R0 - R1; }
                const int lb = 128 << (2 * g), per = lb - 4, b = r / per, i = r - b * per;
                const float* src = (const float*)A.in[I_SWA0 + g] + ((size_t)(b * lb + i + 4)) * 512;
                dstp[q] = A.out + (g == 0 ? O_KV0_S : (g == 1 ? O_KV1_S : O_KV2_S)) + ((size_t)(b * lb + i)) * 512;
                v[q][0] = ((const f32x4*)src)[lane]; v[q][1] = ((const f32x4*)src)[lane + 64]; } }
#pragma unroll
        for (int q = 0; q < 4; ++q) if (dstp[q]) { ((f32x4*)dstp[q])[lane] = v[q][0]; ((f32x4*)dstp[q])[lane + 64] = v[q][1]; }
    }
}

__device__ __forceinline__ void prologue_phase(const Args& A, LAS unsigned char* lds) {
    const int tid = threadIdx.x, lane = tid & 63, wave = __builtin_amdgcn_readfirstlane(tid >> 6);
    const int gw = blockIdx.x * NWAVES + wave, ngw = gridDim.x * NWAVES;
    LAS float* scr = (LAS float*)(lds + wave * 8448);
    unsigned char* ws = A.ws;
    {
        constexpr int I0 = 16 * 84, I1 = 32 * 16, I2 = 16 * 36, I3 = 12 * 16, I4 = 16 * 40, I5 = 24 * 16, I6 = 16 * 88, I7 = 44 * 16;
        constexpr int P1 = 2 * I0, P2 = P1 + 2 * I1, P3 = P2 + I2, P4 = P3 + I3, P5 = P4 + I4, P6 = P5 + I5, P7 = P6 + 4 * I6, PT = P7 + 4 * I7;
        for (int item = gw; item < PT; item += ngw) {
            const float* W; int K, Nsrc, Ndst, mt, li; bf16* WT; const float* gain;
            if (item < P1)      { const int i = item / I0; li = item - i * I0; W = (const float*)A.in[I_SSMWIN] + (size_t)i * DM * SSMN; K = DM; Nsrc = SSMN; Ndst = SSMNP; mt = 0; WT = (bf16*)(ws + WS_WSSDIN + i * al4k(SZ_WSSDIN)); gain = (const float*)A.in[I_NMIX] + (i == 0 ? 0 : 3) * DM; }
            else if (item < P2) { const int r = item - P1, i = r / I1; li = r - i * I1; W = (const float*)A.in[I_SSMWOUT] + (size_t)i * DIN * DM; K = DIN; Nsrc = DM; Ndst = DM; mt = 0; WT = (bf16*)(ws + WS_WSSDOUT + i * al4k(SZ_WSSDOUT)); gain = nullptr; }
            else if (item < P3) { li = item - P2; W = (const float*)A.in[I_SWAQKV]; K = DM; Nsrc = 2304; Ndst = 2304; mt = 2; WT = (bf16*)(ws + WS_WSWAQKV); gain = (const float*)A.in[I_NMIX] + 1 * DM; }
            else if (item < P4) { li = item - P3; W = (const float*)A.in[I_SWAOUT]; K = SWAW; Nsrc = DM; Ndst = DM; mt = 0; WT = (bf16*)(ws + WS_WSWAOUT); gain = nullptr; }
            else if (item < P5) { li = item - P4; W = (const float*)A.in[I_DQKV]; K = DM; Nsrc = 2560; Ndst = 2560; mt = 2; WT = (bf16*)(ws + WS_WDQKV); gain = (const float*)A.in[I_NMIX] + 2 * DM; }
            else if (item < P6) { li = item - P5; W = (const float*)A.in[I_DOUT]; K = DQW; Nsrc = DM; Ndst = DM; mt = 0; WT = (bf16*)(ws + WS_WDOUT); gain = nullptr; }
            else if (item < P7) { const int r = item - P6, l = r / I6; li = r - l * I6; W = (const float*)A.in[I_FFIN] + (size_t)l * DM * 2 * DFF; K = DM; Nsrc = 2 * DFF; Ndst = 2 * DFF; mt = 1; WT = (bf16*)(ws + WS_WFFIN + l * al4k(SZ_WFFIN)); gain = (const float*)A.in[I_NFFN] + l * DM; }
            else                { const int r = item - P7, l = r / I7; li = r - l * I7; W = (const float*)A.in[I_FFOUT] + (size_t)l * DFF * DM; K = DFF; Nsrc = DM; Ndst = DM; mt = 0; WT = (bf16*)(ws + WS_WFFOUT + l * al4k(SZ_WFFOUT)); gain = nullptr; }
            conv_item(W, K, Nsrc, Ndst, WT, gain, mt, scr, li, lane);
        }
    }
    {
        bf16* XB = (bf16*)(ws + WS_XB); float* ss0 = (float*)(ws + WS_SS);
        for (int m = gw; m < MPAD; m += ngw) {
            f32x4 v[4]; float s = 0.f;
            const float* src = m < MP ? (const float*)A.in[I_XP] + (size_t)m * DM : (const float*)A.in[I_XS] + (size_t)(m - MP) * DM;
#pragma unroll
            for (int j = 0; j < 4; ++j) { v[j] = (m < MTOK) ? ((const f32x4*)src)[lane + 64 * j] : (f32x4){0.f, 0.f, 0.f, 0.f}; s += (v[j][0] * v[j][0] + v[j][1] * v[j][1]) + (v[j][2] * v[j][2] + v[j][3] * v[j][3]); }
            s = wave_sum(s);
#pragma unroll
            for (int j = 0; j < 4; ++j) { v2u w; w.x = pk2(v[j][0], v[j][1]); w.y = pk2(v[j][2], v[j][3]); ((v2u*)(XB + (size_t)m * DM))[lane + 64 * j] = w; }
            if (lane < 16) ss0[(size_t)m * 16 + lane] = (lane == 0) ? s : 0.f;
        }
    }
}

__device__ __forceinline__ void ssd_prompt_unit(const Args& A, LAS unsigned char* lds, int li, int b, int h);
__device__ __forceinline__ void ssd_scan_phase(const Args& A, LAS unsigned char* lds, int li) {
    const int tid = threadIdx.x;
    unsigned char* ws = A.ws;
    const bf16* ZX = (const bf16*)(ws + WS_ZX); const float* DT = (const float*)(ws + WS_DT); bf16* YG = (bf16*)(ws + WS_YG);
    const float* convw = (const float*)A.in[I_CONVW] + li * 4 * CONVD; const float* convb = (const float*)A.in[I_CONVB] + li * CONVD;
    const float* alog = (const float*)A.in[I_ALOG] + li * 32; const float* dsk = (const float*)A.in[I_SSMD] + li * 32;
    const float* cst = (const float*)A.in[I_CONVST] + (size_t)li * NBS * 3 * CONVD;
    const float* sst = (const float*)A.in[I_SSMST] + (size_t)li * NBS * 32 * 8192;
    float* out = A.out;
    {
        int tg = tid; asm volatile("" : "+v"(tg)); const int gt = blockIdx.x * NTHR + tg, ngt = gridDim.x * NTHR;
        for (int e = gt; e < NBP * 3 * CONVD; e += ngt) { const int b = e / (3 * CONVD), r = e - b * 3 * CONVD, j = r / CONVD, ch = r - j * CONVD;
            out[O_CONV_P + li * (NBP * 3 * CONVD) + e] = bf2f(ZX[(size_t)(b * SEQ + SEQ - 3 + j) * ZXW + 2048 + ch]); }
        for (int e = gt; e < NBS * 3 * CONVD; e += ngt) { const int b = e / (3 * CONVD), r = e - b * 3 * CONVD, j = r / CONVD, ch = r - j * CONVD;
            out[O_CONV_S + li * (NBS * 3 * CONVD) + e] = bf2f(ZX[(size_t)(MP + b * 4 + 1 + j) * ZXW + 2048 + ch]); }
    }
    for (int rep = 0; rep < REP_SCANP; ++rep)
    for (int u = blockIdx.x; u < 256; u += gridDim.x) ssd_prompt_unit(A, lds, li, u >> 5, u & 31);
    {
        int tidS = tid; asm volatile("" : "+v"(tidS));
        const int lane = tidS & 63, wave = __builtin_amdgcn_readfirstlane(tidS >> 6), G = gridDim.x;
        LAS float* bc = (LAS float*)lds + wave * 1024;
        __syncthreads();
        for (int rep = 0; rep < REP_SCANS; ++rep)
        for (int task = wave * G + (int)blockIdx.x; task < NBS * 32; task += NWAVES * G) {
            const int b = task >> 5, h = task & 31, g = h >> 3, rb = MP + b * TS;
            f32x4 H[32];
            { const f32x4* sp = (const f32x4*)(sst + ((size_t)((b * 32 + h) * 64 + lane)) * 128);
#pragma unroll
              for (int q = 0; q < 32; ++q) H[q] = sp[q]; }
            float xv[4], zv[4], dtv[4];
            {
                int cch[5] = {h * 64 + lane, 2048 + g * 128 + lane, 2048 + g * 128 + 64 + lane, 2560 + g * 128 + lane, 2560 + g * 128 + 64 + lane};
#pragma unroll
                for (int ci = 0; ci < 5; ++ci) { const int cc = cch[ci];
                    float in[7];
#pragma unroll
                    for (int k = 0; k < 3; ++k) in[k] = cst[(size_t)(b * 3 + k) * CONVD + cc];
#pragma unroll
                    for (int k = 0; k < 4; ++k) in[3 + k] = bf2f(ZX[(size_t)(rb + k) * ZXW + 2048 + cc]);
                    const float w0 = convw[cc], w1 = convw[CONVD + cc], w2 = convw[2 * CONVD + cc], w3 = convw[3 * CONVD + cc], bs = convb[cc];
#pragma unroll
                    for (int tt = 0; tt < 4; ++tt) { const float v = silu_f(bs + w0 * in[tt] + w1 * in[tt + 1] + w2 * in[tt + 2] + w3 * in[tt + 3]);
                        if (ci == 0) xv[tt] = v; else bc[tt * 256 + (ci - 1) * 64 + lane] = v; }
                }
#pragma unroll
                for (int tt = 0; tt < 4; ++tt) { zv[tt] = bf2f(ZX[(size_t)(rb + tt) * ZXW + h * 64 + lane]); dtv[tt] = DT[(size_t)(rb + tt) * 32 + h]; }
            }
            LDS_WAIT(); __builtin_amdgcn_wave_barrier();
            const float a = -__expf(alog[h]), Dh = dsk[h];
#pragma unroll
            for (int tt = 0; tt < 4; ++tt) {
                const float dt = dtv[tt], dA = __expf(dt * a), dtx = dt * xv[tt];
                const LAS f32x4* Bp = (const LAS f32x4*)(bc + tt * 256); const LAS f32x4* Cp = Bp + 32;
                float y0 = 0.f, y1 = 0.f;
#pragma unroll
                for (int q = 0; q < 32; ++q) { const f32x4 bb = Bp[q], cq = Cp[q];
                    H[q] = H[q] * dA + bb * dtx;
                    y0 += cq[0] * H[q][0] + cq[1] * H[q][1]; y1 += cq[2] * H[q][2] + cq[3] * H[q][3]; }
                const float y = (y0 + y1) + Dh * xv[tt];
                YG[(size_t)(rb + tt) * DIN + h * 64 + lane] = (bf16)f2bf(y * silu_f(zv[tt]));
            }
            { f32x4* so = (f32x4*)(out + O_SSM_S + li * (NBS * 32 * 8192) + ((size_t)((b * 32 + h) * 64 + lane)) * 128);
#pragma unroll
              for (int q = 0; q < 32; ++q) so[q] = H[q]; }
            LDS_WAIT(); __builtin_amdgcn_wave_barrier();
        }
        __syncthreads();
    }
}

__device__ __forceinline__ int pi32_pos0(int tb8) { return ((tb8 >> 2) << 5) + 16 * (tb8 & 1) + 4 * ((tb8 >> 1) & 1); }
__device__ __forceinline__ void ssd_prepass_phase(const Args& A, LAS unsigned char* lds, int li) {
    int tid = threadIdx.x; asm volatile("" : "+v"(tid));
    const int lane = tid & 63, wave = __builtin_amdgcn_readfirstlane(tid >> 6);
    const int gw = blockIdx.x * NWAVES + wave, ngw = gridDim.x * NWAVES, gt = blockIdx.x * NTHR + tid, ngt = gridDim.x * NTHR;
    const bf16* ZX = (const bf16*)(A.ws + WS_ZX); const float* DT = (const float*)(A.ws + WS_DT);
    bf16* BC = (bf16*)(A.ws + WS_BC); bf16* BT = (bf16*)(A.ws + WS_BT); f32x4* SC = (f32x4*)(A.ws + WS_SC);
    const float* convw = (const float*)A.in[I_CONVW] + li * 4 * CONVD; const float* convb = (const float*)A.in[I_CONVB] + li * CONVD;
    const float* alog = (const float*)A.in[I_ALOG] + li * 32;
    for (int wt = blockIdx.x; wt < NBP * 32 * 2; wt += gridDim.x) {
        const int hc = wt & 1, tb4 = (wt >> 1) & 31, b = wt >> 6, ch = hc * 512 + tid, cc = 2048 + ch, t0 = tb4 * 64;
        const float w0 = convw[cc], w1 = convw[CONVD + cc], w2 = convw[2 * CONVD + cc], w3 = convw[3 * CONVD + cc], bs = convb[cc];
        unsigned raw[67];
#pragma unroll
        for (int k = 0; k < 67; ++k) { const int t = t0 - 3 + k; raw[k] = 0u; if (t >= 0) raw[k] = (unsigned)ZX[(size_t)(b * SEQ + t) * ZXW + 2048 + cc]; }
        unsigned op[32];
#pragma unroll
        for (int e = 0; e < 64; e += 2) {
            const float oa = silu_f(bs + w0 * bflo(raw[e]) + w1 * bflo(raw[e + 1]) + w2 * bflo(raw[e + 2]) + w3 * bflo(raw[e + 3]));
            const float ob = silu_f(bs + w0 * bflo(raw[e + 1]) + w1 * bflo(raw[e + 2]) + w2 * bflo(raw[e + 3]) + w3 * bflo(raw[e + 4]));
            BC[(size_t)(b * SEQ + t0 + e) * 1024 + ch] = (bf16)f2bf(oa); BC[(size_t)(b * SEQ + t0 + e + 1) * 1024 + ch] = (bf16)f2bf(ob);
            op[e >> 1] = pk2(oa, ob);
        }
        if (hc == 0) {
            LAS unsigned char* rowl = lds + tid * 144;
#pragma unroll
            for (int tb8 = 0; tb8 < 8; ++tb8) { const int p0 = ((tb8 >> 2) << 5) + 16 * (tb8 & 1) + 4 * ((tb8 >> 1) & 1);
                v2u a; a.x = op[4 * tb8]; a.y = op[4 * tb8 + 1]; v2u c2; c2.x = op[4 * tb8 + 2]; c2.y = op[4 * tb8 + 3];
                *(LAS v2u*)(rowl + p0 * 2) = a; *(LAS v2u*)(rowl + (p0 + 8) * 2) = c2; }
            __syncthreads();
#pragma unroll
            for (int j = 0; j < 8; ++j) { const int id = j * NTHR + tid, rw = id >> 3, c = id & 7;
                const v4u piece = *(const LAS v4u*)(lds + rw * 144 + c * 16);
                *(v4u*)(BT + (size_t)((b * 4 + (rw >> 7)) * 128 + (rw & 127)) * SEQ + t0 + c * 8) = piece; }
            __syncthreads();
        }
    }
    for (int task = gw; task < NBP * 32 * 32; task += ngw) {
        const int h = task & 31, ck = (task >> 5) & 31, b = task >> 10, row = b * SEQ + ck * 64 + lane;
        const float dt = DT[(size_t)row * 32 + h], a = -__expf(alog[h]);
        float x = dt * a;
#pragma unroll
        for (int o = 1; o < 64; o <<= 1) { const float y = __shfl_up(x, o); if (lane >= o) x += y; }
        const float tot = __shfl(x, 63);
        SC[(size_t)row * 32 + h] = (f32x4){x, dt, dt * __expf(tot - x), __expf(x)};
    }
}


namespace ssdk { constexpr int PX = 144, PC = 272;
    constexpr int XST = 0, XSW = XST + 64 * PX, CM = XSW + 64 * PX, BM = CM + 64 * PC, BMT = BM + 64 * PC, HB = BMT + 128 * PX, SCL = HB + 64 * PC; }
template <int NJ>
__device__ __forceinline__ void ssd_stage1(LAS unsigned char* lds, const pg8::bf16x8 (&cf)[4], const LAS float* cumL, const LAS float* dtL, int r, int c, float Dh, pg8::bf16x8 (&wf)[2]) {
    constexpr int it = NJ - 1;
    f32x4 g4[4];
#pragma unroll
    for (int jt = 0; jt < 4; ++jt) g4[jt] = (f32x4){0.f, 0.f, 0.f, 0.f};
#pragma unroll
    for (int kh = 0; kh < 2; ++kh) {
        pg8::bf16x8 bfr[NJ][2];
#pragma unroll
        for (int jt = 0; jt < NJ; ++jt)
#pragma unroll
            for (int k2 = 0; k2 < 2; ++k2) bfr[jt][k2] = *(const LAS pg8::bf16x8*)(lds + ssdk::BM + (16 * jt + r) * ssdk::PC + (32 * (2 * kh + k2) + 8 * c) * 2);
        __builtin_amdgcn_sched_barrier(0);
#pragma unroll
        for (int k2 = 0; k2 < 2; ++k2)
#pragma unroll
            for (int jt = 0; jt < NJ; ++jt) g4[jt] = __builtin_amdgcn_mfma_f32_16x16x32_bf16(bfr[jt][k2], cf[2 * kh + k2], g4[jt], 0, 0, 0);
        __builtin_amdgcn_sched_barrier(0);
    }
    f32x4 cj[NJ], dj[NJ];
#pragma unroll
    for (int jt = 0; jt < NJ; ++jt) { cj[jt] = *(const LAS f32x4*)(cumL + 16 * jt + 4 * c); dj[jt] = *(const LAS f32x4*)(dtL + 16 * jt + 4 * c); }
    const float ci = cumL[16 * it + r];
#pragma unroll
    for (int jt = 0; jt < NJ; ++jt)
#pragma unroll
        for (int q = 0; q < 4; ++q) {
            float wv = g4[jt][q] * __expf(ci - cj[jt][q]) * dj[jt][q];
            if (jt == it) { const int jl = 4 * c + q; wv = (jl <= r) ? wv : 0.f; if (jl == r) wv += Dh; }
            g4[jt][q] = wv; }
#pragma unroll
    for (int kk = 0; kk < 2; ++kk) { v4u w; w.x = pk2(g4[2 * kk][0], g4[2 * kk][1]); w.y = pk2(g4[2 * kk][2], g4[2 * kk][3]); w.z = pk2(g4[2 * kk + 1][0], g4[2 * kk + 1][1]); w.w = pk2(g4[2 * kk + 1][2], g4[2 * kk + 1][3]);
        wf[kk] = __builtin_bit_cast(pg8::bf16x8, w); }
}

__device__ __forceinline__ void ssd_prompt_unit(const Args& A, LAS unsigned char* lds, int li, int b, int h) {
    const int tid = threadIdx.x, lane = tid & 63, wave = __builtin_amdgcn_readfirstlane(tid >> 6);
    const int r = lane & 15, c = lane >> 4, it = (wave < 4) ? (wave >> 1) : 3 - ((wave - 4) >> 1), ph = wave & 1, g = h >> 3, rb = b * SEQ;
    using namespace ssdk;
    static_assert(SCL + 1024 <= RING_BYTES, "ssd LDS map");
    LAS float* cumL = (LAS float*)(lds + SCL); LAS float* dtL = cumL + 64; LAS float* ecL = cumL + 128;
    const bf16* ZX = (const bf16*)(A.ws + WS_ZX); const bf16* BC = (const bf16*)(A.ws + WS_BC); const bf16* BT = (const bf16*)(A.ws + WS_BT); const f32x4* SC = (const f32x4*)(A.ws + WS_SC);
    bf16* YG = (bf16*)(A.ws + WS_YG);
    const float* convw = (const float*)A.in[I_CONVW] + li * 4 * CONVD; const float* convb = (const float*)A.in[I_CONVB] + li * CONVD;
    const float Dh = ((const float*)A.in[I_SSMD])[li * 32 + h];
    const int xcc = h * 64 + lane;
    const float xw0 = convw[xcc], xw1 = convw[CONVD + xcc], xw2 = convw[2 * CONVD + xcc], xw3 = convw[3 * CONVD + xcc], xbs = convb[xcc];
    const int xpos = pi32_pos0(wave);
    const int crow = tid >> 4, cc16 = tid & 15, tn = tid >> 3, tc8 = tid & 7;
    const bf16* csrc = BC + (size_t)(rb + crow) * 1024 + 512 + g * 128 + cc16 * 8;
    const bf16* bsrc = BC + (size_t)(rb + crow) * 1024 + g * 128 + cc16 * 8;
    const bf16* tsrc = BT + (size_t)((b * 4 + g) * 128 + tn) * SEQ + tc8 * 8;
    const int cdst = crow * PC + cc16 * 16, tdst = tn * PX + tc8 * 16;
    f32x4 Ht[4];
#pragma unroll
    for (int i = 0; i < 4; ++i) Ht[i] = (f32x4){0.f, 0.f, 0.f, 0.f};
    struct SsdRegs { v4u pc0, pc1, pb0, pb1, pt0, pt1; f32x4 psc; unsigned xr[11]; float xwj[8]; v2u zz[2]; };
    SsdRegs R0;
    R0.psc = (f32x4){0.f, 0.f, 0.f, 0.f};
#define SSD_PREFETCH(R, ck) do { const size_t ro = (size_t)(ck) * 64 * 1024; \
        R.pc0 = *(const v4u*)(csrc + ro); R.pc1 = *(const v4u*)(csrc + ro + 32 * 1024); R.pb0 = *(const v4u*)(bsrc + ro); R.pb1 = *(const v4u*)(bsrc + ro + 32 * 1024); \
        R.pt0 = *(const v4u*)(tsrc + (ck) * 64); R.pt1 = *(const v4u*)(tsrc + (ck) * 64 + (size_t)64 * SEQ); \
        if (tid < 64) R.psc = SC[(size_t)(rb + (ck) * 64 + tid) * 32 + h]; \
        _Pragma("unroll") for (int k = 0; k < 11; ++k) { const int t = (ck) * 64 + 8 * wave - 3 + k; R.xr[k] = ZX[(size_t)(rb + (t < 0 ? 0 : t)) * ZXW + 2048 + xcc]; } \
        _Pragma("unroll") for (int e = 0; e < 8; ++e) R.xwj[e] = ((const float*)SC)[((size_t)(rb + (ck) * 64 + 8 * wave + e) * 32 + h) * 4 + 2]; \
        _Pragma("unroll") for (int pt = 0; pt < 2; ++pt) R.zz[pt] = *(const v2u*)(ZX + (size_t)(rb + (ck) * 64 + 16 * it + r) * ZXW + h * 64 + 32 * ph + 16 * pt + 4 * c); } while (0)
#define SSD_CHUNK(R, ck) do { \
        __syncthreads();                                              \
        _Pragma("unroll") for (int pt = 0; pt < 4; ++pt) { v2u w; w.x = pk2(Ht[pt][0], Ht[pt][1]); w.y = pk2(Ht[pt][2], Ht[pt][3]); *(LAS v2u*)(lds + HB + (16 * pt + r) * PC + (16 * wave + 4 * c) * 2) = w; } \
        *(LAS v4u*)(lds + CM + cdst) = R.pc0; *(LAS v4u*)(lds + CM + cdst + 32 * PC) = R.pc1; \
        *(LAS v4u*)(lds + BM + cdst) = R.pb0; *(LAS v4u*)(lds + BM + cdst + 32 * PC) = R.pb1; \
        *(LAS v4u*)(lds + BMT + tdst) = R.pt0; *(LAS v4u*)(lds + BMT + tdst + 64 * PX) = R.pt1; \
        if (tid < 64) { cumL[tid] = R.psc[0]; dtL[tid] = R.psc[1]; ecL[tid] = R.psc[3]; } \
        { float o[8]; \
            float xin[11]; \
            _Pragma("unroll") for (int k = 0; k < 11; ++k) xin[k] = ((ck) * 64 + 8 * wave - 3 + k >= 0) ? bflo(R.xr[k]) : 0.f; \
            _Pragma("unroll") for (int e = 0; e < 8; ++e) o[e] = silu_f(xbs + xw0 * xin[e] + xw1 * xin[e + 1] + xw2 * xin[e + 2] + xw3 * xin[e + 3]); \
            v2u a, a2, s1, s2; a.x = pk2(o[0], o[1]); a.y = pk2(o[2], o[3]); a2.x = pk2(o[4], o[5]); a2.y = pk2(o[6], o[7]); \
            s1.x = pk2(o[0] * R.xwj[0], o[1] * R.xwj[1]); s1.y = pk2(o[2] * R.xwj[2], o[3] * R.xwj[3]); s2.x = pk2(o[4] * R.xwj[4], o[5] * R.xwj[5]); s2.y = pk2(o[6] * R.xwj[6], o[7] * R.xwj[7]); \
            *(LAS v2u*)(lds + XST + lane * PX + xpos * 2) = a; *(LAS v2u*)(lds + XST + lane * PX + (xpos + 8) * 2) = a2; \
            *(LAS v2u*)(lds + XSW + lane * PX + xpos * 2) = s1; *(LAS v2u*)(lds + XSW + lane * PX + (xpos + 8) * 2) = s2; } \
        const v2u zc0 = R.zz[0], zc1 = R.zz[1]; \
        __syncthreads();                                              \
        const int tok = rb + (ck) * 64 + 16 * it + r; \
        if ((ck) + 1 < 32) SSD_PREFETCH(R, (ck) + 1); \
        pg8::bf16x8 cf[4]; \
        _Pragma("unroll") for (int ks = 0; ks < 4; ++ks) cf[ks] = *(const LAS pg8::bf16x8*)(lds + CM + (16 * it + r) * PC + (32 * ks + 8 * c) * 2); \
        pg8::bf16x8 wf[2]; \
        if (it == 0) ssd_stage1<1>(lds, cf, cumL, dtL, r, c, Dh, wf); else if (it == 1) ssd_stage1<2>(lds, cf, cumL, dtL, r, c, Dh, wf); \
        else if (it == 2) ssd_stage1<3>(lds, cf, cumL, dtL, r, c, Dh, wf); else ssd_stage1<4>(lds, cf, cumL, dtL, r, c, Dh, wf); \
          \
        pg8::bf16x8 hfr[2][4], xfr[2][2]; \
        _Pragma("unroll") for (int pt = 0; pt < 2; ++pt) { \
            _Pragma("unroll") for (int ks = 0; ks < 4; ++ks) hfr[pt][ks] = *(const LAS pg8::bf16x8*)(lds + HB + (32 * ph + 16 * pt + r) * PC + (32 * ks + 8 * c) * 2); \
            _Pragma("unroll") for (int kk = 0; kk < 2; ++kk) xfr[pt][kk] = *(const LAS pg8::bf16x8*)(lds + XST + (32 * ph + 16 * pt + r) * PX + (32 * kk + 8 * c) * 2); } \
        const float eci = ecL[16 * it + r], etot = ecL[63]; \
        __builtin_amdgcn_sched_barrier(0); \
        f32x4 yt[2]; yt[0] = (f32x4){0.f, 0.f, 0.f, 0.f}; yt[1] = yt[0]; \
        _Pragma("unroll") for (int ks = 0; ks < 4; ++ks) \
            _Pragma("unroll") for (int pt = 0; pt < 2; ++pt) yt[pt] = __builtin_amdgcn_mfma_f32_16x16x32_bf16(hfr[pt][ks], cf[ks], yt[pt], 0, 0, 0); \
        yt[0] = yt[0] * eci; yt[1] = yt[1] * eci; \
        _Pragma("unroll") for (int kk = 0; kk < 2; ++kk) \
            _Pragma("unroll") for (int pt = 0; pt < 2; ++pt) yt[pt] = __builtin_amdgcn_mfma_f32_16x16x32_bf16(xfr[pt][kk], wf[kk], yt[pt], 0, 0, 0); \
        _Pragma("unroll") for (int pt = 0; pt < 2; ++pt) { \
            const v2u zq = pt ? zc1 : zc0; \
            const float z0 = bflo(zq.x), z1 = bfhi(zq.x), z2 = bflo(zq.y), z3 = bfhi(zq.y); \
            v2u w; w.x = pk2(yt[pt][0] * silu_f(z0), yt[pt][1] * silu_f(z1)); w.y = pk2(yt[pt][2] * silu_f(z2), yt[pt][3] * silu_f(z3)); \
            *(v2u*)(YG + (size_t)tok * DIN + h * 64 + 32 * ph + 16 * pt + 4 * c) = w; } \
        __builtin_amdgcn_sched_barrier(0); \
          \
        pg8::bf16x8 tfr[2], sfr[2][4]; \
        _Pragma("unroll") for (int kk = 0; kk < 2; ++kk) { tfr[kk] = *(const LAS pg8::bf16x8*)(lds + BMT + (16 * wave + r) * PX + (32 * kk + 8 * c) * 2); \
            _Pragma("unroll") for (int pt = 0; pt < 4; ++pt) sfr[kk][pt] = *(const LAS pg8::bf16x8*)(lds + XSW + (16 * pt + r) * PX + (32 * kk + 8 * c) * 2); } \
        __builtin_amdgcn_sched_barrier(0); \
        _Pragma("unroll") for (int pt = 0; pt < 4; ++pt) Ht[pt] = Ht[pt] * etot; \
        _Pragma("unroll") for (int kk = 0; kk < 2; ++kk) \
            _Pragma("unroll") for (int pt = 0; pt < 4; ++pt) Ht[pt] = __builtin_amdgcn_mfma_f32_16x16x32_bf16(tfr[kk], sfr[kk][pt], Ht[pt], 0, 0, 0); \
    } while (0)
    SSD_PREFETCH(R0, 0);
#pragma unroll 1
    for (int ck = 0; ck < 32; ++ck) { SSD_CHUNK(R0, ck); }
#undef SSD_CHUNK
#undef SSD_PREFETCH
    int r2 = r, c2 = c; asm volatile("" : "+v"(r2), "+v"(c2));
    float* so = A.out + O_SSM_P + li * (NBP * 32 * 8192) + (size_t)((b * 32 + h) * 64) * 128;
#pragma unroll
    for (int pt = 0; pt < 4; ++pt) *(f32x4*)(so + (size_t)(16 * pt + r2) * 128 + 16 * wave + 4 * c2) = Ht[pt];
    __syncthreads();
}

__device__ __forceinline__ void ssd_gatenorm_phase(const Args& A, int li, bf16* YG) {
    const int tid = threadIdx.x, lane = tid & 63, wave = __builtin_amdgcn_readfirstlane(tid >> 6);
    const int gw = blockIdx.x * NWAVES + wave, ngw = gridDim.x * NWAVES;
    const float* nrm = (const float*)A.in[I_SSMNORM] + li * DIN;
    for (int r0 = gw; r0 < MTOK; r0 += 2 * ngw) {
      v4u w2[2][4];
#pragma unroll
      for (int rr = 0; rr < 2; ++rr) { const int row = r0 + rr * ngw;
#pragma unroll
        for (int g = 0; g < 4; ++g) w2[rr][g] = (row < MTOK) ? *(const v4u*)(YG + (size_t)row * DIN + g * 512 + lane * 8) : (v4u){0u, 0u, 0u, 0u}; }
#pragma unroll
      for (int rr = 0; rr < 2; ++rr) { const int row = r0 + rr * ngw; if (row >= MTOK) break;
        v4u w[4];
#pragma unroll
        for (int g = 0; g < 4; ++g) w[g] = w2[rr][g];
#pragma unroll
        for (int g = 0; g < 4; ++g) {
            float v[8] = {bflo(w[g].x), bfhi(w[g].x), bflo(w[g].y), bfhi(w[g].y), bflo(w[g].z), bfhi(w[g].z), bflo(w[g].w), bfhi(w[g].w)};
            float q = 0.f;
#pragma unroll
            for (int e = 0; e < 8; ++e) q += v[e] * v[e];
            q = wave_sum(q); const float r = rsqrtf(q * (1.0f / 512.0f) + EPS);
            const f32x4 n0 = *(const f32x4*)(nrm + g * 512 + lane * 8), n1 = *(const f32x4*)(nrm + g * 512 + lane * 8 + 4);
            v4u o; o.x = pk2(v[0] * r * n0[0], v[1] * r * n0[1]); o.y = pk2(v[2] * r * n0[2], v[3] * r * n0[3]); o.z = pk2(v[4] * r * n1[0], v[5] * r * n1[1]); o.w = pk2(v[6] * r * n1[2], v[7] * r * n1[3]);
            *(v4u*)(YG + (size_t)row * DIN + g * 512 + lane * 8) = o;
        }
      }
    }
}

__device__ __forceinline__ float dot64_bb(const v4u (&q)[8], const bf16* krow) {
    const v4u* kp = (const v4u*)krow; float acc = 0.f;
#pragma unroll
    for (int i = 0; i < 8; ++i) { const v4u k = kp[i];
        acc += bflo(q[i].x) * bflo(k.x) + bfhi(q[i].x) * bfhi(k.x) + bflo(q[i].y) * bflo(k.y) + bfhi(q[i].y) * bfhi(k.y)
             + bflo(q[i].z) * bflo(k.z) + bfhi(q[i].z) * bfhi(k.z) + bflo(q[i].w) * bflo(k.w) + bfhi(q[i].w) * bfhi(k.w); }
    return acc;
}
__device__ __forceinline__ float dot64_bf(const v4u (&q)[8], const float* krow) {
    const f32x4* kp = (const f32x4*)krow; float acc = 0.f;
#pragma unroll
    for (int i = 0; i < 8; ++i) { const f32x4 k0 = kp[2 * i], k1 = kp[2 * i + 1];
        acc += bflo(q[i].x) * k0[0] + bfhi(q[i].x) * k0[1] + bflo(q[i].y) * k0[2] + bfhi(q[i].y) * k0[3]
             + bflo(q[i].z) * k1[0] + bfhi(q[i].z) * k1[1] + bflo(q[i].w) * k1[2] + bfhi(q[i].w) * k1[3]; }
    return acc;
}


__device__ __forceinline__ void swa_prompt_mfma(const Args& A, LAS unsigned char* lds) {
    const int tid = threadIdx.x, lane = tid & 63, wave = __builtin_amdgcn_readfirstlane(tid >> 6);
    const int gw = blockIdx.x * NWAVES + wave, ngw = gridDim.x * NWAVES, l31 = lane & 31, hh = lane >> 5;
    LAS float* tab = (LAS float*)(lds + 8192);
    const bf16* QS = (const bf16*)(A.ws + WS_QS); const bf16* KS = (const bf16*)(A.ws + WS_KS); const bf16* VTS = (const bf16*)(A.ws + WS_VTS); bf16* AO = (bf16*)(A.ws + WS_AO);
    float* LSE = (float*)(A.ws + WS_LSE);
    const float* relb = (const float*)A.in[I_RELB];
    const float LOG2E = 1.4426950408889634f, c1 = 0.125f * LOG2E;
    __syncthreads();
    for (int e = tid; e < 12 * 129; e += NTHR) { const int head = e / 129, n = e - head * 129; tab[head * 132 + n] = relb[rel_bucket(n << (2 * (head >> 2))) * 12 + head] * LOG2E; }
    __syncthreads();
    for (int task = gw; task < NBP * 12 * 64; task += ngw) {
        const int blk = task & 63, bhd = task >> 6, head = bhd % 12, b = bhd / 12, g = head >> 2, lg = 2 * g;
        const int ncb = 64 >> lg, cls = blk / ncb, qb = blk - cls * ncb, ncls = SEQ >> lg;
        const int qpos = 32 * qb + l31, qtok = b * SEQ + (qpos << lg) + cls;
        pg8::bf16x8 qf[4];
#pragma unroll
        for (int ks = 0; ks < 4; ++ks) qf[ks] = *(const pg8::bf16x8*)(QS + (size_t)qtok * SWAW + head * 64 + 16 * ks + 8 * hh);
        f32x16 o[2];
#pragma unroll
        for (int i = 0; i < 2; ++i)
#pragma unroll
            for (int r = 0; r < 16; ++r) o[i][r] = 0.f;
        float m_run = -INFINITY, l_run = 0.f;
        const bf16* vbase = VTS + (size_t)((b * 12 + head) * 64 + l31) * SEQ + cls * ncls + 8 * hh;
        const LAS float* tb = tab + head * 132;
        const int kt0 = qb >= 4 ? qb - 4 : 0;
        pg8::bf16x8 kf[4], vf[2][2];
#define SWA_LOAD(kt) do { const int ktok = b * SEQ + ((32 * (kt) + l31) << lg) + cls; \
            _Pragma("unroll") for (int ks = 0; ks < 4; ++ks) kf[ks] = *(const pg8::bf16x8*)(KS + (size_t)ktok * SWAW + head * 64 + 16 * ks + 8 * hh); \
            _Pragma("unroll") for (int dvt = 0; dvt < 2; ++dvt) _Pragma("unroll") for (int s2 = 0; s2 < 2; ++s2) vf[dvt][s2] = *(const pg8::bf16x8*)(vbase + (size_t)(dvt * 32) * SEQ + 32 * (kt) + 16 * s2); } while (0)
        SWA_LOAD(kt0);
        for (int kt = kt0; kt <= qb; ++kt) {
            f32x16 S;
#pragma unroll
            for (int r = 0; r < 16; ++r) S[r] = 0.f;
#pragma unroll
            for (int ks = 0; ks < 4; ++ks) S = __builtin_amdgcn_mfma_f32_32x32x16_bf16(kf[ks], qf[ks], S, 0, 0, 0);
            pg8::bf16x8 vc[2][2];
#pragma unroll
            for (int dvt = 0; dvt < 2; ++dvt)
#pragma unroll
                for (int s2 = 0; s2 < 2; ++s2) vc[dvt][s2] = vf[dvt][s2];
            if (kt < qb) SWA_LOAD(kt + 1);
            float mx = -INFINITY;
            if (kt < qb && (kt > qb - 4)) {
                const LAS float* tq = tb + (qpos - 32 * kt - 4 * hh);
#pragma unroll
                for (int r = 0; r < 16; ++r) { const float x = S[r] * c1 + tq[-((r & 3) + 8 * (r >> 2))]; S[r] = x; mx = fmaxf(mx, x); }
            } else {
#pragma unroll
                for (int r = 0; r < 16; ++r) { const int kq = 32 * kt + (r & 3) + 8 * (r >> 2) + 4 * hh, n = qpos - kq; const bool ok = (n >= 0) && (n <= 128);
                    const float x = ok ? S[r] * c1 + tb[ok ? n : 0] : -INFINITY; S[r] = x; mx = fmaxf(mx, x); }
            }
            mx = fmaxf(mx, __shfl_xor(mx, 32));
            const float m_new = (mx > m_run + 8.0f) ? mx : m_run;
            const bool moved = __builtin_amdgcn_ballot_w64(m_new != m_run) != 0ull;
            const float alpha = __builtin_amdgcn_exp2f(m_run - m_new);
            float rs = 0.f;
#pragma unroll
            for (int r = 0; r < 16; ++r) { const float pv = __builtin_amdgcn_exp2f(S[r] - m_new); S[r] = pv; rs += pv; }
            rs += __shfl_xor(rs, 32);
            l_run = l_run * alpha + rs; m_run = m_new;
            if (moved) {
#pragma unroll
                for (int i = 0; i < 2; ++i)
#pragma unroll
                    for (int r = 0; r < 16; ++r) o[i][r] *= alpha;
            }
#pragma unroll
            for (int s2 = 0; s2 < 2; ++s2) { const int r0 = 8 * s2;
                v4u w; w.x = pk2(S[r0], S[r0 + 1]); w.y = pk2(S[r0 + 2], S[r0 + 3]); w.z = pk2(S[r0 + 4], S[r0 + 5]); w.w = pk2(S[r0 + 6], S[r0 + 7]);
                const pg8::bf16x8 pf = __builtin_bit_cast(pg8::bf16x8, w);
#pragma unroll
                for (int dvt = 0; dvt < 2; ++dvt) o[dvt] = __builtin_amdgcn_mfma_f32_32x32x16_bf16(vc[dvt][s2], pf, o[dvt], 0, 0, 0); }
        }
#undef SWA_LOAD
        const float inv = 1.0f / l_run;
        bf16* orow = AO + (size_t)qtok * SWAW + head * 64;
#pragma unroll
        for (int i = 0; i < 2; ++i)
#pragma unroll
            for (int q4 = 0; q4 < 4; ++q4) { v2u w; w.x = pk2(o[i][4 * q4] * inv, o[i][4 * q4 + 1] * inv); w.y = pk2(o[i][4 * q4 + 2] * inv, o[i][4 * q4 + 3] * inv);
                *(v2u*)(orow + i * 32 + 8 * q4 + 4 * hh) = w; }
        if (hh == 0) LSE[(size_t)qtok * 12 + head] = (m_run + log2f(l_run)) * 0.6931471805599453f;
    }
    __syncthreads();
}

__device__ __forceinline__ void swa_combine_phase(const Args& A) {
    int tg = threadIdx.x; asm volatile("" : "+v"(tg)); const int gt = blockIdx.x * NTHR + tg, ngt = gridDim.x * NTHR;
    bf16* AO = (bf16*)(A.ws + WS_AO); const float* LSE = (const float*)(A.ws + WS_LSE);
    for (int task0 = gt; task0 < MP * 12 * 8; task0 += 4 * ngt) {
        v4u w[4]; float l0[4], l1[4], l2[4]; v4u* ptr[4]; int gq[4];
#pragma unroll
        for (int q = 0; q < 4; ++q) { const int task = task0 + q * ngt; ptr[q] = nullptr;
            if (task < MP * 12 * 8) { const int ch = task & 7, head = (task >> 3) % 12, tok = task / 96, j = head & 3; gq[q] = head >> 2;
                l0[q] = LSE[(size_t)tok * 12 + j]; l1[q] = LSE[(size_t)tok * 12 + 4 + j]; l2[q] = LSE[(size_t)tok * 12 + 8 + j];
                ptr[q] = (v4u*)(AO + (size_t)tok * SWAW + head * 64 + ch * 8); w[q] = *ptr[q]; } }
#pragma unroll
        for (int q = 0; q < 4; ++q) if (ptr[q]) {
            const float mm = fmaxf(fmaxf(l0[q], l1[q]), l2[q]), a0 = __expf(l0[q] - mm), a1 = __expf(l1[q] - mm), a2 = __expf(l2[q] - mm);
            const float al = (gq[q] == 0 ? a0 : (gq[q] == 1 ? a1 : a2)) * __builtin_amdgcn_rcpf(a0 + a1 + a2);
            v4u o; o.x = pk2(bflo(w[q].x) * al, bfhi(w[q].x) * al); o.y = pk2(bflo(w[q].y) * al, bfhi(w[q].y) * al); o.z = pk2(bflo(w[q].z) * al, bfhi(w[q].z) * al); o.w = pk2(bflo(w[q].w) * al, bfhi(w[q].w) * al);
            *ptr[q] = o; }
    }
}

__device__ __forceinline__ void swa_attn_phase(const Args& A, LAS unsigned char* lds) {
    const int tid = threadIdx.x, lane = tid & 63, wave = __builtin_amdgcn_readfirstlane(tid >> 6);
    const int gw = blockIdx.x * NWAVES + wave, ngw = gridDim.x * NWAVES;
    LAS float* pw = (LAS float*)lds + wave * 192;
    const bf16* QS = (const bf16*)(A.ws + WS_QS); const bf16* KS = (const bf16*)(A.ws + WS_KS); const bf16* VS = (const bf16*)(A.ws + WS_VS); bf16* AO = (bf16*)(A.ws + WS_AO);
    const float* relb = (const float*)A.in[I_RELB];
    swa_prompt_mfma(A, lds);
    constexpr int VPIT = 68;
    LAS float* vb = (LAS float*)(lds + 16384) + (wave < 3 ? wave : 0) * (129 * VPIT + 64);
    static_assert(16384 + 3 * (129 * VPIT + 64) * 4 <= RING_BYTES, "swa sample LDS map");
    const int G = gridDim.x;
    for (int task = (wave < 3) ? wave * G + (int)blockIdx.x : (1 << 30); task < MS * 4; task += 3 * G) {
        const int r = MP + (task >> 2), j = task & 3, b = (r - MP) >> 2, t = (r - MP) & 3;
        float og[3], lseg[3];
#pragma unroll
        for (int g = 0; g < 3; ++g) {
            const int head = g * 4 + j, dil = 1 << (2 * g), lb = 128 << (2 * g);
            const float* cache = (const float*)A.in[I_SWA0 + g];
            v4u qv[8];
#pragma unroll
            for (int i = 0; i < 8; ++i) qv[i] = ((const v4u*)(QS + (size_t)r * SWAW + head * 64))[i];
            float s[3];
#pragma unroll
            for (int kk = 0; kk < 3; ++kk) {
                const int n = lane + 64 * kk; float sc = -INFINITY;
                if (n <= 128) { const int idx = lb + t - n * dil; float d;
                    if (idx >= lb) d = dot64_bb(qv, KS + (size_t)(MP + b * 4 + idx - lb) * SWAW + head * 64);
                    else d = dot64_bf(qv, cache + ((size_t)((b * lb + idx) * 2 + 0) * 4 + j) * 64);
                    sc = d * 0.125f + relb[rel_bucket(n * dil) * 12 + head]; }
                s[kk] = sc;
            }
            const float mx = wave_max(fmaxf(fmaxf(s[0], s[1]), s[2]));
            float e[3];
#pragma unroll
            for (int kk = 0; kk < 3; ++kk) e[kk] = (s[kk] == -INFINITY) ? 0.f : __expf(s[kk] - mx);
            const float sum = wave_sum(e[0] + e[1] + e[2]), inv = 1.0f / sum;
            lseg[g] = mx + __logf(sum);
#pragma unroll
            for (int kk = 0; kk < 3; ++kk) {
                const int n = lane + 64 * kk;
                if (n <= 128) { const int idx = lb + t - n * dil; const float pn = e[kk] * inv; LAS f32x4* dst = (LAS f32x4*)(vb + n * VPIT);
                    if (idx >= lb) { const v4u* vp = (const v4u*)(VS + (size_t)(MP + b * 4 + idx - lb) * SWAW + head * 64);
#pragma unroll
                        for (int i = 0; i < 8; ++i) { const v4u w = vp[i]; dst[2 * i] = (f32x4){bflo(w.x) * pn, bfhi(w.x) * pn, bflo(w.y) * pn, bfhi(w.y) * pn}; dst[2 * i + 1] = (f32x4){bflo(w.z) * pn, bfhi(w.z) * pn, bflo(w.w) * pn, bfhi(w.w) * pn}; } }
                    else { const f32x4* vp = (const f32x4*)(cache + ((size_t)((b * lb + idx) * 2 + 1) * 4 + j) * 64);
#pragma unroll
                        for (int i = 0; i < 16; ++i) dst[i] = vp[i] * pn; } }
            }
            LDS_WAIT(); __builtin_amdgcn_wave_barrier();
            float o = 0.f;
#pragma unroll 43
            for (int n = 0; n <= 128; ++n) o += vb[n * VPIT + lane];
            og[g] = o;
            LDS_WAIT(); __builtin_amdgcn_wave_barrier();
        }
        const float mm = fmaxf(fmaxf(lseg[0], lseg[1]), lseg[2]);
        const float a0 = __expf(lseg[0] - mm), a1 = __expf(lseg[1] - mm), a2 = __expf(lseg[2] - mm), inv = 1.0f / (a0 + a1 + a2);
        AO[(size_t)r * SWAW + (0 * 4 + j) * 64 + lane] = (bf16)f2bf(og[0] * a0 * inv);
        AO[(size_t)r * SWAW + (1 * 4 + j) * 64 + lane] = (bf16)f2bf(og[1] * a1 * inv);
        AO[(size_t)r * SWAW + (2 * 4 + j) * 64 + lane] = (bf16)f2bf(og[2] * a2 * inv);
    }
}

__device__ __forceinline__ float diff_lambda(const float* lp, int lane, float lam_init) {
    const float s1 = wave_sum(lp[lane] * lp[64 + lane]), s2 = wave_sum(lp[128 + lane] * lp[192 + lane]);
    return __expf(s1) - __expf(s2) + lam_init;
}

__device__ __forceinline__ void diff_attn_prompt_phase(const Args& A, LAS unsigned char* lds, float lam_init) {
    const int tid = threadIdx.x, lane = tid & 63, wave = __builtin_amdgcn_readfirstlane(tid >> 6);
    const int gw = blockIdx.x * NWAVES + wave, ngw = gridDim.x * NWAVES;
    LAS float* pw = (LAS float*)lds + wave * 128;
    const bf16* QD = (const bf16*)(A.ws + WS_QD); const bf16* KD = (const bf16*)(A.ws + WS_KD); const bf16* VD = (const bf16*)(A.ws + WS_VD); bf16* AOD = (bf16*)(A.ws + WS_AOD);
    const float* relb = (const float*)A.in[I_RELB]; const float* onorm = (const float*)A.in[I_DON];
    const float lam = diff_lambda((const float*)A.in[I_DLAM], lane, lam_init);
    const float on0 = onorm[2 * lane], on1 = onorm[2 * lane + 1];
    for (int it = gw; it < NBP * 12 * SEQ; it += ngw) {
        const int hb = it % 96, i = it / 96; const int b = hb / 12, h = hb - b * 12, g = h / 3;
        const int row = b * SEQ + i;
        v4u q0[8], q1[8];
#pragma unroll
        for (int k = 0; k < 8; ++k) { q0[k] = ((const v4u*)(QD + (size_t)row * DQW + (h * 2 + 0) * 64))[k]; q1[k] = ((const v4u*)(QD + (size_t)row * DQW + (h * 2 + 1) * 64))[k]; }
        float m0 = -INFINITY, m1 = -INFINITY, l0 = 0.f, l1 = 0.f, o00 = 0.f, o01 = 0.f, o10 = 0.f, o11 = 0.f;
#pragma unroll 1
        for (int jb = 0; jb <= (i >> 6); ++jb) {
            const int jj = jb * 64 + lane; float s0 = -INFINITY, s1 = -INFINITY;
            if (jj <= i) { const bf16* krow = KD + (size_t)(b * SEQ + jj) * DKW + g * 128; const float bias = relb[rel_bucket(i - jj) * 12 + h];
                s0 = dot64_bb(q0, krow) * 0.125f + bias; s1 = dot64_bb(q1, krow + 64) * 0.125f + bias; }
            const float mn0 = fmaxf(m0, wave_max(s0)), mn1 = fmaxf(m1, wave_max(s1));
            const float c0 = __expf(m0 - mn0), c1 = __expf(m1 - mn1);
            const float p0 = (jj <= i) ? __expf(s0 - mn0) : 0.f, p1 = (jj <= i) ? __expf(s1 - mn1) : 0.f;
            l0 = l0 * c0 + wave_sum(p0); l1 = l1 * c1 + wave_sum(p1);
            o00 *= c0; o01 *= c0; o10 *= c1; o11 *= c1; m0 = mn0; m1 = mn1;
            pw[lane] = p0; pw[64 + lane] = p1;
            LDS_WAIT(); __builtin_amdgcn_wave_barrier();
            const int nv = (i - jb * 64 + 1) < 64 ? (i - jb * 64 + 1) : 64;
#pragma unroll 4
            for (int k = 0; k < nv; ++k) { const float pp0 = pw[k], pp1 = pw[64 + k];
                const unsigned vv = *(const unsigned*)(VD + (size_t)(b * SEQ + jb * 64 + k) * DKW + g * 128 + 2 * lane);
                const float v0 = bflo(vv), v1 = bfhi(vv);
                o00 += pp0 * v0; o01 += pp0 * v1; o10 += pp1 * v0; o11 += pp1 * v1; }
            LDS_WAIT(); __builtin_amdgcn_wave_barrier();
        }
        const float i0 = 1.0f / l0, i1 = 1.0f / l1;
        const float a0 = o00 * i0 - lam * o10 * i1, a1 = o01 * i0 - lam * o11 * i1;
        const float ssq = wave_sum(a0 * a0 + a1 * a1), rr = rsqrtf(ssq * (1.0f / 128.0f) + EPS) * (1.0f - lam_init);
        *(unsigned*)(AOD + (size_t)row * DQW + h * 128 + 2 * lane) = pk2(a0 * rr * on0, a1 * rr * on1);
    }
}

__device__ __forceinline__ void diff_attn_prompt_mfma(const Args& A, LAS unsigned char* lds, float lam_init, int cidx, int ncu) {
    const int tid = threadIdx.x, lane = tid & 63, wave = __builtin_amdgcn_readfirstlane(tid >> 6);
    const int l31 = lane & 31, hh = lane >> 5, rg = wave >> 1, m = wave & 1;
    constexpr int KPITCH = 272, VPITCH = 144, KT_BYTES = 64 * KPITCH, VT_BYTES = 128 * VPITCH, BUF_BYTES = KT_BYTES + VT_BYTES;
    constexpr int VB_OFF = 2 * KT_BYTES;
    constexpr int L1_OFF = 2 * KT_BYTES + 3 * VT_BYTES;
    constexpr int CP_OFF = L1_OFF + 1024, CP_STRIDE = 2208;
    static_assert(CP_OFF + 4 * CP_STRIDE * 4 <= RING_BYTES, "diff attention LDS map");
    LAS float* cpy = (LAS float*)(lds + CP_OFF);
    LAS float* ex = (LAS float*)lds;
    LAS float* exl = (LAS float*)(lds + L1_OFF);
    const bf16* QD = (const bf16*)(A.ws + WS_QD); const bf16* KD = (const bf16*)(A.ws + WS_KD); const bf16* VTD = (const bf16*)(A.ws + WS_VTD); bf16* AOD = (bf16*)(A.ws + WS_AOD);
    const float* relb = (const float*)A.in[I_RELB]; const float* onorm = (const float*)A.in[I_DON];
    const float lam = diff_lambda((const float*)A.in[I_DLAM], lane, lam_init);
    const float LOG2E = 1.4426950408889634f, c1 = 0.125f * LOG2E;
    const int c = cidx, Gd = ncu;
    for (int ui = 0; ; ++ui) {
        const int rnd = ui, base = rnd * Gd; const int k = (rnd & 1) ? base + (Gd - 1 - c) : base + c;
        if (base >= 1536) break;
        __syncthreads();
        if (k < 1536) {
        const int qblk = 15 - k / 96, bh = k % 96, b = bh / 12, h = bh - b * 12, g = h / 3;
        for (int i = tid; i < 2176; i += NTHR) { const int d = 2048 - i; cpy[i] = (d >= 0 && d < 2048) ? relb[rel_bucket(d) * 12 + h] * 8.0f : 0.f; }
        __syncthreads();
        for (int n = tid; n < 3 * 2176; n += NTHR) { const int sc = 1 + n / 2176, i = n - (sc - 1) * 2176; cpy[sc * CP_STRIDE + i] = (i >= sc) ? cpy[i - sc] : 0.f; }
        const int q_abs = qblk * 128 + rg * 32 + l31, row = b * SEQ + q_abs;
        pg8::bf16x8 qf[4];
#pragma unroll
        for (int ks = 0; ks < 4; ++ks) qf[ks] = *(const pg8::bf16x8*)(QD + (size_t)row * DQW + (h * 2 + m) * 64 + 16 * ks + 8 * hh);
        f32x16 o[4];
#pragma unroll
        for (int i = 0; i < 4; ++i)
#pragma unroll
            for (int r = 0; r < 16; ++r) o[i][r] = 0.f;
        float m_run = -INFINITY, l_run = 0.f;
        const float THRU = 8.0f / c1;
        const LAS float* cb = cpy + (l31 & 3) * CP_STRIDE + ((l31 & 3) + 2048 - q_abs + 4 * hh);
        const int ntiles = 2 * qblk + 2, my_last = 2 * qblk + (rg >> 1);
        const int kkey = tid >> 4, kc = tid & 15, vdv = tid >> 3, vc = tid & 7;
        const char* ksrc = (const char*)(KD + (size_t)(b * SEQ) * DKW + g * 128);
        const char* vsrc = (const char*)(VTD + (size_t)((b * 4 + g) * 128) * SEQ);
        const unsigned koff = (unsigned)((kkey * DKW + kc * 8) * 2), voff = (unsigned)((vdv * SEQ + vc * 8) * 2);
        const int kdst = kkey * KPITCH + kc * 16, vdst = VB_OFF + vdv * VPITCH + vc * 16;
        v4u sa0, sa1, sa2, sa3;
#define DA_LOAD(R0, R1, R2, R3, t) do { const char* ks2 = ksrc + (size_t)(t) * 64 * DKW * 2; const char* vs2 = vsrc + (t) * 128; \
            R0 = *(const v4u*)(ks2 + koff); R1 = *(const v4u*)(ks2 + (size_t)32 * DKW * 2 + koff); R2 = *(const v4u*)(vs2 + voff); R3 = *(const v4u*)(vs2 + (size_t)64 * SEQ * 2 + voff); } while (0)
#define DA_STORE(R0, R1, R2, R3, t, vo) do { LAS unsigned char* nk = lds + ((t) & 1) * KT_BYTES + kdst; LAS unsigned char* nv = lds + (vo) + vdst; \
            *(LAS v4u*)(nk) = R0; *(LAS v4u*)(nk + 32 * KPITCH) = R1; *(LAS v4u*)(nv) = R2; *(LAS v4u*)(nv + 64 * VPITCH) = R3; } while (0)
#define DA_PV(vo) do { LAS unsigned char* Vb = lds + VB_OFF + (vo); \
_Pragma("unroll") \
            for (int kk = 0; kk < 4; ++kk) \
_Pragma("unroll") \
                for (int dvt = 0; dvt < 4; ++dvt) { const pg8::bf16x8 a = *(const LAS pg8::bf16x8*)(Vb + (dvt * 32 + l31) * VPITCH + kk * 32 + hh * 16); \
                    o[dvt] = __builtin_amdgcn_mfma_f32_32x32x16_bf16(a, pfp[kk], o[dvt], 0, 0, 0); } \
        } while (0)
#define DA_COMPUTE(kt) do { \
                LAS unsigned char* Kb = lds + (kt & 1) * KT_BYTES; \
                const bool offdiag = kt * 64 + 63 <= qblk * 128 + rg * 32; \
                f32x16 S[2]; \
                if (offdiag) { \
                    const LAS float* cq = cb + kt * 64; \
_Pragma("unroll") \
                    for (int sub = 0; sub < 2; ++sub) \
_Pragma("unroll") \
                        for (int j = 0; j < 4; ++j) { const f32x4 t4 = *(const LAS f32x4*)(cq + sub * 32 + 8 * j); \
                            S[sub][4 * j] = t4[0]; S[sub][4 * j + 1] = t4[1]; S[sub][4 * j + 2] = t4[2]; S[sub][4 * j + 3] = t4[3]; } \
                } else { \
_Pragma("unroll") \
                    for (int sub = 0; sub < 2; ++sub) \
_Pragma("unroll") \
                        for (int r = 0; r < 16; ++r) S[sub][r] = 0.f; \
                } \
_Pragma("unroll") \
                for (int ks = 0; ks < 4; ++ks) \
_Pragma("unroll") \
                    for (int sub = 0; sub < 2; ++sub) { const pg8::bf16x8 a = *(const LAS pg8::bf16x8*)(Kb + (sub * 32 + l31) * KPITCH + m * 128 + ks * 32 + hh * 16); \
                        S[sub] = __builtin_amdgcn_mfma_f32_32x32x16_bf16(a, qf[ks], S[sub], 0, 0, 0); } \
                if (!offdiag) { \
_Pragma("unroll") \
                    for (int sub = 0; sub < 2; ++sub) \
_Pragma("unroll") \
                        for (int r = 0; r < 16; ++r) { const int key = kt * 64 + sub * 32 + (r & 3) + 8 * (r >> 2) + 4 * hh; const int d = q_abs - key; \
                            const float x = S[sub][r] + cpy[2048 - (d < 0 ? 0 : d)]; S[sub][r] = d < 0 ? -INFINITY : x; } \
                } \
                  \
                float mx0 = -INFINITY, mx1 = -INFINITY; \
_Pragma("unroll") \
                for (int r = 0; r < 16; ++r) { mx0 = fmaxf(mx0, S[0][r]); mx1 = fmaxf(mx1, S[1][r]); } \
                float mx = fmaxf(mx0, mx1); \
                mx = fmaxf(mx, __shfl_xor(mx, 32)); \
                const float m_new = (mx > m_run + THRU) ? mx : m_run; \
                const bool moved = __builtin_amdgcn_ballot_w64(m_new != m_run) != 0ull; \
                const float alpha = __builtin_amdgcn_exp2f((m_run - m_new) * c1); \
                const float nmc = -m_new * c1; \
                DA_PV(vo_prev); \
                float rs0 = 0.f, rs1 = 0.f; \
_Pragma("unroll") \
                for (int r = 0; r < 16; ++r) { const float p0 = __builtin_amdgcn_exp2f(__builtin_fmaf(S[0][r], c1, nmc)); S[0][r] = p0; rs0 += p0; \
                    const float p1 = __builtin_amdgcn_exp2f(__builtin_fmaf(S[1][r], c1, nmc)); S[1][r] = p1; rs1 += p1; } \
                float rs = rs0 + rs1; \
                rs += __shfl_xor(rs, 32); \
                l_run = l_run * alpha + rs; m_run = m_new; \
_Pragma("unroll") \
                for (int kk = 0; kk < 4; ++kk) { const int sub = kk >> 1, r0 = (kk & 1) * 8; \
                    v4u w; w.x = pk2(S[sub][r0], S[sub][r0 + 1]); w.y = pk2(S[sub][r0 + 2], S[sub][r0 + 3]); w.z = pk2(S[sub][r0 + 4], S[sub][r0 + 5]); w.w = pk2(S[sub][r0 + 6], S[sub][r0 + 7]); \
                    pfp[kk] = __builtin_bit_cast(pg8::bf16x8, w); } \
                if (moved) { \
_Pragma("unroll") \
                    for (int i = 0; i < 4; ++i) \
_Pragma("unroll") \
                        for (int r = 0; r < 16; ++r) o[i][r] *= alpha; \
                } \
        } while (0)
        pg8::bf16x8 pfp[4];
#pragma unroll
        for (int kk = 0; kk < 4; ++kk) pfp[kk] = __builtin_bit_cast(pg8::bf16x8, v4u{0u, 0u, 0u, 0u});
        int vo_prev = 0, vo_cur = 0, vo_next = VT_BYTES, vo_free = 2 * VT_BYTES;
        DA_LOAD(sa0, sa1, sa2, sa3, 0); DA_STORE(sa0, sa1, sa2, sa3, 0, 0);
        __syncthreads();
#pragma unroll 1
        for (int kt = 0; kt < ntiles; ++kt) {
            if (kt + 1 < ntiles) DA_LOAD(sa0, sa1, sa2, sa3, kt + 1);
            DA_COMPUTE(kt);
            if (kt + 1 < ntiles) DA_STORE(sa0, sa1, sa2, sa3, kt + 1, vo_next);
            { const int t = (kt == 0) ? vo_free : vo_prev; vo_prev = vo_cur; vo_cur = vo_next; vo_next = t; }
            __syncthreads();
        }
        DA_PV(vo_prev);
        __syncthreads();
#undef DA_PV
#undef DA_COMPUTE
#undef DA_LOAD
#undef DA_STORE
        const float inv_l = 1.0f / l_run;
        if (m == 1) {
#pragma unroll
            for (int i = 0; i < 4; ++i)
#pragma unroll
                for (int r = 0; r < 16; ++r) ex[(rg * 64 + i * 16 + r) * 64 + lane] = o[i][r] * inv_l;
        }
        __syncthreads();
        if (m == 0) {
            float ssq = 0.f; float lam2 = lam; asm volatile("" : "+v"(lam2));
#pragma unroll
            for (int i = 0; i < 4; ++i)
#pragma unroll
                for (int r = 0; r < 16; ++r) { const float a = o[i][r] * inv_l - lam2 * ex[(rg * 64 + i * 16 + r) * 64 + lane]; o[i][r] = a; ssq += a * a; }
            ssq += __shfl_xor(ssq, 32);
            const float rr = rsqrtf(ssq * (1.0f / 128.0f) + EPS) * (1.0f - lam_init);
            int hh4 = 4 * hh; asm volatile("" : "+v"(hh4)); const float* onb = onorm + hh4; bf16* orow = AOD + (size_t)row * DQW + h * 128 + hh4;
#pragma unroll
            for (int i = 0; i < 4; ++i)
#pragma unroll
                for (int q4 = 0; q4 < 4; ++q4) { const int dv0 = i * 32 + 8 * q4; const f32x4 on = *(const f32x4*)(onb + dv0);
                    v2u w; w.x = pk2(o[i][4 * q4] * rr * on[0], o[i][4 * q4 + 1] * rr * on[1]); w.y = pk2(o[i][4 * q4 + 2] * rr * on[2], o[i][4 * q4 + 3] * rr * on[3]);
                    *(v2u*)(orow + dv0) = w; }
        }
        }
    }
    __syncthreads();
    (void)exl;
}

__device__ __forceinline__ void diff_sample_partial_phase(const Args& A, LAS unsigned char* lds) {
    const int tid = threadIdx.x, lane = tid & 63, wave = __builtin_amdgcn_readfirstlane(tid >> 6);
    LAS float* qs = (LAS float*)lds;
    LAS float* sc = qs + 24 * 64;
    LAS float* ml = sc + 1024 * 24;
    LAS int* pg = (LAS int*)(ml + 32);
    const bf16* QD = (const bf16*)(A.ws + WS_QD); float* PART = (float*)(A.ws + WS_PART);
    const float* ck = (const float*)A.in[I_DCK]; const float* cv = (const float*)A.in[I_DCV]; const int* pt = (const int*)A.in[I_PT];
    const float* relb = (const float*)A.in[I_RELB];
    for (int u = blockIdx.x; u < 1024; u += gridDim.x) {
        const int b = u >> 5, g = (u >> 3) & 3, c = u & 7;
        __syncthreads();
        for (int e = tid; e < 24 * 64; e += NTHR) { const int qi = e >> 6, d = e & 63, m = qi / 12, tr = qi - m * 12, t = tr / 3, r = tr - t * 3;
            qs[e] = bf2f(QD[(size_t)(MP + b * 4 + t) * DQW + ((g * 3 + r) * 2 + m) * 64 + d]); }
        if (tid < 8) pg[tid] = pt[b * 64 + c * 8 + tid];
        __syncthreads();
        {
            const int phys = pg[wave];
#pragma unroll 1
            for (int ks = 0; ks < 2; ++ks) {
                const int slot = lane + 64 * ks;
                const float* kb = ck + ((size_t)(phys * 128 + slot) * 4 + g) * 128;
                float acc[24];
#pragma unroll
                for (int q = 0; q < 24; ++q) acc[q] = 0.f;
#pragma unroll 1
                for (int dc = 0; dc < 16; ++dc) {
                    const f32x4 k0 = *(const f32x4*)(kb + 4 * dc), k1 = *(const f32x4*)(kb + 64 + 4 * dc);
#pragma unroll
                    for (int q = 0; q < 12; ++q) { const f32x4 qa = *(const LAS f32x4*)(qs + q * 64 + 4 * dc), qb = *(const LAS f32x4*)(qs + (12 + q) * 64 + 4 * dc);
                        acc[q] += (qa[0] * k0[0] + qa[1] * k0[1]) + (qa[2] * k0[2] + qa[3] * k0[3]);
                        acc[12 + q] += (qb[0] * k1[0] + qb[1] * k1[1]) + (qb[2] * k1[2] + qb[3] * k1[3]); }
                }
                const int kpos = (c * 8 + wave) * 128 + slot, kl = wave * 128 + slot;
#pragma unroll
                for (int t = 0; t < 4; ++t) { const int bk = rel_bucket(PAST + t - kpos);
#pragma unroll
                    for (int r = 0; r < 3; ++r) { const float bias = relb[bk * 12 + g * 3 + r];
                        sc[kl * 24 + t * 3 + r] = acc[t * 3 + r] * 0.125f + bias; sc[kl * 24 + 12 + t * 3 + r] = acc[12 + t * 3 + r] * 0.125f + bias; } }
            }
        }
        __syncthreads();
        for (int qi = wave; qi < 24; qi += NWAVES) {
            float mx = -INFINITY;
            for (int k = lane; k < 1024; k += 64) mx = fmaxf(mx, sc[k * 24 + qi]);
            mx = wave_max(mx);
            float sm = 0.f;
            for (int k = lane; k < 1024; k += 64) { const float p = __expf(sc[k * 24 + qi] - mx); sc[k * 24 + qi] = p; sm += p; }
            sm = wave_sum(sm);
            if (lane == 0) { PART[((size_t)u * 24 + qi) * PART_STRIDE + 128] = mx; PART[((size_t)u * 24 + qi) * PART_STRIDE + 129] = sm; }
        }
        __syncthreads();
        {
            const int dv = tid & 127, qg = tid >> 7;
            float o[6] = {0.f, 0.f, 0.f, 0.f, 0.f, 0.f};
            for (int kl = 0; kl < 1024; ++kl) {
                const int phys = pg[kl >> 7], slot = kl & 127;
                const float v = cv[((size_t)(phys * 128 + slot) * 4 + g) * 128 + dv];
                const LAS f32x2* pp = (const LAS f32x2*)(sc + kl * 24 + qg * 6);
                const f32x2 pa = pp[0], pb = pp[1], pc = pp[2];
                o[0] += pa[0] * v; o[1] += pa[1] * v; o[2] += pb[0] * v; o[3] += pb[1] * v; o[4] += pc[0] * v; o[5] += pc[1] * v;
            }
#pragma unroll
            for (int q = 0; q < 6; ++q) PART[((size_t)u * 24 + qg * 6 + q) * PART_STRIDE + dv] = o[q];
        }
    }
}


__device__ __forceinline__ void diff_sample_partial_mfma(const Args& A, LAS unsigned char* lds, int cidx, int ncu) {
    int tid = threadIdx.x; asm volatile("" : "+v"(tid));
    const int lane = tid & 63, wave = __builtin_amdgcn_readfirstlane(tid >> 6);
    const int r = lane & 15, c4 = lane >> 4;
    LAS float* ow = (LAS float*)lds;
    static_assert(8 * 24 * 132 * 4 <= RING_BYTES, "diff sample LDS map");
    const bf16* QD = (const bf16*)(A.ws + WS_QD); float* PART = (float*)(A.ws + WS_PART);
    const float* ck = (const float*)A.in[I_DCK]; const float* cv = (const float*)A.in[I_DCV]; const int* pt = (const int*)A.in[I_PT];
    const float* relb = (const float*)A.in[I_RELB];
    const int tq = r / 3, rep = r - tq * 3;
    for (int u = cidx; u < 1024; u += ncu) {
        const int b = u >> 5, g = (u >> 3) & 3, cc = u & 7, head = g * 3 + rep;
        __syncthreads();
        pg8::bf16x8 qf[2][2];
#pragma unroll
        for (int m = 0; m < 2; ++m)
#pragma unroll
            for (int ks = 0; ks < 2; ++ks) { v4u w = (v4u){0u, 0u, 0u, 0u};
                if (r < 12) w = *(const v4u*)(QD + (size_t)(MP + b * 4 + tq) * DQW + (head * 2 + m) * 64 + 16 * c4 + 8 * ks);
                qf[m][ks] = __builtin_bit_cast(pg8::bf16x8, w); }
        const int phys = pt[b * 64 + cc * 8 + wave], page_start = (cc * 8 + wave) * 128;
        const float* kp = ck + (size_t)phys * 128 * 512 + g * 128 + (size_t)r * 512 + 16 * c4;
        const float* vp = cv + (size_t)phys * 128 * 512 + g * 128 + (size_t)(4 * c4) * 512 + 8 * r;
        const bool far = (PAST - (page_start + 127)) >= 2048;
        const float bfar = (r < 12) ? relb[31 * 12 + head] : 0.f;
        f32x4 oacc[2][8];
#pragma unroll
        for (int m = 0; m < 2; ++m)
#pragma unroll
            for (int d = 0; d < 8; ++d) oacc[m][d] = (f32x4){0.f, 0.f, 0.f, 0.f};
        float m_run0 = -INFINITY, m_run1 = -INFINITY, l_run0 = 0.f, l_run1 = 0.f;
#pragma unroll 1
        for (int sb = 0; sb < 4; ++sb) {
            f32x4 S[2][2];
#pragma unroll
            for (int tt = 0; tt < 2; ++tt) { const float* kr = kp + (size_t)(sb * 32 + tt * 16) * 512;
#pragma unroll
                for (int m = 0; m < 2; ++m) { S[m][tt] = (f32x4){0.f, 0.f, 0.f, 0.f};
#pragma unroll
                    for (int ks = 0; ks < 2; ++ks) { const f32x4 a = *(const f32x4*)(kr + m * 64 + 8 * ks), a2 = *(const f32x4*)(kr + m * 64 + 8 * ks + 4);
                        v4u w; w.x = pk2(a[0], a[1]); w.y = pk2(a[2], a[3]); w.z = pk2(a2[0], a2[1]); w.w = pk2(a2[2], a2[3]);
                        S[m][tt] = __builtin_amdgcn_mfma_f32_16x16x32_bf16(__builtin_bit_cast(pg8::bf16x8, w), qf[m][ks], S[m][tt], 0, 0, 0); } } }
            float bias[2][4];
#pragma unroll
            for (int tt = 0; tt < 2; ++tt)
#pragma unroll
                for (int q = 0; q < 4; ++q) { float bv = bfar;
                    if (!far) { const int kpos = page_start + sb * 32 + tt * 16 + 4 * c4 + q; bv = (r < 12) ? relb[rel_bucket(PAST + tq - kpos) * 12 + head] : 0.f; }
                    bias[tt][q] = bv; }
            pg8::bf16x8 pf[2];
#pragma unroll
            for (int m = 0; m < 2; ++m) {
                float mx = -INFINITY;
#pragma unroll
                for (int tt = 0; tt < 2; ++tt)
#pragma unroll
                    for (int q = 0; q < 4; ++q) { const float x = S[m][tt][q] * 0.125f + bias[tt][q]; S[m][tt][q] = x; mx = fmaxf(mx, x); }
                mx = fmaxf(mx, __shfl_xor(mx, 16)); mx = fmaxf(mx, __shfl_xor(mx, 32));
                const float m_old = m ? m_run1 : m_run0, m_new = fmaxf(m_old, mx), alpha = __expf(m_old - m_new);
                float rs = 0.f;
#pragma unroll
                for (int tt = 0; tt < 2; ++tt)
#pragma unroll
                    for (int q = 0; q < 4; ++q) { const float pv = __expf(S[m][tt][q] - m_new); S[m][tt][q] = pv; rs += pv; }
                rs += __shfl_xor(rs, 16); rs += __shfl_xor(rs, 32);
                if (m) { l_run1 = l_run1 * alpha + rs; m_run1 = m_new; } else { l_run0 = l_run0 * alpha + rs; m_run0 = m_new; }
#pragma unroll
                for (int d = 0; d < 8; ++d) oacc[m][d] = oacc[m][d] * alpha;
                v4u w; w.x = pk2(S[m][0][0], S[m][0][1]); w.y = pk2(S[m][0][2], S[m][0][3]); w.z = pk2(S[m][1][0], S[m][1][1]); w.w = pk2(S[m][1][2], S[m][1][3]);
                pf[m] = __builtin_bit_cast(pg8::bf16x8, w);
            }
            const float* vr = vp + (size_t)(sb * 32) * 512;
#pragma unroll
            for (int hf = 0; hf < 2; ++hf) {
                __builtin_amdgcn_sched_barrier(0);
                f32x4 vv[8];
#pragma unroll
                for (int jj = 0; jj < 8; ++jj) vv[jj] = *(const f32x4*)(vr + (size_t)(16 * (jj >> 2) + (jj & 3)) * 512 + 4 * hf);
#pragma unroll
                for (int d = 0; d < 4; ++d) { v4u w; w.x = pk2(vv[0][d], vv[1][d]); w.y = pk2(vv[2][d], vv[3][d]); w.z = pk2(vv[4][d], vv[5][d]); w.w = pk2(vv[6][d], vv[7][d]);
                    const pg8::bf16x8 vf = __builtin_bit_cast(pg8::bf16x8, w);
                    oacc[0][4 * hf + d] = __builtin_amdgcn_mfma_f32_16x16x32_bf16(vf, pf[0], oacc[0][4 * hf + d], 0, 0, 0);
                    oacc[1][4 * hf + d] = __builtin_amdgcn_mfma_f32_16x16x32_bf16(vf, pf[1], oacc[1][4 * hf + d], 0, 0, 0); }
                __builtin_amdgcn_sched_barrier(0);
            }
        }
        if (r < 12) {
#pragma unroll
            for (int m = 0; m < 2; ++m) { LAS float* dst = ow + (wave * 24 + m * 12 + r) * 132;
#pragma unroll
                for (int q = 0; q < 4; ++q) { *(LAS f32x4*)(dst + 32 * c4 + 8 * q) = (f32x4){oacc[m][0][q], oacc[m][1][q], oacc[m][2][q], oacc[m][3][q]};
                    *(LAS f32x4*)(dst + 32 * c4 + 8 * q + 4) = (f32x4){oacc[m][4][q], oacc[m][5][q], oacc[m][6][q], oacc[m][7][q]}; }
                if (c4 == 0) { dst[128] = m ? m_run1 : m_run0; dst[129] = m ? l_run1 : l_run0; } }
        }
        __syncthreads();
        for (int idx = tid; idx < 24 * 128; idx += NTHR) { const int qi = idx >> 7, dv = idx & 127;
            float M = -INFINITY;
#pragma unroll
            for (int w = 0; w < 8; ++w) M = fmaxf(M, ow[(w * 24 + qi) * 132 + 128]);
            float o = 0.f, L = 0.f;
#pragma unroll
            for (int w = 0; w < 8; ++w) { const float e = __expf(ow[(w * 24 + qi) * 132 + 128] - M); o += ow[(w * 24 + qi) * 132 + dv] * e; L += ow[(w * 24 + qi) * 132 + 129] * e; }
            PART[((size_t)u * 24 + qi) * PART_STRIDE + dv] = o;
            if (dv == 0) { PART[((size_t)u * 24 + qi) * PART_STRIDE + 128] = M; PART[((size_t)u * 24 + qi) * PART_STRIDE + 129] = L; }
        }
    }
    __syncthreads();
}

__device__ __forceinline__ void diff_sample_combine_phase(const Args& A, float lam_init) {
    const int tid = threadIdx.x, lane = tid & 63, wave = __builtin_amdgcn_readfirstlane(tid >> 6);
    const int gw = blockIdx.x * NWAVES + wave, ngw = gridDim.x * NWAVES;
    const bf16* QD = (const bf16*)(A.ws + WS_QD); const bf16* KD = (const bf16*)(A.ws + WS_KD); const bf16* VD = (const bf16*)(A.ws + WS_VD); bf16* AOD = (bf16*)(A.ws + WS_AOD);
    const float* PART = (const float*)(A.ws + WS_PART);
    const float* relb = (const float*)A.in[I_RELB]; const float* onorm = (const float*)A.in[I_DON];
    const float lam = diff_lambda((const float*)A.in[I_DLAM], lane, lam_init);
    const float on0 = onorm[2 * lane], on1 = onorm[2 * lane + 1];
    for (int it = gw; it < NBS * 4 * 12; it += ngw) {
        const int b = it / 48, rem = it - b * 48, g = rem / 12, tr = rem - g * 12, t = tr / 3, r = tr - t * 3, h = g * 3 + r;
        const int row = MP + b * 4 + t;
        float res[2][2];
#pragma unroll
        for (int m = 0; m < 2; ++m) {
            const int qi = m * 12 + tr;
            const float qd = bf2f(QD[(size_t)row * DQW + (h * 2 + m) * 64 + lane]);
            float sn[4];
#pragma unroll
            for (int t2 = 0; t2 < 4; ++t2) { const float kd = bf2f(KD[(size_t)(MP + b * 4 + t2) * DKW + (g * 2 + m) * 64 + lane]);
                const float d = wave_sum(qd * kd); sn[t2] = (t2 <= t) ? d * 0.125f + relb[rel_bucket(t - t2) * 12 + h] : -INFINITY; }
            float M = fmaxf(fmaxf(sn[0], sn[1]), fmaxf(sn[2], sn[3]));
            float mc[8];
#pragma unroll
            for (int c = 0; c < 8; ++c) { mc[c] = PART[((size_t)((b * 4 + g) * 8 + c) * 24 + qi) * PART_STRIDE + 128]; M = fmaxf(M, mc[c]); }
            float Lsum = 0.f, o0 = 0.f, o1 = 0.f;
#pragma unroll
            for (int c = 0; c < 8; ++c) { const float* pp = PART + ((size_t)((b * 4 + g) * 8 + c) * 24 + qi) * PART_STRIDE; const float w = __expf(mc[c] - M);
                Lsum += pp[129] * w; const f32x2 ov = *(const f32x2*)(pp + 2 * lane); o0 += ov[0] * w; o1 += ov[1] * w; }
#pragma unroll
            for (int t2 = 0; t2 < 4; ++t2) { if (t2 <= t) { const float w = __expf(sn[t2] - M); Lsum += w;
                const unsigned vv = *(const unsigned*)(VD + (size_t)(MP + b * 4 + t2) * DKW + g * 128 + 2 * lane); o0 += w * bflo(vv); o1 += w * bfhi(vv); } }
            const float inv = 1.0f / Lsum; res[m][0] = o0 * inv; res[m][1] = o1 * inv;
        }
        const float a0 = res[0][0] - lam * res[1][0], a1 = res[0][1] - lam * res[1][1];
        const float ssq = wave_sum(a0 * a0 + a1 * a1), rr = rsqrtf(ssq * (1.0f / 128.0f) + EPS) * (1.0f - lam_init);
        *(unsigned*)(AOD + (size_t)row * DQW + h * 128 + 2 * lane) = pk2(a0 * rr * on0, a1 * rr * on1);
    }
}

constexpr int N_PHASES = 27;
__global__ void __launch_bounds__(NTHR, 2) hybrid_fwd(Args args) {
    extern __shared__ __attribute__((aligned(16))) unsigned char lds_raw[];
    LAS unsigned char* lds = (LAS unsigned char*)lds_raw;
    const int tid = threadIdx.x;
    volatile LAS unsigned* MISC = (volatile LAS unsigned*)(lds + MISC_OFF);
    for (int u = tid; u < (LDS_BYTES - LDSCTL_OFF) / 4; u += NTHR) ((LAS unsigned*)(lds + LDSCTL_OFF))[u] = 0u;
    __syncthreads();
    unsigned char* ws = args.ws;
    XcdBarrier bar; bar.bar = (unsigned*)(ws + WS_CTL) + CW_BAR; bar.x = 0; bar.st = nullptr;
#if !MK_PER_PHASE
    bar = xcd_barrier_post((unsigned*)(ws + WS_CTL) + CW_BAR, MISC + 8);
#endif
    const int lo = args.ph_lo, hi = args.ph_hi, G = gridDim.x, bx = blockIdx.x;
#define IN(k) (lo <= (k) && (k) < hi)
#if MK_PER_PHASE
#define SEAM(k) do { } while (0)
#else
#define SEAM(k) do { if (IN((k) + 1)) xcd_barrier(bar); } while (0)
#endif
    float* SS = (float*)(ws + WS_SS);
    bf16* XB = (bf16*)(ws + WS_XB);
    const float lam_init2 = 0.47071301f;

#define GEMM_PHASE(EPI, E, Aptr, Bptr, Ncols, Kdim) do { pg8::Gemm g_{(const pg8::bf16_t*)(Aptr), (const pg8::bf16_t*)(Bptr), MP, (Ncols), (Kdim)}; pg8::StaticOrder S_; S_.init(MP, (Ncols), G, bx); \
        pg8::gemm_phase<EPI, pg8::StaticOrder, true, true>(lds, g_, S_, E); } while (0)

    int ph = 0;
    if (IN(0)) { for (int rep = 0; rep < REP_PRO; ++rep) { prologue_phase(args, lds); __syncthreads(); } SEAM(0); for (int rep = 0; rep < PROBE_BAR; ++rep) xcd_barrier(bar); }

#define SSD_LAYER(P, LI, SSIN, SSMID, FFL, SSOUT, FIN) \
    if (IN((P) + 0)) { EpiSsdIn E{(bf16*)(ws + WS_ZX), (float*)(ws + WS_DT), SS + (SSIN) * (MPAD * 16), (const float*)args.in[I_DTB] + (LI) * 32}; \
        if (PROBE_SSDIN) GEMM_PHASE(EpiSsdIn, E, XB, ws + WS_WSSDIN + (LI) * al4k(SZ_WSSDIN), ZXW, DM); GEMM_PHASE(EpiSsdIn, E, XB, ws + WS_WSSDIN + (LI) * al4k(SZ_WSSDIN), ZXW, DM); \
        sk_ssdin(args, (const bf16*)(ws + WS_WSSDIN + (LI) * al4k(SZ_WSSDIN)), SS + (SSIN) * (MPAD * 16), (const float*)args.in[I_DTB] + (LI) * 32, (64 * 20) % G); SEAM((P) + 0); } \
    if (IN((P) + 1)) { for (int rep = 0; rep < REP_PRE; ++rep) ssd_prepass_phase(args, lds, (LI)); SEAM((P) + 1); } \
    if (IN((P) + 2)) { for (int rep = 0; rep < REP_SCAN; ++rep) { ssd_scan_phase(args, lds, (LI)); __syncthreads(); } SEAM((P) + 2); } \
    if (IN((P) + 3)) { ssd_gatenorm_phase(args, (LI), (bf16*)(ws + WS_YG)); if (PROBE_GN) ssd_gatenorm_phase(args, (LI), (bf16*)(ws + WS_ACT)); SEAM((P) + 3); } \
    if (IN((P) + 4)) { EpiRes E{XB, SS + (SSMID) * (MPAD * 16), nullptr, XB}; GEMM_PHASE(EpiRes, E, ws + WS_YG, ws + WS_WSSDOUT + (LI) * al4k(SZ_WSSDOUT), DM, DIN); \
        sk_res(args, (const bf16*)(ws + WS_YG), DIN, (const bf16*)(ws + WS_WSSDOUT + (LI) * al4k(SZ_WSSDOUT)), SS + (SSMID) * (MPAD * 16), nullptr, 0); SEAM((P) + 4); } \
    FFN_LAYER((P) + 5, FFL, SSMID, SSOUT, FIN)
#define FFN_LAYER(P, FFL, SSMID, SSOUT, FIN) \
    if (IN((P) + 0)) { EpiSwiGlu E{(bf16*)(ws + WS_ACT), SS + (SSMID) * (MPAD * 16)}; if (PROBE_FFIN == 1) { GEMM_PHASE(EpiSwiGlu, E, XB, ws + WS_WFFIN + (FFL) * al4k(SZ_WFFIN), 2 * DFF, DM); } if (PROBE_FFIN == 2) { EpiNone EN; GEMM_PHASE(EpiNone, EN, XB, ws + WS_WFFIN + (FFL) * al4k(SZ_WFFIN), 2 * DFF, DM); } GEMM_PHASE(EpiSwiGlu, E, XB, ws + WS_WFFIN + (FFL) * al4k(SZ_WFFIN), 2 * DFF, DM); \
        for (int rep = 0; rep < REP_SKSW; ++rep) sk_swiglu(args, (const bf16*)(ws + WS_WFFIN + (FFL) * al4k(SZ_WFFIN)), SS + (SSMID) * (MPAD * 16), (64 * 22) % G); for (int rep = 0; rep < REP_COPY; ++rep) cache_copy_slice(args, (FFL), 6, (64 * 22) % G); SEAM((P) + 0); } \
    if (IN((P) + 1)) { EpiRes E{XB, SS + ((SSOUT) & 7) * (MPAD * 16), (FIN) ? args.out : nullptr, XB}; if (PROBE_FFOUT) { EpiRes E2{XB, (float*)(ws + WS_ZX + ((size_t)96 << 20)), nullptr, (bf16*)(ws + WS_YG)}; GEMM_PHASE(EpiRes, E2, ws + WS_ACT, ws + WS_WFFOUT + (FFL) * al4k(SZ_WFFOUT), DM, DFF); } GEMM_PHASE(EpiRes, E, ws + WS_ACT, ws + WS_WFFOUT + (FFL) * al4k(SZ_WFFOUT), DM, DFF); \
        sk_res(args, (const bf16*)(ws + WS_ACT), DFF, (const bf16*)(ws + WS_WFFOUT + (FFL) * al4k(SZ_WFFOUT)), SS + ((SSOUT) & 7) * (MPAD * 16), (FIN) ? args.out : nullptr, 0); SEAM((P) + 1); }

    SSD_LAYER(1, 0, 0, 1, 0, 2, false)

    if (IN(8)) { EpiSwaQkv E{(bf16*)(ws + WS_QS), (bf16*)(ws + WS_KS), (bf16*)(ws + WS_VS), (bf16*)(ws + WS_VTS), SS + 2 * (MPAD * 16), (const float*)args.in[I_SWAQN], (const float*)args.in[I_SWAKN], args.out};
        if (PROBE_QKV) GEMM_PHASE(EpiSwaQkv, E, XB, ws + WS_WSWAQKV, 2304, DM); GEMM_PHASE(EpiSwaQkv, E, XB, ws + WS_WSWAQKV, 2304, DM); sk_swaqkv(args, (const bf16*)(ws + WS_WSWAQKV), SS + 2 * (MPAD * 16), (64 * 9) % G); cache_copy_slice(args, 4, 6, (64 * 9) % G); SEAM(8); }
    if (IN(9)) { for (int rep = 0; rep < REP_SWA; ++rep) { swa_attn_phase(args, lds); __syncthreads(); } SEAM(9); }
    if (IN(10)) { swa_combine_phase(args); SEAM(10); }
    if (IN(11)) { EpiRes E{XB, SS + 3 * (MPAD * 16), nullptr, XB}; GEMM_PHASE(EpiRes, E, ws + WS_AO, ws + WS_WSWAOUT, DM, SWAW); sk_res(args, (const bf16*)(ws + WS_AO), SWAW, (const bf16*)(ws + WS_WSWAOUT), SS + 3 * (MPAD * 16), nullptr, 0); SEAM(11); }
    FFN_LAYER(12, 1, 3, 4, false)

    if (IN(14)) { EpiDiffQkv E{(bf16*)(ws + WS_QD), (bf16*)(ws + WS_KD), (bf16*)(ws + WS_VD), (bf16*)(ws + WS_VTD), SS + 4 * (MPAD * 16), (const float*)args.in[I_DQN], (const float*)args.in[I_DKN], args.out};
        if (PROBE_QKV) GEMM_PHASE(EpiDiffQkv, E, XB, ws + WS_WDQKV, 2560, DM); GEMM_PHASE(EpiDiffQkv, E, XB, ws + WS_WDQKV, 2560, DM); sk_diffqkv(args, (const bf16*)(ws + WS_WDQKV), SS + 4 * (MPAD * 16), (64 * 10) % G); cache_copy_slice(args, 5, 6, (64 * 10) % G); SEAM(14); }
    if (IN(15)) {
        if (DIFF_PARTITION && G % 32 == 0) { const int grp = bx >> 3, xl = bx & 7;
            if ((grp & 3) == 0) diff_sample_partial_mfma(args, lds, (grp >> 2) * 8 + xl, G / 4);
            else diff_attn_prompt_mfma(args, lds, lam_init2, ((grp >> 2) * 3 + (grp & 3) - 1) * 8 + xl, G - G / 4); }
        else { diff_attn_prompt_mfma(args, lds, lam_init2, bx, G); if (REP_DATT > 1) diff_attn_prompt_mfma(args, lds, lam_init2, bx, G); diff_sample_partial_mfma(args, lds, bx, G); if (REP_DSMP > 1) diff_sample_partial_mfma(args, lds, bx, G); }
        SEAM(15); }
    if (IN(16)) { diff_sample_combine_phase(args, lam_init2); SEAM(16); }
    if (IN(17)) { EpiRes E{XB, SS + 5 * (MPAD * 16), nullptr, XB}; GEMM_PHASE(EpiRes, E, ws + WS_AOD, ws + WS_WDOUT, DM, DQW); sk_res(args, (const bf16*)(ws + WS_AOD), DQW, (const bf16*)(ws + WS_WDOUT), SS + 5 * (MPAD * 16), nullptr, 0); SEAM(17); }
    FFN_LAYER(18, 2, 5, 6, false)

    SSD_LAYER(20, 1, 6, 7, 3, 8, true)
    (void)ph;
#undef IN
#undef SEAM
}

extern "C" void kernel_launch(void* const* d_in, const int* in_sizes, int n_in, void* d_out, int out_size, void* d_ws, size_t ws_size, hipStream_t stream) {
    static int grid = 0;
    if (grid == 0) {
        if (n_in != N_IN || out_size != O_TOTAL || ws_size < WS_END) { fprintf(stderr, "kernel_launch: unexpected shapes: n_in %d out %d ws %zu (need %zu)\n", n_in, out_size, ws_size, (size_t)WS_END); grid = -1; return; }
        int dev = 0, cus = 0, per_cu = 0;
        if (hipGetDevice(&dev) != hipSuccess || hipDeviceGetAttribute(&cus, hipDeviceAttributeMultiprocessorCount, dev) != hipSuccess) { grid = -1; return; }
        if (hipFuncSetAttribute((const void*)hybrid_fwd, hipFuncAttributeMaxDynamicSharedMemorySize, LDS_BYTES) != hipSuccess) { fprintf(stderr, "kernel_launch: hipFuncSetAttribute failed\n"); grid = -1; return; }
        if (hipOccupancyMaxActiveBlocksPerMultiprocessor(&per_cu, (const void*)hybrid_fwd, NTHR, LDS_BYTES) != hipSuccess || per_cu < 1) fprintf(stderr, "kernel_launch: occupancy query says %d\n", per_cu);
        (void)hipGetLastError();
        grid = cus;
    }
    if (grid < 0) return;
    if (hipMemsetAsync((char*)d_ws + WS_CTL, 0, WS_ZERO_BYTES, stream) != hipSuccess) { fprintf(stderr, "kernel_launch: memset failed\n"); return; }
    Args a{};
    for (int i = 0; i < N_IN; ++i) a.in[i] = d_in[i];
    a.out = (float*)d_out; a.ws = (unsigned char*)d_ws;
#if MK_PER_PHASE
    for (int p = 0; p < N_PHASES; ++p) { a.ph_lo = p; a.ph_hi = p + 1; hipLaunchKernelGGL(hybrid_fwd, dim3(grid), dim3(NTHR), LDS_BYTES, stream, a); }
#else
    a.ph_lo = 0; a.ph_hi = N_PHASES; hipLaunchKernelGGL(hybrid_fwd, dim3(grid), dim3(NTHR), LDS_BYTES, stream, a);
#endif
    const hipError_t le = hipPeekAtLastError();
    if (le != hipSuccess) fprintf(stderr, "kernel_launch: launch failed: %s\n", hipGetErrorName(le));
}
```

```cpp
#include <hip/hip_runtime.h>
#include <cstdio>
#include <cstdint>
#ifndef MK_PER_PHASE
#define MK_PER_PHASE 0
#endif
#ifndef REP_PRO
#define REP_PRO 1
#endif
#ifndef REP_SCAN
#define REP_SCAN 1
#endif
#ifndef REP_FFIN
#define REP_FFIN 1
#endif
#ifndef REP_SWA
#define REP_SWA 1
#endif
#ifndef REP_DATT
#define REP_DATT 1
#endif
#ifndef REP_DSMP
#define REP_DSMP 1
#endif
#ifndef REP_SCANP
#define REP_SCANP 1
#endif
#ifndef REP_SCANS
#define REP_SCANS 1
#endif
#ifndef REP_PRE
#define REP_PRE 1
#endif
#ifndef PROBE_FFIN
#define PROBE_FFIN 0
#endif
#ifndef REP_SKSW
#define REP_SKSW 1
#endif
#ifndef REP_COPY
#define REP_COPY 1
#endif
#ifndef PROBE_GN
#define PROBE_GN 0
#endif
#ifndef PROBE_FFOUT
#define PROBE_FFOUT 0
#endif
#ifndef DIFF_PARTITION
#define DIFF_PARTITION 0
#endif
#ifndef PROBE_BAR
#define PROBE_BAR 0
#endif
#ifndef PROBE_SSDIN
#define PROBE_SSDIN 0
#endif
#ifndef PROBE_QKV
#define PROBE_QKV 0
#endif
#ifndef PROBE_SST
#define PROBE_SST 0
#endif
#ifndef PROBE_SCANBAR
#define PROBE_SCANBAR 0
#endif
#ifndef PROBE_SCANT
#define PROBE_SCANT 0
#endif
#ifndef PROBE_DAT
#define PROBE_DAT 0
#endif
#ifndef DATT_XCD
#define DATT_XCD 1
#endif
#ifndef DATT_PRIO
#define DATT_PRIO 0
#endif
#ifndef PROBE_DAS
#define PROBE_DAS 0
#endif
#ifndef PROBE_SS
#define PROBE_SS 0
#endif
#ifndef PROBE_SKR
#define PROBE_SKR 0
#endif
namespace pg8 {
#define PG8_LAS __attribute__((address_space(3)))
typedef unsigned short bf16_t;
typedef short bf16x8 __attribute__((ext_vector_type(8)));
typedef float f32x4 __attribute__((ext_vector_type(4)));
typedef unsigned u32x4 __attribute__((ext_vector_type(4)));
constexpr int BM = 256, BK = 64, HALF = 128, HTB = HALF * BK * 2  , STAGE_BYTES = 8 * HTB, NXCD = 8, WGM = 8;

__host__ __device__ __forceinline__ int lds_byte(int r, int c) { const int st = (r >> 4) * 2 + (c >> 5), rr = r & 15, cc = c & 31, ob = rr * 64 + cc * 2; return st * 1024 + (ob ^ (((ob >> 9) & 1) << 5)); }
__host__ __device__ __forceinline__ void stage_rc(int b, int& R, int& C) { const int st = b / 1024, sb = b % 1024, swz = sb ^ (((sb >> 9) & 1) << 5); R = (st >> 1) * 16 + swz / 64; C = (st & 1) * 32 + (swz % 64) / 2; }
__host__ __device__ __forceinline__ int perm32(int rho) { const int n = rho >> 4, i = rho & 15; return 8 * (i >> 2) + 4 * n + (i & 3); }

struct Unit { int pm, pn; };
struct Gemm { const bf16_t* A; const bf16_t* Bt; int M, N, K; };

struct StaticOrder {
    int nM, nN, nwg, G, c;
    __host__ __device__ void init(int M, int N, int G_, int c_) { nM = M / BM; nN = N / BM; nwg = nM * nN; G = G_; c = c_; }
    __host__ __device__ bool next(int i, Unit& u) const {
        const long L = (long)i * G + c; if (L >= nwg) return false;
        int wgid = (int)L; { const int q = nwg / NXCD, r = nwg % NXCD, xcd = wgid % NXCD, off = wgid / NXCD; wgid = (xcd < r ? xcd * (q + 1) : r * (q + 1) + (xcd - r) * q) + off; }
        const int nig = WGM * nN, gid = wgid / nig, fm = gid * WGM, gsz = (nM - fm) < WGM ? (nM - fm) : WGM;
        u.pm = fm + ((wgid % nig) % gsz); u.pn = (wgid % nig) / gsz; return true;
    }
    __device__ __forceinline__ void a_ready(const Unit&) const {}
    __device__ __forceinline__ void done(const Unit&) const {}
};

__device__ __forceinline__ unsigned cvt_pk_bf16(float lo, float hi) { unsigned r; asm volatile("v_cvt_pk_bf16_f32 %0, %1, %2" : "=v"(r) : "v"(lo), "v"(hi)); return r; }
template <class Epi, class Sched, bool ALIGN_EPI = false, bool SP2 = false>
__device__ __forceinline__ void gemm_phase(PG8_LAS unsigned char* lds, const Gemm g, const Sched& S, const Epi& E) {
    const int tid = threadIdx.x, wid = __builtin_amdgcn_readfirstlane(tid >> 6), lane = tid & 63, wr = wid >> 2, wc = wid & 3, fr = lane & 15, fq = lane >> 4;
    const int K = g.K, nt = K / BK;
    unsigned voffA[2], voffB[2];
#pragma unroll
    for (int i = 0; i < 2; ++i) { int R, C; stage_rc(tid * 16 + i * 8192, R, C); const int Rb = Epi::PERM ? ((R & ~31) + perm32(R & 31)) : R;
        voffA[i] = (unsigned)(R * K + C) * 2u; voffB[i] = (unsigned)(Rb * K + C) * 2u; }
    const size_t kstep = (size_t)(BK * 2);
    const size_t hstep = (size_t)HALF * K * 2;
    const size_t tstep = 2 * hstep;
    const unsigned ldsw = (unsigned)wid * 1024u;
    const int aoff = lds_byte(wr * 64 + fr, fq * 8), boff = lds_byte(wc * 32 + fr, fq * 8);
#define PG8_SA(b, h) (((b) * 2 + (h)) * HTB)
#define PG8_SB(b, h) ((4 + (b) * 2 + (h)) * HTB)
#define PG8_STAGE(bufoff, gbase, voff) do { _Pragma("unroll") for (int _i = 0; _i < 2; ++_i) \
        __builtin_amdgcn_global_load_lds((const unsigned*)((const char*)(gbase) + (voff)[_i]), (PG8_LAS unsigned*)(lds + (bufoff) + ldsw + _i * 8192), 16, 0, 0); } while (0)
#define PG8_LDA(dst, b, h) do { _Pragma("unroll") for (int m = 0; m < 4; ++m) _Pragma("unroll") for (int k = 0; k < 2; ++k) dst[m][k] = *(const PG8_LAS bf16x8*)(lds + PG8_SA(b, h) + aoff + m * 2048 + k * 1024); } while (0)
#define PG8_LDB(dst, b, h) do { _Pragma("unroll") for (int n = 0; n < 2; ++n) _Pragma("unroll") for (int k = 0; k < 2; ++k) dst[n][k] = *(const PG8_LAS bf16x8*)(lds + PG8_SB(b, h) + boff + n * 2048 + k * 1024); } while (0)
#define PG8_MMA(ai, bj, At, Bt) do { __builtin_amdgcn_s_setprio(1); _Pragma("unroll") for (int m = 0; m < 4; ++m) _Pragma("unroll") for (int n = 0; n < 2; ++n) _Pragma("unroll") for (int k = 0; k < 2; ++k) \
        acc[ai][bj][m][n] = __builtin_amdgcn_mfma_f32_16x16x32_bf16(Bt[n][k], At[m][k], acc[ai][bj][m][n], 0, 0, 0); __builtin_amdgcn_s_setprio(0); } while (0)
#define PG8_WAIT_V(n) asm volatile("s_waitcnt vmcnt(" #n ")" ::: "memory")
#define PG8_WAIT_L(n) asm volatile("s_waitcnt lgkmcnt(" #n ")" ::: "memory")
#define PG8_BAR __builtin_amdgcn_s_barrier()
#define PG8_SCHED __builtin_amdgcn_sched_barrier(0)
    Unit cur, nxt; int ui = 0;
    if (!S.next(0, cur)) return;
    f32x4 acc[2][2][4][2];
#pragma unroll
    for (int a = 0; a < 2; ++a)
#pragma unroll
        for (int b = 0; b < 2; ++b)
#pragma unroll
            for (int m = 0; m < 4; ++m)
#pragma unroll
                for (int n = 0; n < 2; ++n) acc[a][b][m][n] = (f32x4){0.f, 0.f, 0.f, 0.f};
    bf16x8 At[4][2], B0[2][2], B1[2][2];
    const char* cA = (const char*)g.A + (size_t)cur.pm * tstep; const char* cB = (const char*)g.Bt + (size_t)cur.pn * tstep;
    S.a_ready(cur);
    if constexpr (SP2) {
        PG8_STAGE(PG8_SB(0, 0), cB, voffB); PG8_STAGE(PG8_SB(0, 1), cB + hstep, voffB); PG8_STAGE(PG8_SA(0, 0), cA, voffA); PG8_STAGE(PG8_SA(0, 1), cA + hstep, voffA);
        if (wr == 1) PG8_BAR;
        PG8_WAIT_V(2); PG8_BAR;
        PG8_STAGE(PG8_SB(1, 0), cB + kstep, voffB); PG8_STAGE(PG8_SA(1, 0), cA + kstep, voffA); PG8_STAGE(PG8_SB(1, 1), cB + hstep + kstep, voffB);
        PG8_WAIT_V(6); PG8_BAR;
    } else {
        PG8_STAGE(PG8_SB(0, 0), cB, voffB); PG8_STAGE(PG8_SA(0, 0), cA, voffA); PG8_STAGE(PG8_SB(0, 1), cB + hstep, voffB); PG8_STAGE(PG8_SA(0, 1), cA + hstep, voffA);
        if (wr == 1) PG8_BAR;
        PG8_WAIT_V(4); PG8_BAR;
        PG8_STAGE(PG8_SB(1, 0), cB + kstep, voffB); PG8_STAGE(PG8_SA(1, 0), cA + kstep, voffA); PG8_STAGE(PG8_SB(1, 1), cB + hstep + kstep, voffB);
        PG8_WAIT_V(6); PG8_BAR;
    }
    for (;;) {
        const bool has_next = S.next(ui + 1, nxt);
        const char* nA = has_next ? (const char*)g.A + (size_t)nxt.pm * tstep : cA; const char* nB = has_next ? (const char*)g.Bt + (size_t)nxt.pn * tstep : cB;
        for (int t = 0; t < nt; t += 2) {
            const bool last = (t == nt - 2);
            const char* a1 = cA + (size_t)(t + 1) * kstep;
            const char* a2 = last ? nA : cA + (size_t)(t + 2) * kstep; const char* b2 = last ? nB : cB + (size_t)(t + 2) * kstep;
            const char* a3 = a2 + kstep; const char* b3 = b2 + kstep;
            if (last && has_next) S.a_ready(nxt);
            if constexpr (SP2) {
            PG8_LDB(B0, 0, 0); PG8_LDB(B1, 0, 1); PG8_SCHED; PG8_LDA(At, 0, 0); PG8_STAGE(PG8_SA(1, 1), a1 + hstep, voffA);
            PG8_WAIT_V(8); PG8_WAIT_L(0); PG8_BAR; PG8_MMA(0, 0, At, B0); PG8_MMA(0, 1, At, B1); PG8_BAR; PG8_SCHED;
            PG8_LDA(At, 0, 1); PG8_STAGE(PG8_SB(0, 0), b2, voffB); PG8_STAGE(PG8_SB(0, 1), b2 + hstep, voffB); PG8_STAGE(PG8_SA(0, 0), a2, voffA);
            PG8_WAIT_V(8); PG8_WAIT_L(0); PG8_BAR; PG8_MMA(1, 0, At, B0); PG8_MMA(1, 1, At, B1); PG8_BAR; PG8_SCHED;
            PG8_LDB(B0, 1, 0); PG8_LDB(B1, 1, 1); PG8_SCHED; PG8_LDA(At, 1, 0); PG8_STAGE(PG8_SA(0, 1), a2 + hstep, voffA);
            PG8_WAIT_V(8); PG8_WAIT_L(0); PG8_BAR; PG8_MMA(0, 0, At, B0); PG8_MMA(0, 1, At, B1); PG8_BAR; PG8_SCHED;
            PG8_LDA(At, 1, 1); PG8_STAGE(PG8_SB(1, 0), b3, voffB); PG8_STAGE(PG8_SB(1, 1), b3 + hstep, voffB); PG8_STAGE(PG8_SA(1, 0), a3, voffA);
            PG8_WAIT_V(8); PG8_WAIT_L(0); PG8_BAR; PG8_MMA(1, 0, At, B0); PG8_MMA(1, 1, At, B1); PG8_BAR; PG8_SCHED;
            } else {
            PG8_LDB(B0, 0, 0); PG8_SCHED; PG8_LDA(At, 0, 0); PG8_STAGE(PG8_SA(1, 1), a1 + hstep, voffA);
            PG8_WAIT_L(8); PG8_BAR; PG8_WAIT_L(0); PG8_MMA(0, 0, At, B0); PG8_BAR; PG8_SCHED;
            PG8_LDB(B1, 0, 1); PG8_STAGE(PG8_SB(0, 0), b2, voffB);
            PG8_BAR; PG8_WAIT_L(0); PG8_MMA(0, 1, At, B1); PG8_BAR;
            PG8_LDA(At, 0, 1); PG8_STAGE(PG8_SA(0, 0), a2, voffA);
            PG8_BAR; PG8_WAIT_L(0); PG8_MMA(1, 0, At, B0); PG8_BAR; PG8_SCHED;
            PG8_STAGE(PG8_SB(0, 1), b2 + hstep, voffB);
            PG8_WAIT_V(6); PG8_BAR; PG8_MMA(1, 1, At, B1); PG8_BAR;
            PG8_LDB(B0, 1, 0); PG8_SCHED; PG8_LDA(At, 1, 0); PG8_STAGE(PG8_SA(0, 1), a2 + hstep, voffA);
            PG8_WAIT_L(8); PG8_BAR; PG8_WAIT_L(0); PG8_MMA(0, 0, At, B0); PG8_BAR; PG8_SCHED;
            PG8_LDB(B1, 1, 1); PG8_STAGE(PG8_SB(1, 0), b3, voffB);
            PG8_BAR; PG8_WAIT_L(0); PG8_MMA(0, 1, At, B1); PG8_BAR;
            PG8_LDA(At, 1, 1); PG8_STAGE(PG8_SA(1, 0), a3, voffA);
            PG8_BAR; PG8_WAIT_L(0); PG8_MMA(1, 0, At, B0); PG8_BAR; PG8_SCHED;
            PG8_STAGE(PG8_SB(1, 1), b3 + hstep, voffB);
            PG8_WAIT_V(6); PG8_BAR; PG8_MMA(1, 1, At, B1); PG8_BAR;
            }
        }
        if constexpr (ALIGN_EPI) { if (wr == 0) PG8_BAR; }
        if constexpr (!Epi::AFTER_DRAIN) { E(acc, cur, wr, wc, fr, fq); S.done(cur); }
        if (!has_next) break;
#pragma unroll
        for (int a = 0; a < 2; ++a)
#pragma unroll
            for (int b = 0; b < 2; ++b)
#pragma unroll
                for (int m = 0; m < 4; ++m)
#pragma unroll
                    for (int n = 0; n < 2; ++n) acc[a][b][m][n] = (f32x4){0.f, 0.f, 0.f, 0.f};
        cur = nxt; cA = nA; cB = nB; ++ui;
        if constexpr (ALIGN_EPI) { if (wr == 1) PG8_BAR; }
    }
    PG8_WAIT_V(0);
    if constexpr (!ALIGN_EPI) { if (wr == 0) PG8_BAR; }
    PG8_BAR;
    if constexpr (Epi::AFTER_DRAIN) { E.fused(acc, cur, wr, wc, fr, fq, lds, wid, lane); S.done(cur); }
#undef PG8_SA
#undef PG8_SB
#undef PG8_STAGE
#undef PG8_LDA
#undef PG8_LDB
#undef PG8_MMA
#undef PG8_WAIT_V
#undef PG8_WAIT_L
#undef PG8_BAR
#undef PG8_SCHED
}
}

constexpr int DM = 1024, SEQ = 2048, NBP = 8, NBS = 32, TS = 4, PAST = 8192;
constexpr int MP = NBP * SEQ;
constexpr int MS = NBS * TS;
constexpr int MTOK = MP + MS;
constexpr int MPAD = 16640;
constexpr int DFF = 2816, DIN = 2048, CONVD = 3072, ZXW = 5120, SSMN = 5152, SSMNP = 5376;
constexpr int SWAW = 768, DQW = 1536, DKW = 512;
constexpr float EPS = 1e-6f;
constexpr int NWAVES = 8, NTHR = 512;

enum { I_XP = 0, I_XS, I_CONVST, I_SSMST, I_SWA0, I_SWA1, I_SWA2, I_DCK, I_DCV, I_PT, I_RELB, I_NMIX, I_NFFN, I_FFIN, I_FFOUT,
       I_SSMWIN, I_CONVW, I_CONVB, I_DTB, I_ALOG, I_SSMD, I_SSMNORM, I_SSMWOUT, I_SWAQKV, I_SWAQN, I_SWAKN, I_SWAOUT,
       I_DQKV, I_DQN, I_DKN, I_DLAM, I_DON, I_DOUT, N_IN };

constexpr int O_Y_P = 0;
constexpr int O_Y_S = O_Y_P + MP * DM;
constexpr int O_CONV_P = O_Y_S + MS * DM;
constexpr int O_CONV_S = O_CONV_P + 2 * NBP * 3 * CONVD;
constexpr int O_SSM_P = O_CONV_S + 2 * NBS * 3 * CONVD;
constexpr int O_SSM_S = O_SSM_P + 2 * NBP * 32 * 64 * 128;
constexpr int O_KV0_P = O_SSM_S + 2 * NBS * 32 * 64 * 128;
constexpr int O_KV0_S = O_KV0_P + NBP * 128 * 512;
constexpr int O_KV1_P = O_KV0_S + NBS * 128 * 512;
constexpr int O_KV1_S = O_KV1_P + NBP * 512 * 512;
constexpr int O_KV2_P = O_KV1_S + NBS * 512 * 512;
constexpr int O_KV2_S = O_KV2_P + NBP * 2048 * 512;
constexpr int O_DK_P = O_KV2_S + NBS * 2048 * 512;
constexpr int O_DK_S = O_DK_P + MP * 512;
constexpr int O_DV_P = O_DK_S + MS * 512;
constexpr int O_DV_S = O_DV_P + MP * 512;
constexpr int O_TOTAL = O_DV_S + MS * 512;
static_assert(O_TOTAL == 110575616, "output size");

constexpr size_t al4k(size_t x) { return (x + 4095) & ~(size_t)4095; }
constexpr size_t WS_CTL = 0;
constexpr size_t WS_ZERO_BYTES = (size_t)1 << 20;
constexpr size_t WS_SS = (size_t)1 << 20;
constexpr size_t SZ_SS1 = (size_t)MPAD * 16 * 4;
constexpr size_t SZ_WSSDIN = (size_t)SSMNP * DM * 2, SZ_WSSDOUT = (size_t)DM * DIN * 2, SZ_WSWAQKV = (size_t)2304 * DM * 2, SZ_WSWAOUT = (size_t)DM * SWAW * 2,
                 SZ_WDQKV = (size_t)2560 * DM * 2, SZ_WDOUT = (size_t)DM * DQW * 2, SZ_WFFIN = (size_t)2 * DFF * DM * 2, SZ_WFFOUT = (size_t)DM * DFF * 2;
constexpr size_t WS_WSSDIN = WS_SS + al4k(8 * SZ_SS1);
constexpr size_t WS_WSSDOUT = WS_WSSDIN + 2 * al4k(SZ_WSSDIN);
constexpr size_t WS_WSWAQKV = WS_WSSDOUT + 2 * al4k(SZ_WSSDOUT);
constexpr size_t WS_WSWAOUT = WS_WSWAQKV + al4k(SZ_WSWAQKV);
constexpr size_t WS_WDQKV = WS_WSWAOUT + al4k(SZ_WSWAOUT);
constexpr size_t WS_WDOUT = WS_WDQKV + al4k(SZ_WDQKV);
constexpr size_t WS_WFFIN = WS_WDOUT + al4k(SZ_WDOUT);
constexpr size_t WS_WFFOUT = WS_WFFIN + 4 * al4k(SZ_WFFIN);
constexpr size_t WS_X = WS_WFFOUT + 4 * al4k(SZ_WFFOUT);
constexpr size_t WS_XB = WS_X + al4k((size_t)MPAD * DM * 4);
constexpr size_t WS_ZX = WS_XB + al4k((size_t)MPAD * DM * 2);
constexpr size_t WS_DT = WS_ZX + al4k((size_t)MPAD * ZXW * 2);
constexpr size_t WS_YG = WS_DT + al4k((size_t)MPAD * 32 * 4);
constexpr size_t WS_ACT = WS_YG + al4k((size_t)MPAD * DIN * 2);
constexpr size_t WS_QS = WS_ACT + al4k((size_t)MPAD * DFF * 2);
constexpr size_t WS_KS = WS_QS + al4k((size_t)MPAD * SWAW * 2);
constexpr size_t WS_VS = WS_KS + al4k((size_t)MPAD * SWAW * 2);
constexpr size_t WS_AO = WS_VS + al4k((size_t)MPAD * SWAW * 2);
constexpr size_t WS_QD = WS_AO + al4k((size_t)MPAD * SWAW * 2);
constexpr size_t WS_KD = WS_QD + al4k((size_t)MPAD * DQW * 2);
constexpr size_t WS_VD = WS_KD + al4k((size_t)MPAD * DKW * 2);
constexpr size_t WS_AOD = WS_VD + al4k((size_t)MPAD * DKW * 2);
constexpr size_t WS_VTD = WS_AOD + al4k((size_t)MPAD * DQW * 2);
constexpr size_t WS_BC = WS_VTD + al4k((size_t)NBP * 4 * 128 * SEQ * 2);
constexpr size_t WS_BT = WS_BC + al4k((size_t)MP * 1024 * 2);
constexpr size_t WS_SC = WS_BT + al4k((size_t)NBP * 4 * 128 * SEQ * 2);
constexpr size_t WS_VTS = WS_SC + al4k((size_t)MP * 32 * 16);
constexpr size_t WS_LSE = WS_VTS + al4k((size_t)NBP * 12 * 64 * SEQ * 2);
constexpr int PART_STRIDE = 132;
constexpr size_t WS_PART = WS_LSE + al4k((size_t)MP * 12 * 4);
constexpr size_t WS_END = WS_PART + al4k((size_t)1024 * 24 * PART_STRIDE * 4);

constexpr int CW_BAR = 4096;

constexpr int RING_BYTES = 131072;
constexpr int LDSCTL_OFF = RING_BYTES, MISC_OFF = LDSCTL_OFF + 320;
constexpr int LDS_BYTES = 147456;

#define GAS __attribute__((address_space(1)))
#define LAS __attribute__((address_space(3)))
typedef unsigned short bf16;
typedef unsigned v4u __attribute__((ext_vector_type(4)));
typedef unsigned v2u __attribute__((ext_vector_type(2)));
typedef float f32x4 __attribute__((ext_vector_type(4)));
typedef float f32x2 __attribute__((ext_vector_type(2)));
typedef float f32x16 __attribute__((ext_vector_type(16)));
typedef GAS unsigned gu32;
#define RLX_AGENT __ATOMIC_RELAXED, __HIP_MEMORY_SCOPE_AGENT
#define LDS_WAIT() asm volatile("s_waitcnt lgkmcnt(0)" ::: "memory")

__device__ __forceinline__ float bf2f(unsigned short v) { return __builtin_bit_cast(float, (unsigned)v << 16); }
__device__ __forceinline__ float bflo(unsigned w) { return __builtin_bit_cast(float, w << 16); }
__device__ __forceinline__ float bfhi(unsigned w) { return __builtin_bit_cast(float, w & 0xffff0000u); }
__device__ __forceinline__ unsigned f2bf(float f) { unsigned u = __builtin_bit_cast(unsigned, f); return (u + 0x7fffu + ((u >> 16) & 1u)) >> 16; }
__device__ __forceinline__ unsigned pk2(float lo, float hi) { return pg8::cvt_pk_bf16(lo, hi); }
__device__ __forceinline__ int opaque_tid() { int t = threadIdx.x; asm volatile("" : "+v"(t)); return t; }
__device__ __forceinline__ float wave_sum(float v) {
#pragma unroll
    for (int o = 1; o < 64; o <<= 1) v += __shfl_xor(v, o);
    return v;
}
__device__ __forceinline__ float wave_max(float v) {
#pragma unroll
    for (int o = 1; o < 64; o <<= 1) v = fmaxf(v, __shfl_xor(v, o));
    return v;
}
__device__ __forceinline__ float silu_f(float x) { return x * __builtin_amdgcn_rcpf(1.f + __expf(-x)); }
__device__ __forceinline__ float softplus_f(float x) { return x > 20.f ? x : log1pf(__expf(x)); }
__device__ __forceinline__ int rel_bucket(int d) {
    d = d < 0 ? 0 : d;
    if (d < 16) return d;
    const float v = logf((float)d / 16.0f) / 4.852030263919617f * 16.0f;
    const int l = 16 + (int)v;
    return l < 31 ? l : 31;
}

#define XB_TMO      128
#define XB_XCNT(j)  (256  + 64 * (j))
#define XB_XSUB(j)  (1280 + 64 * (j))
#define XB_XGEN(j)  (2304 + 64 * (j))
#define XB_TOP      3328
#define XB_TOPGEN   3392
#define XCD_BAR_WORDS 3456
#define XB_SPIN_CAP (1u << 18)
__device__ __forceinline__ unsigned xb_ld(unsigned* p)              { return __hip_atomic_load(p, __ATOMIC_RELAXED, __HIP_MEMORY_SCOPE_AGENT); }
__device__ __forceinline__ unsigned xb_add(unsigned* p, unsigned v) { return __hip_atomic_fetch_add(p, v, __ATOMIC_RELAXED, __HIP_MEMORY_SCOPE_AGENT); }
__device__ __forceinline__ unsigned xb_xcc_id() { return (unsigned)__builtin_amdgcn_s_getreg((3 << 11) | 20) & 0xFu; }
#define XB_SPIN(cond, bar) do { unsigned _sp = 0; while (cond) { __builtin_amdgcn_s_sleep(1); \
    if ((++_sp & 255u) == 0u) { if (xb_ld(&(bar)[XB_TMO])) break; if (_sp > XB_SPIN_CAP) { atomicAdd(&(bar)[XB_TMO], 1u); break; } } } } while (0)
struct XcdBarrier { unsigned* bar; unsigned x; volatile LAS unsigned* st; };
__device__ __forceinline__ XcdBarrier xcd_barrier_post(unsigned* bar, volatile LAS unsigned* st) {
    XcdBarrier b; b.bar = bar; b.x = xb_xcc_id(); b.st = st;
    if (threadIdx.x == 0) (void)xb_add(&bar[XB_XCNT(b.x)], 1u);
    return b;
}
__device__ __forceinline__ void xcd_barrier_complete(unsigned* bar, unsigned x, unsigned& nloc, unsigned& nx) {
    const unsigned G = gridDim.x * gridDim.y * gridDim.z;
    unsigned sum, cnt, mine, sp = 0u;
    for (;;) {
        sum = 0u; cnt = 0u; mine = 0u;
#pragma unroll
        for (unsigned j = 0; j < 16; ++j) { const unsigned c = xb_ld(&bar[XB_XCNT(j)]); sum += c; cnt += (c > 0u) ? 1u : 0u; mine = (j == x) ? c : mine; }
        if (sum == G) break;
        __builtin_amdgcn_s_sleep(1);
        if ((++sp & 255u) == 0u) { if (xb_ld(&bar[XB_TMO])) break; if (sp > XB_SPIN_CAP) { atomicAdd(&bar[XB_TMO], 1u); break; } }
    }
    nloc = mine > 0u ? mine : 1u; nx = cnt > 0u ? cnt : 1u;
}
__device__ __forceinline__ void xcd_barrier(const XcdBarrier& b) {
    asm volatile("s_waitcnt vmcnt(0)" ::: "memory");
    __syncthreads();
    if (threadIdx.x == 0) {
        unsigned* bar = b.bar;
        __builtin_amdgcn_s_waitcnt(0);
        unsigned nloc = b.st[0], nx = b.st[1];
        if (nloc == 0u) { xcd_barrier_complete(bar, b.x, nloc, nx); b.st[0] = nloc; b.st[1] = nx; }
        const unsigned old = xb_add(&bar[XB_XSUB(b.x)], 1u);
        const unsigned gen = old / nloc;
        if (old + 1u == (gen + 1u) * nloc) {
            __builtin_amdgcn_fence(__ATOMIC_RELEASE, "agent");
            asm volatile("s_waitcnt vmcnt(0)" ::: "memory");
            const unsigned og = xb_add(&bar[XB_TOP], 1u);
            const unsigned tg = og / nx;
            if (og + 1u == (tg + 1u) * nx) xb_add(&bar[XB_TOPGEN], 1u);
            else XB_SPIN(xb_ld(&bar[XB_TOPGEN]) == tg, bar);
            __builtin_amdgcn_fence(__ATOMIC_ACQUIRE, "agent");
            xb_add(&bar[XB_XGEN(b.x)], 1u);
            asm volatile("s_waitcnt vmcnt(0)" ::: "memory");
        } else {
            XB_SPIN(xb_ld(&bar[XB_XGEN(b.x)]) == gen, bar);
            __builtin_amdgcn_fence(__ATOMIC_ACQUIRE, "agent");
            asm volatile("s_waitcnt vmcnt(0)" ::: "memory");
        }
    }
    __syncthreads();
}

struct Args { const void* in[N_IN]; float* out; unsigned char* ws; int ph_lo, ph_hi; };
static_assert(sizeof(Args) == N_IN * 8 + 24, "Args has no padding");

__device__ __forceinline__ float rs_of(const float* ssp, int row) {
    const f32x4* p = (const f32x4*)(ssp + (size_t)row * 16); const f32x4 a = p[0], b = p[1], c = p[2], d = p[3];
    const float s = (((a[0] + a[1]) + (a[2] + a[3])) + ((b[0] + b[1]) + (b[2] + b[3]))) + (((c[0] + c[1]) + (c[2] + c[3])) + ((d[0] + d[1]) + (d[2] + d[3])));
    return rsqrtf(s * (1.0f / 1024.0f) + EPS);
}
#define RS_OF(ss, row) rs_of((ss), (row))

struct EpiSsdIn {
    static constexpr bool PERM = true, AFTER_DRAIN = false;
    bf16* ZX; float* DT; const float* ss; const float* dtb;
    __device__ __forceinline__ void operator()(const pg8::f32x4 (&acc)[2][2][4][2], const pg8::Unit& u, int wr, int wc, int fr, int fq) const {
        const int row0 = u.pm * 256 + wr * 64 + fr;
        {
            const int col0 = u.pn * 256 + wc * 32 + 8 * fq;
#pragma unroll
            for (int ai = 0; ai < 2; ++ai)
#pragma unroll
                for (int m = 0; m < 4; ++m) { const int row = row0 + ai * 128 + m * 16; const float rs = RS_OF(ss, row);
#pragma unroll
                    for (int bj = 0; bj < 2; ++bj) { const f32x4 v0 = acc[ai][bj][m][0] * rs, v1 = acc[ai][bj][m][1] * rs;
                        v4u w; w.x = pk2(v0[0], v0[1]); w.y = pk2(v0[2], v0[3]); w.z = pk2(v1[0], v1[1]); w.w = pk2(v1[2], v1[3]);
                        *(v4u*)(ZX + (size_t)row * ZXW + col0 + bj * 128) = w; } }
        }
    }
};

struct EpiNone { static constexpr bool PERM = true, AFTER_DRAIN = false;
    __device__ __forceinline__ void operator()(const pg8::f32x4 (&acc)[2][2][4][2], const pg8::Unit& u, int wr, int wc, int fr, int fq) const { asm volatile("" :: "v"(acc[0][0][0][0][0]), "v"(acc[1][1][3][1][3])); } };
struct EpiRes {
    static constexpr bool PERM = true, AFTER_DRAIN = false;
    const bf16* XB; float* ss_out; float* fin; bf16* XBd;
    __device__ __forceinline__ void operator()(const pg8::f32x4 (&acc)[2][2][4][2], const pg8::Unit& u, int wr, int wc, int fr, int fq) const {
        const int row0 = u.pm * 256 + wr * 64 + fr, col0 = u.pn * 256 + wc * 32 + 8 * fq;
#pragma unroll
        for (int ai = 0; ai < 2; ++ai)
#pragma unroll
            for (int m = 0; m < 4; ++m) { const int row = row0 + ai * 128 + m * 16; float q = 0.f;
                const bf16* xr = XB + (size_t)row * DM + col0;
                v4u xin[2];
#pragma unroll
                for (int bj = 0; bj < 2; ++bj) xin[bj] = *(const v4u*)(xr + bj * 128);
#pragma unroll
                for (int bj = 0; bj < 2; ++bj) { const int co = bj * 128; const v4u xi = xin[bj];
                    const f32x4 v0 = (f32x4){bflo(xi.x), bfhi(xi.x), bflo(xi.y), bfhi(xi.y)} + acc[ai][bj][m][0];
                    const f32x4 v1 = (f32x4){bflo(xi.z), bfhi(xi.z), bflo(xi.w), bfhi(xi.w)} + acc[ai][bj][m][1];
                    if (fin) { if (row < MTOK) { *(f32x4*)(fin + (size_t)row * DM + col0 + co) = v0; *(f32x4*)(fin + (size_t)row * DM + col0 + co + 4) = v1; } }
                    else { v4u w; w.x = pk2(v0[0], v0[1]); w.y = pk2(v0[2], v0[3]); w.z = pk2(v1[0], v1[1]); w.w = pk2(v1[2], v1[3]); *(v4u*)(XBd + (size_t)row * DM + col0 + co) = w;
                           q += ((v0[0] * v0[0] + v0[1] * v0[1]) + (v0[2] * v0[2] + v0[3] * v0[3])) + ((v1[0] * v1[0] + v1[1] * v1[1]) + (v1[2] * v1[2] + v1[3] * v1[3])); } }
                if (!fin) { q += __shfl_xor(q, 16); q += __shfl_xor(q, 32);
                    if (fq == 0) ss_out[(size_t)row * 16 + u.pn * 4 + wc] = q; } }
    }
};

struct EpiSwiGlu {
    static constexpr bool PERM = true, AFTER_DRAIN = false;
    bf16* ACT; const float* ss;
    __device__ __forceinline__ void operator()(const pg8::f32x4 (&acc)[2][2][4][2], const pg8::Unit& u, int wr, int wc, int fr, int fq) const {
        const int row0 = u.pm * 256 + wr * 64 + fr, col0 = u.pn * 128 + wc * 32 + 8 * fq;
#pragma unroll
        for (int ai = 0; ai < 2; ++ai)
#pragma unroll
            for (int m = 0; m < 4; ++m) { const int row = row0 + ai * 128 + m * 16; const float rs = RS_OF(ss, row);
                f32x4 o[2];
#pragma unroll
                for (int n = 0; n < 2; ++n) { const f32x4 g = acc[ai][0][m][n] * rs, up = acc[ai][1][m][n] * rs;
#pragma unroll
                    for (int j = 0; j < 4; ++j) o[n][j] = silu_f(g[j]) * up[j]; }
                v4u w; w.x = pk2(o[0][0], o[0][1]); w.y = pk2(o[0][2], o[0][3]); w.z = pk2(o[1][0], o[1][1]); w.w = pk2(o[1][2], o[1][3]);
                *(v4u*)(ACT + (size_t)row * DFF + col0) = w; }
    }
};

struct EpiSwaQkv {
    static constexpr bool PERM = true, AFTER_DRAIN = false;
    bf16 *Q, *K, *V, *VT; const float* ss; const float *qn, *kn; float* out;
    __device__ __forceinline__ void operator()(const pg8::f32x4 (&acc)[2][2][4][2], const pg8::Unit& u, int wr, int wc, int fr, int fq) const {
        const int row0 = u.pm * 256 + wr * 64 + fr;
        const int slot = u.pn * 4 + wc, kind = slot / 12, head = slot - kind * 12;
        const float* nwp = kind == 0 ? qn : kn;
        f32x4 nw[2][2];
#pragma unroll
        for (int bj = 0; bj < 2; ++bj)
#pragma unroll
            for (int n = 0; n < 2; ++n) nw[bj][n] = (kind < 2) ? *(const f32x4*)(nwp + 32 * bj + 8 * fq + 4 * n) : (f32x4){1.f, 1.f, 1.f, 1.f};
        bf16* dst = Q + (size_t)kind * ((WS_KS - WS_QS) / 2) + head * 64 + 8 * fq;
        const int g = head >> 2, j4 = head & 3, kv = kind - 1, keep = 128 << (2 * g);
        const int obp = g == 0 ? O_KV0_P : (g == 1 ? O_KV1_P : O_KV2_P), obs = g == 0 ? O_KV0_S : (g == 1 ? O_KV1_S : O_KV2_S);
        const bool vt16 = (kind == 2) && (u.pm < 64) && (g == 2);
        if (vt16) {
#pragma unroll
            for (int ai = 0; ai < 2; ++ai) {
                const int rowa = row0 + ai * 128, b = rowa >> 11, t = rowa & 2047, pp = ((t & 15) << 7) + (t >> 4), tp = (pp & ~12) | ((pp & 4) << 1) | ((pp & 8) >> 1);
                bf16* vt = VT + ((size_t)((b * 12 + head) * 64 + 8 * fq)) * SEQ + tp;
                const float r0 = RS_OF(ss, rowa), r1 = RS_OF(ss, rowa + 16), r2 = RS_OF(ss, rowa + 32), r3 = RS_OF(ss, rowa + 48);
#pragma unroll
                for (int bj = 0; bj < 2; ++bj)
#pragma unroll
                    for (int n = 0; n < 2; ++n) { const f32x4 x0 = acc[ai][bj][0][n] * r0, x1 = acc[ai][bj][1][n] * r1, x2 = acc[ai][bj][2][n] * r2, x3 = acc[ai][bj][3][n] * r3;
#pragma unroll
                        for (int j = 0; j < 4; ++j) { v2u w; w.x = f2bf(x0[j]) | (f2bf(x1[j]) << 16); w.y = f2bf(x2[j]) | (f2bf(x3[j]) << 16); *(v2u*)(vt + (size_t)(32 * bj + 4 * n + j) * SEQ) = w; } }
            }
        }
#pragma unroll
        for (int ai = 0; ai < 2; ++ai)
#pragma unroll
            for (int m = 0; m < 4; ++m) { const int row = row0 + ai * 128 + m * 16; const float rs = RS_OF(ss, row);
                f32x4 v[2][2]; float q = 0.f;
#pragma unroll
                for (int bj = 0; bj < 2; ++bj)
#pragma unroll
                    for (int n = 0; n < 2; ++n) { v[bj][n] = acc[ai][bj][m][n] * rs; const f32x4 x = v[bj][n]; q += (x[0] * x[0] + x[1] * x[1]) + (x[2] * x[2] + x[3] * x[3]); }
                if (kind < 2) { q += __shfl_xor(q, 16); q += __shfl_xor(q, 32); const float r = rsqrtf(q * (1.0f / 64.0f) + EPS);
#pragma unroll
                    for (int bj = 0; bj < 2; ++bj)
#pragma unroll
                        for (int n = 0; n < 2; ++n) v[bj][n] = v[bj][n] * r * nw[bj][n]; }
                if (vt16) { } else if (kind == 2 && u.pm < 64) {
                    const int b = row >> 11, t = row & 2047, pp = ((t & ((1 << (2 * g)) - 1)) << (11 - 2 * g)) + (t >> (2 * g)), tp = (pp & ~12) | ((pp & 4) << 1) | ((pp & 8) >> 1);
                    bf16* vt = VT + ((size_t)((b * 12 + head) * 64 + 8 * fq)) * SEQ + tp;
#pragma unroll
                    for (int bj = 0; bj < 2; ++bj)
#pragma unroll
                        for (int n = 0; n < 2; ++n)
#pragma unroll
                            for (int j = 0; j < 4; ++j) vt[(size_t)(32 * bj + 4 * n + j) * SEQ] = (bf16)f2bf(v[bj][n][j]);
                } else {
#pragma unroll
                for (int bj = 0; bj < 2; ++bj) { v4u w; w.x = pk2(v[bj][0][0], v[bj][0][1]); w.y = pk2(v[bj][0][2], v[bj][0][3]); w.z = pk2(v[bj][1][0], v[bj][1][1]); w.w = pk2(v[bj][1][2], v[bj][1][3]);
                    *(v4u*)(dst + (size_t)row * SWAW + 32 * bj) = w; }
                }
                if (kind >= 1 && row < MTOK) {
                    int base = -1;
                    if (row < MP) { const int b = row >> 11, t = row & 2047, t0 = 2048 - keep; if (t >= t0) base = obp + (((b * keep + (t - t0)) * 2 + kv) * 4 + j4) * 64; }
                    else { const int r2 = row - MP, b = r2 >> 2, tt = r2 & 3; base = obs + (((b * keep + (keep - 4 + tt)) * 2 + kv) * 4 + j4) * 64; }
                    if (base >= 0) {
#pragma unroll
                        for (int bj = 0; bj < 2; ++bj)
#pragma unroll
                            for (int n = 0; n < 2; ++n) *(f32x4*)(out + base + 32 * bj + 8 * fq + 4 * n) = v[bj][n]; }
                } }
    }
};

struct EpiDiffQkv {
    static constexpr bool PERM = true, AFTER_DRAIN = false;
    bf16 *Q, *K, *V, *VT; const float* ss; const float *qn, *kn; float* out;
    __device__ __forceinline__ void operator()(const pg8::f32x4 (&acc)[2][2][4][2], const pg8::Unit& u, int wr, int wc, int fr, int fq) const {
        const int row0 = u.pm * 256 + wr * 64 + fr;
        const int slot = u.pn * 4 + wc, kind = slot < 24 ? 0 : (slot < 32 ? 1 : 2);
        const float* nwp = kind == 0 ? qn : kn;
        f32x4 nw[2][2];
#pragma unroll
        for (int bj = 0; bj < 2; ++bj)
#pragma unroll
            for (int n = 0; n < 2; ++n) nw[bj][n] = (kind < 2) ? *(const f32x4*)(nwp + 32 * bj + 8 * fq + 4 * n) : (f32x4){1.f, 1.f, 1.f, 1.f};
        bf16* dst; int pitch, cofs;
        if (kind == 0) { dst = Q; pitch = DQW; cofs = slot * 64; } else { dst = K + (size_t)(kind - 1) * ((WS_VD - WS_KD) / 2); pitch = DKW; cofs = (slot - (kind == 1 ? 24 : 32)) * 64; }
        const int obp = kind == 1 ? O_DK_P : O_DV_P, obs = kind == 1 ? O_DK_S : O_DV_S;
#pragma unroll
        for (int ai = 0; ai < 2; ++ai)
#pragma unroll
            for (int m = 0; m < 4; ++m) { const int row = row0 + ai * 128 + m * 16; const float rs = RS_OF(ss, row);
                f32x4 v[2][2]; float q = 0.f;
#pragma unroll
                for (int bj = 0; bj < 2; ++bj)
#pragma unroll
                    for (int n = 0; n < 2; ++n) { v[bj][n] = acc[ai][bj][m][n] * rs; const f32x4 x = v[bj][n]; q += (x[0] * x[0] + x[1] * x[1]) + (x[2] * x[2] + x[3] * x[3]); }
                if (kind < 2) { q += __shfl_xor(q, 16); q += __shfl_xor(q, 32); const float r = rsqrtf(q * (1.0f / 64.0f) + EPS);
#pragma unroll
                    for (int bj = 0; bj < 2; ++bj)
#pragma unroll
                        for (int n = 0; n < 2; ++n) v[bj][n] = v[bj][n] * r * nw[bj][n]; }
                if (kind == 2 && u.pm < 64) {
                    const int b = row >> 11, t = row & 2047, tp = (t & ~12) | ((t & 4) << 1) | ((t & 8) >> 1), gg = (slot - 32) >> 1, half = (slot - 32) & 1;
                    bf16* vt = VT + ((size_t)((b * 4 + gg) * 128 + half * 64 + 8 * fq)) * SEQ + tp;
#pragma unroll
                    for (int bj = 0; bj < 2; ++bj)
#pragma unroll
                        for (int n = 0; n < 2; ++n)
#pragma unroll
                            for (int j = 0; j < 4; ++j) vt[(size_t)(32 * bj + 4 * n + j) * SEQ] = (bf16)f2bf(v[bj][n][j]);
                } else {
#pragma unroll
                for (int bj = 0; bj < 2; ++bj) { v4u w; w.x = pk2(v[bj][0][0], v[bj][0][1]); w.y = pk2(v[bj][0][2], v[bj][0][3]); w.z = pk2(v[bj][1][0], v[bj][1][1]); w.w = pk2(v[bj][1][2], v[bj][1][3]);
                    *(v4u*)(dst + (size_t)row * pitch + cofs + 32 * bj + 8 * fq) = w; }
                }
                if (kind >= 1 && row < MTOK) {
                    const int base = (row < MP ? obp + row * 512 : obs + (row - MP) * 512) + cofs;
#pragma unroll
                    for (int bj = 0; bj < 2; ++bj)
#pragma unroll
                        for (int n = 0; n < 2; ++n) *(f32x4*)(out + base + 32 * bj + 8 * fq + 4 * n) = v[bj][n];
                } }
    }
};


template <int NT>
__device__ __forceinline__ void wave_gemm(f32x4 (&acc)[NT], const bf16* Arow, const bf16* Bt, const int (&nb)[NT], int K, int r, int c4) {
    const bf16* ap = Arow + 8 * c4;
    const bf16* bp[NT];
#pragma unroll
    for (int nt = 0; nt < NT; ++nt) { bp[nt] = Bt + (size_t)(nb[nt] + r) * K + 8 * c4; acc[nt] = (f32x4){0.f, 0.f, 0.f, 0.f}; }
#pragma unroll 1
    for (int k0 = 0; k0 < K; k0 += 256) {
        pg8::bf16x8 af[8], bf_[NT][8];
#pragma unroll
        for (int s2 = 0; s2 < 8; ++s2) { af[s2] = *(const pg8::bf16x8*)(ap + k0 + 32 * s2);
#pragma unroll
            for (int nt = 0; nt < NT; ++nt) bf_[nt][s2] = *(const pg8::bf16x8*)(bp[nt] + k0 + 32 * s2); }
#pragma unroll
        for (int s2 = 0; s2 < 8; ++s2)
#pragma unroll
            for (int nt = 0; nt < NT; ++nt) acc[nt] = __builtin_amdgcn_mfma_f32_16x16x32_bf16(bf_[nt][s2], af[s2], acc[nt], 0, 0, 0);
    }
}
#define SK_WAVE_IDS const int tid = threadIdx.x, lane = tid & 63, wave = __builtin_amdgcn_readfirstlane(tid >> 6), r = lane & 15, c4 = lane >> 4; \
    const int nidle = (int)gridDim.x - c0, blkp = ((int)blockIdx.x - c0 + (int)gridDim.x) % (int)gridDim.x, ngw = nidle * NWAVES; \
    const int gwp = (blkp < nidle) ? wave * nidle + blkp : (1 << 30)

__device__ __forceinline__ void sk_res(const Args& A, const bf16* Aact, int K, const bf16* Bt, float* ss_out, float* fin, int c0) {
    SK_WAVE_IDS; bf16* XB = (bf16*)(A.ws + WS_XB);
    for (int task = gwp; task < 16 * 8; task += ngw) {
        const int it = task >> 3, rt = task & 7, row = MP + 16 * rt + r;
        const int nb[4] = {64 * it, 64 * it + 16, 64 * it + 32, 64 * it + 48};
        f32x4 acc[4]; wave_gemm<4>(acc, Aact + (size_t)row * K, Bt, nb, K, r, c4);
        float q = 0.f;
#pragma unroll
        for (int nt = 0; nt < 4; ++nt) { const int col = nb[nt] + 4 * c4; const v2u xi = *(const v2u*)(XB + (size_t)row * DM + col);
            const f32x4 v = (f32x4){bflo(xi.x), bfhi(xi.x), bflo(xi.y), bfhi(xi.y)} + acc[nt];
            if (fin) *(f32x4*)(fin + (size_t)row * DM + col) = v;
            else { v2u w; w.x = pk2(v[0], v[1]); w.y = pk2(v[2], v[3]); *(v2u*)(XB + (size_t)row * DM + col) = w; q += (v[0] * v[0] + v[1] * v[1]) + (v[2] * v[2] + v[3] * v[3]); } }
        if (!fin) { q += __shfl_xor(q, 16); q += __shfl_xor(q, 32); if (c4 == 0) ss_out[(size_t)row * 16 + it] = q; }
    }
}
__device__ __forceinline__ void sk_swiglu(const Args& A, const bf16* Bt, const float* ss, int c0) {
    SK_WAVE_IDS; const bf16* XB = (const bf16*)(A.ws + WS_XB); bf16* ACT = (bf16*)(A.ws + WS_ACT);
    for (int task = gwp; task < 88 * 8; task += ngw) {
        const int it = task >> 3, rt = task & 7, row = MP + 16 * rt + r, pn = it >> 2, i0 = (it & 3) * 32;
        const int nb[4] = {256 * pn + i0, 256 * pn + i0 + 16, 256 * pn + 128 + i0, 256 * pn + 128 + i0 + 16};
        f32x4 acc[4]; wave_gemm<4>(acc, XB + (size_t)row * DM, Bt, nb, DM, r, c4);
        const float rs = RS_OF(ss, row);
#pragma unroll
        for (int h2 = 0; h2 < 2; ++h2) { const f32x4 g = acc[h2] * rs, up = acc[2 + h2] * rs;
            v2u w; w.x = pk2(silu_f(g[0]) * up[0], silu_f(g[1]) * up[1]); w.y = pk2(silu_f(g[2]) * up[2], silu_f(g[3]) * up[3]);
            *(v2u*)(ACT + (size_t)row * DFF + 128 * pn + i0 + 16 * h2 + 4 * c4) = w; }
    }
}
__device__ __forceinline__ void sk_ssdin(const Args& A, const bf16* Bt, const float* ss, const float* dtb, int c0) {
    SK_WAVE_IDS; const bf16* XB = (const bf16*)(A.ws + WS_XB); bf16* ZX = (bf16*)(A.ws + WS_ZX); float* DT = (float*)(A.ws + WS_DT);
    for (int task = gwp; task < 80 * 8; task += ngw) {
        const int it = task >> 3, rt = task & 7, row = MP + 16 * rt + r;
        const int nb[4] = {64 * it, 64 * it + 16, 64 * it + 32, 64 * it + 48};
        f32x4 acc[4]; wave_gemm<4>(acc, XB + (size_t)row * DM, Bt, nb, DM, r, c4);
        const float rs = RS_OF(ss, row);
#pragma unroll
        for (int nt = 0; nt < 4; ++nt) { const f32x4 v = acc[nt] * rs; v2u w; w.x = pk2(v[0], v[1]); w.y = pk2(v[2], v[3]); *(v2u*)(ZX + (size_t)row * ZXW + nb[nt] + 4 * c4) = w; }
    }
    for (int task = (gwp < (1 << 30)) ? (gwp + ngw - (640 % ngw)) % ngw : gwp; task < (MP + MS) / 16; task += ngw) {
        const int row = 16 * task + r;
        const int nb[2] = {5120, 5136};
        f32x4 acc[2]; wave_gemm<2>(acc, XB + (size_t)row * DM, Bt, nb, DM, r, c4);
        const float rs = RS_OF(ss, row);
#pragma unroll
        for (int nt = 0; nt < 2; ++nt) { f32x4 v = acc[nt] * rs + *(const f32x4*)(dtb + 16 * nt + 4 * c4);
#pragma unroll
            for (int j = 0; j < 4; ++j) v[j] = softplus_f(v[j]);
            *(f32x4*)(DT + (size_t)row * 32 + 16 * nt + 4 * c4) = v; }
    }
}
__device__ __forceinline__ void sk_swaqkv(const Args& A, const bf16* Bt, const float* ss, int c0) {
    SK_WAVE_IDS; const bf16* XB = (const bf16*)(A.ws + WS_XB); bf16* Q = (bf16*)(A.ws + WS_QS);
    for (int task = gwp; task < 36 * 8; task += ngw) {
        const int slot = task >> 3, rt = task & 7, row = MP + 16 * rt + r, pn = slot >> 2, wc = slot & 3, kind = slot / 12, head = slot - kind * 12;
        const int nb[4] = {256 * pn + 32 * wc, 256 * pn + 32 * wc + 16, 256 * pn + 128 + 32 * wc, 256 * pn + 128 + 32 * wc + 16};
        f32x4 acc[4]; wave_gemm<4>(acc, XB + (size_t)row * DM, Bt, nb, DM, r, c4);
        const float rs = RS_OF(ss, row); float q = 0.f;
#pragma unroll
        for (int nt = 0; nt < 4; ++nt) { acc[nt] = acc[nt] * rs; q += (acc[nt][0] * acc[nt][0] + acc[nt][1] * acc[nt][1]) + (acc[nt][2] * acc[nt][2] + acc[nt][3] * acc[nt][3]); }
        if (kind < 2) { q += __shfl_xor(q, 16); q += __shfl_xor(q, 32); const float rr = rsqrtf(q * (1.0f / 64.0f) + EPS); const float* nwp = (const float*)A.in[kind == 0 ? I_SWAQN : I_SWAKN];
#pragma unroll
            for (int nt = 0; nt < 4; ++nt) acc[nt] = acc[nt] * rr * *(const f32x4*)(nwp + 16 * nt + 4 * c4); }
        bf16* dst = Q + (size_t)kind * ((WS_KS - WS_QS) / 2) + (size_t)row * SWAW + head * 64;
#pragma unroll
        for (int nt = 0; nt < 4; ++nt) { v2u w; w.x = pk2(acc[nt][0], acc[nt][1]); w.y = pk2(acc[nt][2], acc[nt][3]); *(v2u*)(dst + 16 * nt + 4 * c4) = w; }
        if (kind >= 1) { const int g = head >> 2, j4 = head & 3, kv = kind - 1, keep = 128 << (2 * g), r2 = row - MP, b = r2 >> 2, tt = r2 & 3;
            const int obs = g == 0 ? O_KV0_S : (g == 1 ? O_KV1_S : O_KV2_S);
            float* o = A.out + obs + (size_t)(((b * keep + (keep - 4 + tt)) * 2 + kv) * 4 + j4) * 64;
#pragma unroll
            for (int nt = 0; nt < 4; ++nt) *(f32x4*)(o + 16 * nt + 4 * c4) = acc[nt]; }
    }
}
__device__ __forceinline__ void sk_diffqkv(const Args& A, const bf16* Bt, const float* ss, int c0) {
    SK_WAVE_IDS; const bf16* XB = (const bf16*)(A.ws + WS_XB);
    for (int task = gwp; task < 40 * 8; task += ngw) {
        const int slot = task >> 3, rt = task & 7, row = MP + 16 * rt + r, pn = slot >> 2, wc = slot & 3, kind = slot < 24 ? 0 : (slot < 32 ? 1 : 2);
        const int nb[4] = {256 * pn + 32 * wc, 256 * pn + 32 * wc + 16, 256 * pn + 128 + 32 * wc, 256 * pn + 128 + 32 * wc + 16};
        f32x4 acc[4]; wave_gemm<4>(acc, XB + (size_t)row * DM, Bt, nb, DM, r, c4);
        const float rs = RS_OF(ss, row); float q = 0.f;
#pragma unroll
        for (int nt = 0; nt < 4; ++nt) { acc[nt] = acc[nt] * rs; q += (acc[nt][0] * acc[nt][0] + acc[nt][1] * acc[nt][1]) + (acc[nt][2] * acc[nt][2] + acc[nt][3] * acc[nt][3]); }
        if (kind < 2) { q += __shfl_xor(q, 16); q += __shfl_xor(q, 32); const float rr = rsqrtf(q * (1.0f / 64.0f) + EPS); const float* nwp = (const float*)A.in[kind == 0 ? I_DQN : I_DKN];
#pragma unroll
            for (int nt = 0; nt < 4; ++nt) acc[nt] = acc[nt] * rr * *(const f32x4*)(nwp + 16 * nt + 4 * c4); }
        bf16* dst; int cofs;
        if (kind == 0) { dst = (bf16*)(A.ws + WS_QD) + (size_t)row * DQW; cofs = slot * 64; }
        else { dst = (bf16*)(A.ws + WS_KD) + (size_t)(kind - 1) * ((WS_VD - WS_KD) / 2) + (size_t)row * DKW; cofs = (slot - (kind == 1 ? 24 : 32)) * 64; }
#pragma unroll
        for (int nt = 0; nt < 4; ++nt) { v2u w; w.x = pk2(acc[nt][0], acc[nt][1]); w.y = pk2(acc[nt][2], acc[nt][3]); *(v2u*)(dst + cofs + 16 * nt + 4 * c4) = w; }
        if (kind >= 1) { float* o = A.out + (kind == 1 ? O_DK_S : O_DV_S) + (size_t)(row - MP) * 512 + cofs;
#pragma unroll
            for (int nt = 0; nt < 4; ++nt) *(f32x4*)(o + 16 * nt + 4 * c4) = acc[nt]; }
    }
}

__device__ __forceinline__ int conv_src_col(int n0, int Nsrc, int Ndst, int maptype) {
    if (maptype == 0) return (n0 < Nsrc) ? n0 : -1;
    const int pn = n0 >> 8, r = n0 & 255;
    if (maptype == 1) return (r >> 7) * (Ndst >> 1) + 128 * pn + (r & 127);
    return 256 * pn + 64 * ((r & 127) >> 5) + 32 * (r >> 7);
}
__device__ __forceinline__ void conv_item(const float* __restrict__ W, int K, int Nsrc, int Ndst, bf16* WT, const float* __restrict__ gain, int maptype, LAS float* scr, int item, int lane) {
    const int nblk = Ndst / 64;
    const int kr = lane >> 4, nc = lane & 15;
    {
        const int kb = item / nblk, nb = item - kb * nblk, k0 = 64 * kb, n0 = 64 * nb;
        const int srcb = conv_src_col(n0 + 32 * (nc >> 3), Nsrc, Ndst, maptype);
        f32x4 v[16];
#pragma unroll
        for (int i = 0; i < 16; ++i) { v[i] = (f32x4){0.f, 0.f, 0.f, 0.f};
            if (srcb >= 0) { v[i] = *(const f32x4*)(W + (size_t)(k0 + 4 * i + kr) * Nsrc + srcb + 4 * (nc & 7)); if (gain) v[i] = v[i] * gain[k0 + 4 * i + kr]; } }
#pragma unroll
        for (int hf = 0; hf < 2; ++hf) {
#pragma unroll
            for (int i = 0; i < 8; ++i) { LAS float* d = scr + (4 * i + kr) * 65 + 4 * nc; const f32x4 x = v[8 * hf + i]; d[0] = x[0]; d[1] = x[1]; d[2] = x[2]; d[3] = x[3]; }
            LDS_WAIT(); asm volatile("" ::: "memory");
#pragma unroll
            for (int j = 0; j < 4; ++j) { const int id = j * 64 + lane, n = id >> 2, c = id & 3; const LAS float* sp = scr + (8 * c) * 65 + n;
                v4u o; o.x = pk2(sp[0 * 65], sp[1 * 65]); o.y = pk2(sp[2 * 65], sp[3 * 65]); o.z = pk2(sp[4 * 65], sp[5 * 65]); o.w = pk2(sp[6 * 65], sp[7 * 65]);
                *(v4u*)(WT + (size_t)(n0 + n) * K + k0 + 32 * hf + 8 * c) = o; }
            LDS_WAIT(); asm volatile("" ::: "memory");
        }
    }
}

__device__ __forceinline__ void cache_copy_slice(const Args& A, int part, int nparts, int c0) {
    const int tid = threadIdx.x, lane = tid & 63, wave = __builtin_amdgcn_readfirstlane(tid >> 6);
    const int nidle = (int)gridDim.x - c0, blkp = ((int)blockIdx.x - c0 + (int)gridDim.x) % (int)gridDim.x;
    if (blkp >= nidle) return;
    constexpr int R0 = NBS * 124, R1 = NBS * 508, R2 = NBS * 2044, RT = R0 + R1 + R2;
    const int lo = (int)((long)RT * part / nparts), hi = (int)((long)RT * (part + 1) / nparts);
    const int gw = blkp * NWAVES + wave, ngw = nidle * NWAVES;
    for (int it0 = lo + 4 * gw; it0 < hi; it0 += 4 * ngw) {
        f32x4 v[4][2]; float* dstp[4];
#pragma unroll
        for (int q = 0; q < 4; ++q) { const int it = it0 + q; dstp[q] = nullptr;
            if (it < hi) { int g, r; if (it < R0) { g = 0; r = it; } else if (it < R0 + R1) { g = 1; r = it - R0; } else { g = 2; r = it - R0 - R1; }
                const int lb = 128 << (2 * g), per = lb - 4, b = r / per, i = r - b * per;
                const float* src = (const float*)A.in[I_SWA0 + g] + ((size_t)(b * lb + i + 4)) * 512;
                dstp[q] = A.out + (g == 0 ? O_KV0_S : (g == 1 ? O_KV1_S : O_KV2_S)) + ((size_t)(b * lb + i)) * 512;
                v[q][0] = ((const f32x4*)src)[lane]; v[q][1] = ((const f32x4*)src)[lane + 64]; } }
#pragma unroll
        for (int q = 0; q < 4; ++q) if (dstp[q]) { ((f32x4*)dstp[q])[lane] = v[q][0]; ((f32x4*)dstp[q])[lane + 64] = v[q][1]; }
    }
}

__device__ __forceinline__ void prologue_phase(const Args& A, LAS unsigned char* lds) {
    const int tid = threadIdx.x, lane = tid & 63, wave = __builtin_amdgcn_readfirstlane(tid >> 6);
    const int gw = blockIdx.x * NWAVES + wave, ngw = gridDim.x * NWAVES;
    LAS float* scr = (LAS float*)(lds + wave * 8448);
    unsigned char* ws = A.ws;
    {
        constexpr int I0 = 16 * 84, I1 = 32 * 16, I2 = 16 * 36, I3 = 12 * 16, I4 = 16 * 40, I5 = 24 * 16, I6 = 16 * 88, I7 = 44 * 16;
        constexpr int P1 = 2 * I0, P2 = P1 + 2 * I1, P3 = P2 + I2, P4 = P3 + I3, P5 = P4 + I4, P6 = P5 + I5, P7 = P6 + 4 * I6, PT = P7 + 4 * I7;
        for (int item = gw; item < PT; item += ngw) {
            const float* W; int K, Nsrc, Ndst, mt, li; bf16* WT; const float* gain;
            if (item < P1)      { const int i = item / I0; li = item - i * I0; W = (const float*)A.in[I_SSMWIN] + (size_t)i * DM * SSMN; K = DM; Nsrc = SSMN; Ndst = SSMNP; mt = 0; WT = (bf16*)(ws + WS_WSSDIN + i * al4k(SZ_WSSDIN)); gain = (const float*)A.in[I_NMIX] + (i == 0 ? 0 : 3) * DM; }
            else if (item < P2) { const int r = item - P1, i = r / I1; li = r - i * I1; W = (const float*)A.in[I_SSMWOUT] + (size_t)i * DIN * DM; K = DIN; Nsrc = DM; Ndst = DM; mt = 0; WT = (bf16*)(ws + WS_WSSDOUT + i * al4k(SZ_WSSDOUT)); gain = nullptr; }
            else if (item < P3) { li = item - P2; W = (const float*)A.in[I_SWAQKV]; K = DM; Nsrc = 2304; Ndst = 2304; mt = 2; WT = (bf16*)(ws + WS_WSWAQKV); gain = (const float*)A.in[I_NMIX] + 1 * DM; }
            else if (item < P4) { li = item - P3; W = (const float*)A.in[I_SWAOUT]; K = SWAW; Nsrc = DM; Ndst = DM; mt = 0; WT = (bf16*)(ws + WS_WSWAOUT); gain = nullptr; }
            else if (item < P5) { li = item - P4; W = (const float*)A.in[I_DQKV]; K = DM; Nsrc = 2560; Ndst = 2560; mt = 2; WT = (bf16*)(ws + WS_WDQKV); gain = (const float*)A.in[I_NMIX] + 2 * DM; }
            else if (item < P6) { li = item - P5; W = (const float*)A.in[I_DOUT]; K = DQW; Nsrc = DM; Ndst = DM; mt = 0; WT = (bf16*)(ws + WS_WDOUT); gain = nullptr; }
            else if (item < P7) { const int r = item - P6, l = r / I6; li = r - l * I6; W = (const float*)A.in[I_FFIN] + (size_t)l * DM * 2 * DFF; K = DM; Nsrc = 2 * DFF; Ndst = 2 * DFF; mt = 1; WT = (bf16*)(ws + WS_WFFIN + l * al4k(SZ_WFFIN)); gain = (const float*)A.in[I_NFFN] + l * DM; }
            else                { const int r = item - P7, l = r / I7; li = r - l * I7; W = (const float*)A.in[I_FFOUT] + (size_t)l * DFF * DM; K = DFF; Nsrc = DM; Ndst = DM; mt = 0; WT = (bf16*)(ws + WS_WFFOUT + l * al4k(SZ_WFFOUT)); gain = nullptr; }
            conv_item(W, K, Nsrc, Ndst, WT, gain, mt, scr, li, lane);
        }
    }
    {
        bf16* XB = (bf16*)(ws + WS_XB); float* ss0 = (float*)(ws + WS_SS);
        for (int m = gw; m < MPAD; m += ngw) {
            f32x4 v[4]; float s = 0.f;
            const float* src = m < MP ? (const float*)A.in[I_XP] + (size_t)m * DM : (const float*)A.in[I_XS] + (size_t)(m - MP) * DM;
#pragma unroll
            for (int j = 0; j < 4; ++j) { v[j] = (m < MTOK) ? ((const f32x4*)src)[lane + 64 * j] : (f32x4){0.f, 0.f, 0.f, 0.f}; s += (v[j][0] * v[j][0] + v[j][1] * v[j][1]) + (v[j][2] * v[j][2] + v[j][3] * v[j][3]); }
            s = wave_sum(s);
#pragma unroll
            for (int j = 0; j < 4; ++j) { v2u w; w.x = pk2(v[j][0], v[j][1]); w.y = pk2(v[j][2], v[j][3]); ((v2u*)(XB + (size_t)m * DM))[lane + 64 * j] = w; }
            if (lane < 16) ss0[(size_t)m * 16 + lane] = (lane == 0) ? s : 0.f;
        }
    }
}

__device__ __forceinline__ void ssd_prompt_unit(const Args& A, LAS unsigned char* lds, int li, int b, int h);
__device__ __forceinline__ void ssd_scan_phase(const Args& A, LAS unsigned char* lds, int li) {
    const int tid = threadIdx.x;
    unsigned char* ws = A.ws;
    const bf16* ZX = (const bf16*)(ws + WS_ZX); const float* DT = (const float*)(ws + WS_DT); bf16* YG = (bf16*)(ws + WS_YG);
    const float* convw = (const float*)A.in[I_CONVW] + li * 4 * CONVD; const float* convb = (const float*)A.in[I_CONVB] + li * CONVD;
    const float* alog = (const float*)A.in[I_ALOG] + li * 32; const float* dsk = (const float*)A.in[I_SSMD] + li * 32;
    const float* cst = (const float*)A.in[I_CONVST] + (size_t)li * NBS * 3 * CONVD;
    const float* sst = (const float*)A.in[I_SSMST] + (size_t)li * NBS * 32 * 8192;
    float* out = A.out;
    {
        int tg = tid; asm volatile("" : "+v"(tg)); const int gt = blockIdx.x * NTHR + tg, ngt = gridDim.x * NTHR;
        for (int e = gt; e < NBP * 3 * CONVD; e += ngt) { const int b = e / (3 * CONVD), r = e - b * 3 * CONVD, j = r / CONVD, ch = r - j * CONVD;
            out[O_CONV_P + li * (NBP * 3 * CONVD) + e] = bf2f(ZX[(size_t)(b * SEQ + SEQ - 3 + j) * ZXW + 2048 + ch]); }
        for (int e = gt; e < NBS * 3 * CONVD; e += ngt) { const int b = e / (3 * CONVD), r = e - b * 3 * CONVD, j = r / CONVD, ch = r - j * CONVD;
            out[O_CONV_S + li * (NBS * 3 * CONVD) + e] = bf2f(ZX[(size_t)(MP + b * 4 + 1 + j) * ZXW + 2048 + ch]); }
    }
    for (int rep = 0; rep < REP_SCANP; ++rep)
    for (int u = blockIdx.x; u < 256; u += gridDim.x) ssd_prompt_unit(A, lds, li, u >> 5, u & 31);
    {
        int tidS = tid; asm volatile("" : "+v"(tidS));
        const int lane = tidS & 63, wave = __builtin_amdgcn_readfirstlane(tidS >> 6), G = gridDim.x;
        LAS float* bc = (LAS float*)lds + wave * 1024;
        __syncthreads();
        for (int rep = 0; rep < REP_SCANS; ++rep)
        for (int task = wave * G + (int)blockIdx.x; task < NBS * 32; task += NWAVES * G) {
            const int b = task >> 5, h = task & 31, g = h >> 3, rb = MP + b * TS;
            f32x4 H[32];
            { const f32x4* sp = (const f32x4*)(sst + ((size_t)((b * 32 + h) * 64 + lane)) * 128);
#pragma unroll
              for (int q = 0; q < 32; ++q) H[q] = sp[q]; }
            float xv[4], zv[4], dtv[4];
            {
                int cch[5] = {h * 64 + lane, 2048 + g * 128 + lane, 2048 + g * 128 + 64 + lane, 2560 + g * 128 + lane, 2560 + g * 128 + 64 + lane};
#pragma unroll
                for (int ci = 0; ci < 5; ++ci) { const int cc = cch[ci];
                    float in[7];
#pragma unroll
                    for (int k = 0; k < 3; ++k) in[k] = cst[(size_t)(b * 3 + k) * CONVD + cc];
#pragma unroll
                    for (int k = 0; k < 4; ++k) in[3 + k] = bf2f(ZX[(size_t)(rb + k) * ZXW + 2048 + cc]);
                    const float w0 = convw[cc], w1 = convw[CONVD + cc], w2 = convw[2 * CONVD + cc], w3 = convw[3 * CONVD + cc], bs = convb[cc];
#pragma unroll
                    for (int tt = 0; tt < 4; ++tt) { const float v = silu_f(bs + w0 * in[tt] + w1 * in[tt + 1] + w2 * in[tt + 2] + w3 * in[tt + 3]);
                        if (ci == 0) xv[tt] = v; else bc[tt * 256 + (ci - 1) * 64 + lane] = v; }
                }
#pragma unroll
                for (int tt = 0; tt < 4; ++tt) { zv[tt] = bf2f(ZX[(size_t)(rb + tt) * ZXW + h * 64 + lane]); dtv[tt] = DT[(size_t)(rb + tt) * 32 + h]; }
            }
            LDS_WAIT(); __builtin_amdgcn_wave_barrier();
            const float a = -__expf(alog[h]), Dh = dsk[h];
#pragma unroll
            for (int tt = 0; tt < 4; ++tt) {
                const float dt = dtv[tt], dA = __expf(dt * a), dtx = dt * xv[tt];
                const LAS f32x4* Bp = (const LAS f32x4*)(bc + tt * 256); const LAS f32x4* Cp = Bp + 32;
                float y0 = 0.f, y1 = 0.f;
#pragma unroll
                for (int q = 0; q < 32; ++q) { const f32x4 bb = Bp[q], cq = Cp[q];
                    H[q] = H[q] * dA + bb * dtx;
                    y0 += cq[0] * H[q][0] + cq[1] * H[q][1]; y1 += cq[2] * H[q][2] + cq[3] * H[q][3]; }
                const float y = (y0 + y1) + Dh * xv[tt];
                YG[(size_t)(rb + tt) * DIN + h * 64 + lane] = (bf16)f2bf(y * silu_f(zv[tt]));
            }
            { f32x4* so = (f32x4*)(out + O_SSM_S + li * (NBS * 32 * 8192) + ((size_t)((b * 32 + h) * 64 + lane)) * 128);
#pragma unroll
              for (int q = 0; q < 32; ++q) so[q] = H[q]; }
            LDS_WAIT(); __builtin_amdgcn_wave_barrier();
        }
        __syncthreads();
    }
}

__device__ __forceinline__ int pi32_pos0(int tb8) { return ((tb8 >> 2) << 5) + 16 * (tb8 & 1) + 4 * ((tb8 >> 1) & 1); }
__device__ __forceinline__ void ssd_prepass_phase(const Args& A, LAS unsigned char* lds, int li) {
    int tid = threadIdx.x; asm volatile("" : "+v"(tid));
    const int lane = tid & 63, wave = __builtin_amdgcn_readfirstlane(tid >> 6);
    const int gw = blockIdx.x * NWAVES + wave, ngw = gridDim.x * NWAVES, gt = blockIdx.x * NTHR + tid, ngt = gridDim.x * NTHR;
    const bf16* ZX = (const bf16*)(A.ws + WS_ZX); const float* DT = (const float*)(A.ws + WS_DT);
    bf16* BC = (bf16*)(A.ws + WS_BC); bf16* BT = (bf16*)(A.ws + WS_BT); f32x4* SC = (f32x4*)(A.ws + WS_SC);
    const float* convw = (const float*)A.in[I_CONVW] + li * 4 * CONVD; const float* convb = (const float*)A.in[I_CONVB] + li * CONVD;
    const float* alog = (const float*)A.in[I_ALOG] + li * 32;
    for (int wt = blockIdx.x; wt < NBP * 32 * 2; wt += gridDim.x) {
        const int hc = wt & 1, tb4 = (wt >> 1) & 31, b = wt >> 6, ch = hc * 512 + tid, cc = 2048 + ch, t0 = tb4 * 64;
        const float w0 = convw[cc], w1 = convw[CONVD + cc], w2 = convw[2 * CONVD + cc], w3 = convw[3 * CONVD + cc], bs = convb[cc];
        unsigned raw[67];
#pragma unroll
        for (int k = 0; k < 67; ++k) { const int t = t0 - 3 + k; raw[k] = 0u; if (t >= 0) raw[k] = (unsigned)ZX[(size_t)(b * SEQ + t) * ZXW + 2048 + cc]; }
        unsigned op[32];
#pragma unroll
        for (int e = 0; e < 64; e += 2) {
            const float oa = silu_f(bs + w0 * bflo(raw[e]) + w1 * bflo(raw[e + 1]) + w2 * bflo(raw[e + 2]) + w3 * bflo(raw[e + 3]));
            const float ob = silu_f(bs + w0 * bflo(raw[e + 1]) + w1 * bflo(raw[e + 2]) + w2 * bflo(raw[e + 3]) + w3 * bflo(raw[e + 4]));
            BC[(size_t)(b * SEQ + t0 + e) * 1024 + ch] = (bf16)f2bf(oa); BC[(size_t)(b * SEQ + t0 + e + 1) * 1024 + ch] = (bf16)f2bf(ob);
            op[e >> 1] = pk2(oa, ob);
        }
        if (hc == 0) {
            LAS unsigned char* rowl = lds + tid * 144;
#pragma unroll
            for (int tb8 = 0; tb8 < 8; ++tb8) { const int p0 = ((tb8 >> 2) << 5) + 16 * (tb8 & 1) + 4 * ((tb8 >> 1) & 1);
                v2u a; a.x = op[4 * tb8]; a.y = op[4 * tb8 + 1]; v2u c2; c2.x = op[4 * tb8 + 2]; c2.y = op[4 * tb8 + 3];
                *(LAS v2u*)(rowl + p0 * 2) = a; *(LAS v2u*)(rowl + (p0 + 8) * 2) = c2; }
            __syncthreads();
#pragma unroll
            for (int j = 0; j < 8; ++j) { const int id = j * NTHR + tid, rw = id >> 3, c = id & 7;
                const v4u piece = *(const LAS v4u*)(lds + rw * 144 + c * 16);
                *(v4u*)(BT + (size_t)((b * 4 + (rw >> 7)) * 128 + (rw & 127)) * SEQ + t0 + c * 8) = piece; }
            __syncthreads();
        }
    }
    for (int task = gw; task < NBP * 32 * 32; task += ngw) {
        const int h = task & 31, ck = (task >> 5) & 31, b = task >> 10, row = b * SEQ + ck * 64 + lane;
        const float dt = DT[(size_t)row * 32 + h], a = -__expf(alog[h]);
        float x = dt * a;
#pragma unroll
        for (int o = 1; o < 64; o <<= 1) { const float y = __shfl_up(x, o); if (lane >= o) x += y; }
        const float tot = __shfl(x, 63);
        SC[(size_t)row * 32 + h] = (f32x4){x, dt, dt * __expf(tot - x), __expf(x)};
    }
}


namespace ssdk { constexpr int PX = 144, PC = 272;
    constexpr int XST = 0, XSW = XST + 64 * PX, CM = XSW + 64 * PX, BM = CM + 64 * PC, BMT = BM + 64 * PC, HB = BMT + 128 * PX, SCL = HB + 64 * PC; }
template <int NJ>
__device__ __forceinline__ void ssd_stage1(LAS unsigned char* lds, const pg8::bf16x8 (&cf)[4], const LAS float* cumL, const LAS float* dtL, int r, int c, float Dh, pg8::bf16x8 (&wf)[2]) {
    constexpr int it = NJ - 1;
    f32x4 g4[4];
#pragma unroll
    for (int jt = 0; jt < 4; ++jt) g4[jt] = (f32x4){0.f, 0.f, 0.f, 0.f};
#pragma unroll
    for (int kh = 0; kh < 2; ++kh) {
        pg8::bf16x8 bfr[NJ][2];
#pragma unroll
        for (int jt = 0; jt < NJ; ++jt)
#pragma unroll
            for (int k2 = 0; k2 < 2; ++k2) bfr[jt][k2] = *(const LAS pg8::bf16x8*)(lds + ssdk::BM + (16 * jt + r) * ssdk::PC + (32 * (2 * kh + k2) + 8 * c) * 2);
        __builtin_amdgcn_sched_barrier(0);
#pragma unroll
        for (int k2 = 0; k2 < 2; ++k2)
#pragma unroll
            for (int jt = 0; jt < NJ; ++jt) g4[jt] = __builtin_amdgcn_mfma_f32_16x16x32_bf16(bfr[jt][k2], cf[2 * kh + k2], g4[jt], 0, 0, 0);
        __builtin_amdgcn_sched_barrier(0);
    }
    f32x4 cj[NJ], dj[NJ];
#pragma unroll
    for (int jt = 0; jt < NJ; ++jt) { cj[jt] = *(const LAS f32x4*)(cumL + 16 * jt + 4 * c); dj[jt] = *(const LAS f32x4*)(dtL + 16 * jt + 4 * c); }
    const float ci = cumL[16 * it + r];
#pragma unroll
    for (int jt = 0; jt < NJ; ++jt)
#pragma unroll
        for (int q = 0; q < 4; ++q) {
            float wv = g4[jt][q] * __expf(ci - cj[jt][q]) * dj[jt][q];
            if (jt == it) { const int jl = 4 * c + q; wv = (jl <= r) ? wv : 0.f; if (jl == r) wv += Dh; }
            g4[jt][q] = wv; }
#pragma unroll
    for (int kk = 0; kk < 2; ++kk) { v4u w; w.x = pk2(g4[2 * kk][0], g4[2 * kk][1]); w.y = pk2(g4[2 * kk][2], g4[2 * kk][3]); w.z = pk2(g4[2 * kk + 1][0], g4[2 * kk + 1][1]); w.w = pk2(g4[2 * kk + 1][2], g4[2 * kk + 1][3]);
        wf[kk] = __builtin_bit_cast(pg8::bf16x8, w); }
}

__device__ __forceinline__ void ssd_prompt_unit(const Args& A, LAS unsigned char* lds, int li, int b, int h) {
    const int tid = threadIdx.x, lane = tid & 63, wave = __builtin_amdgcn_readfirstlane(tid >> 6);
    const int r = lane & 15, c = lane >> 4, it = (wave < 4) ? (wave >> 1) : 3 - ((wave - 4) >> 1), ph = wave & 1, g = h >> 3, rb = b * SEQ;
    using namespace ssdk;
    static_assert(SCL + 1024 <= RING_BYTES, "ssd LDS map");
    LAS float* cumL = (LAS float*)(lds + SCL); LAS float* dtL = cumL + 64; LAS float* ecL = cumL + 128;
    const bf16* ZX = (const bf16*)(A.ws + WS_ZX); const bf16* BC = (const bf16*)(A.ws + WS_BC); const bf16* BT = (const bf16*)(A.ws + WS_BT); const f32x4* SC = (const f32x4*)(A.ws + WS_SC);
    bf16* YG = (bf16*)(A.ws + WS_YG);
    const float* convw = (const float*)A.in[I_CONVW] + li * 4 * CONVD; const float* convb = (const float*)A.in[I_CONVB] + li * CONVD;
    const float Dh = ((const float*)A.in[I_SSMD])[li * 32 + h];
    const int xcc = h * 64 + lane;
    const float xw0 = convw[xcc], xw1 = convw[CONVD + xcc], xw2 = convw[2 * CONVD + xcc], xw3 = convw[3 * CONVD + xcc], xbs = convb[xcc];
    const int xpos = pi32_pos0(wave);
    const int crow = tid >> 4, cc16 = tid & 15, tn = tid >> 3, tc8 = tid & 7;
    const bf16* csrc = BC + (size_t)(rb + crow) * 1024 + 512 + g * 128 + cc16 * 8;
    const bf16* bsrc = BC + (size_t)(rb + crow) * 1024 + g * 128 + cc16 * 8;
    const bf16* tsrc = BT + (size_t)((b * 4 + g) * 128 + tn) * SEQ + tc8 * 8;
    const int cdst = crow * PC + cc16 * 16, tdst = tn * PX + tc8 * 16;
    f32x4 Ht[4];
#pragma unroll
    for (int i = 0; i < 4; ++i) Ht[i] = (f32x4){0.f, 0.f, 0.f, 0.f};
    struct SsdRegs { v4u pc0, pc1, pb0, pb1, pt0, pt1; f32x4 psc; unsigned xr[11]; float xwj[8]; v2u zz[2]; };
    SsdRegs R0;
    R0.psc = (f32x4){0.f, 0.f, 0.f, 0.f};
#define SSD_PREFETCH(R, ck) do { const size_t ro = (size_t)(ck) * 64 * 1024; \
        R.pc0 = *(const v4u*)(csrc + ro); R.pc1 = *(const v4u*)(csrc + ro + 32 * 1024); R.pb0 = *(const v4u*)(bsrc + ro); R.pb1 = *(const v4u*)(bsrc + ro + 32 * 1024); \
        R.pt0 = *(const v4u*)(tsrc + (ck) * 64); R.pt1 = *(const v4u*)(tsrc + (ck) * 64 + (size_t)64 * SEQ); \
        if (tid < 64) R.psc = SC[(size_t)(rb + (ck) * 64 + tid) * 32 + h]; \
        _Pragma("unroll") for (int k = 0; k < 11; ++k) { const int t = (ck) * 64 + 8 * wave - 3 + k; R.xr[k] = ZX[(size_t)(rb + (t < 0 ? 0 : t)) * ZXW + 2048 + xcc]; } \
        _Pragma("unroll") for (int e = 0; e < 8; ++e) R.xwj[e] = ((const float*)SC)[((size_t)(rb + (ck) * 64 + 8 * wave + e) * 32 + h) * 4 + 2]; \
        _Pragma("unroll") for (int pt = 0; pt < 2; ++pt) R.zz[pt] = *(const v2u*)(ZX + (size_t)(rb + (ck) * 64 + 16 * it + r) * ZXW + h * 64 + 32 * ph + 16 * pt + 4 * c); } while (0)
#define SSD_CHUNK(R, ck) do { \
        __syncthreads();                                              \
        _Pragma("unroll") for (int pt = 0; pt < 4; ++pt) { v2u w; w.x = pk2(Ht[pt][0], Ht[pt][1]); w.y = pk2(Ht[pt][2], Ht[pt][3]); *(LAS v2u*)(lds + HB + (16 * pt + r) * PC + (16 * wave + 4 * c) * 2) = w; } \
        *(LAS v4u*)(lds + CM + cdst) = R.pc0; *(LAS v4u*)(lds + CM + cdst + 32 * PC) = R.pc1; \
        *(LAS v4u*)(lds + BM + cdst) = R.pb0; *(LAS v4u*)(lds + BM + cdst + 32 * PC) = R.pb1; \
        *(LAS v4u*)(lds + BMT + tdst) = R.pt0; *(LAS v4u*)(lds + BMT + tdst + 64 * PX) = R.pt1; \
        if (tid < 64) { cumL[tid] = R.psc[0]; dtL[tid] = R.psc[1]; ecL[tid] = R.psc[3]; } \
        { float o[8]; \
            float xin[11]; \
            _Pragma("unroll") for (int k = 0; k < 11; ++k) xin[k] = ((ck) * 64 + 8 * wave - 3 + k >= 0) ? bflo(R.xr[k]) : 0.f; \
            _Pragma("unroll") for (int e = 0; e < 8; ++e) o[e] = silu_f(xbs + xw0 * xin[e] + xw1 * xin[e + 1] + xw2 * xin[e + 2] + xw3 * xin[e + 3]); \
            v2u a, a2, s1, s2; a.x = pk2(o[0], o[1]); a.y = pk2(o[2], o[3]); a2.x = pk2(o[4], o[5]); a2.y = pk2(o[6], o[7]); \
            s1.x = pk2(o[0] * R.xwj[0], o[1] * R.xwj[1]); s1.y = pk2(o[2] * R.xwj[2], o[3] * R.xwj[3]); s2.x = pk2(o[4] * R.xwj[4], o[5] * R.xwj[5]); s2.y = pk2(o[6] * R.xwj[6], o[7] * R.xwj[7]); \
            *(LAS v2u*)(lds + XST + lane * PX + xpos * 2) = a; *(LAS v2u*)(lds + XST + lane * PX + (xpos + 8) * 2) = a2; \
            *(LAS v2u*)(lds + XSW + lane * PX + xpos * 2) = s1; *(LAS v2u*)(lds + XSW + lane * PX + (xpos + 8) * 2) = s2; } \
        const v2u zc0 = R.zz[0], zc1 = R.zz[1]; \
        __syncthreads();                                              \
        const int tok = rb + (ck) * 64 + 16 * it + r; \
        if ((ck) + 1 < 32) SSD_PREFETCH(R, (ck) + 1); \
        pg8::bf16x8 cf[4]; \
        _Pragma("unroll") for (int ks = 0; ks < 4; ++ks) cf[ks] = *(const LAS pg8::bf16x8*)(lds + CM + (16 * it + r) * PC + (32 * ks + 8 * c) * 2); \
        pg8::bf16x8 wf[2]; \
        if (it == 0) ssd_stage1<1>(lds, cf, cumL, dtL, r, c, Dh, wf); else if (it == 1) ssd_stage1<2>(lds, cf, cumL, dtL, r, c, Dh, wf); \
        else if (it == 2) ssd_stage1<3>(lds, cf, cumL, dtL, r, c, Dh, wf); else ssd_stage1<4>(lds, cf, cumL, dtL, r, c, Dh, wf); \
          \
        pg8::bf16x8 hfr[2][4], xfr[2][2]; \
        _Pragma("unroll") for (int pt = 0; pt < 2; ++pt) { \
            _Pragma("unroll") for (int ks = 0; ks < 4; ++ks) hfr[pt][ks] = *(const LAS pg8::bf16x8*)(lds + HB + (32 * ph + 16 * pt + r) * PC + (32 * ks + 8 * c) * 2); \
            _Pragma("unroll") for (int kk = 0; kk < 2; ++kk) xfr[pt][kk] = *(const LAS pg8::bf16x8*)(lds + XST + (32 * ph + 16 * pt + r) * PX + (32 * kk + 8 * c) * 2); } \
        const float eci = ecL[16 * it + r], etot = ecL[63]; \
        __builtin_amdgcn_sched_barrier(0); \
        f32x4 yt[2]; yt[0] = (f32x4){0.f, 0.f, 0.f, 0.f}; yt[1] = yt[0]; \
        _Pragma("unroll") for (int ks = 0; ks < 4; ++ks) \
            _Pragma("unroll") for (int pt = 0; pt < 2; ++pt) yt[pt] = __builtin_amdgcn_mfma_f32_16x16x32_bf16(hfr[pt][ks], cf[ks], yt[pt], 0, 0, 0); \
        yt[0] = yt[0] * eci; yt[1] = yt[1] * eci; \
        _Pragma("unroll") for (int kk = 0; kk < 2; ++kk) \
            _Pragma("unroll") for (int pt = 0; pt < 2; ++pt) yt[pt] = __builtin_amdgcn_mfma_f32_16x16x32_bf16(xfr[pt][kk], wf[kk], yt[pt], 0, 0, 0); \
        _Pragma("unroll") for (int pt = 0; pt < 2; ++pt) { \
            const v2u zq = pt ? zc1 : zc0; \
            const float z0 = bflo(zq.x), z1 = bfhi(zq.x), z2 = bflo(zq.y), z3 = bfhi(zq.y); \
            v2u w; w.x = pk2(yt[pt][0] * silu_f(z0), yt[pt][1] * silu_f(z1)); w.y = pk2(yt[pt][2] * silu_f(z2), yt[pt][3] * silu_f(z3)); \
            *(v2u*)(YG + (size_t)tok * DIN + h * 64 + 32 * ph + 16 * pt + 4 * c) = w; } \
        __builtin_amdgcn_sched_barrier(0); \
          \
        pg8::bf16x8 tfr[2], sfr[2][4]; \
        _Pragma("unroll") for (int kk = 0; kk < 2; ++kk) { tfr[kk] = *(const LAS pg8::bf16x8*)(lds + BMT + (16 * wave + r) * PX + (32 * kk + 8 * c) * 2); \
            _Pragma("unroll") for (int pt = 0; pt < 4; ++pt) sfr[kk][pt] = *(const LAS pg8::bf16x8*)(lds + XSW + (16 * pt + r) * PX + (32 * kk + 8 * c) * 2); } \
        __builtin_amdgcn_sched_barrier(0); \
        _Pragma("unroll") for (int pt = 0; pt < 4; ++pt) Ht[pt] = Ht[pt] * etot; \
        _Pragma("unroll") for (int kk = 0; kk < 2; ++kk) \
            _Pragma("unroll") for (int pt = 0; pt < 4; ++pt) Ht[pt] = __builtin_amdgcn_mfma_f32_16x16x32_bf16(tfr[kk], sfr[kk][pt], Ht[pt], 0, 0, 0); \
    } while (0)
    SSD_PREFETCH(R0, 0);
#pragma unroll 1
    for (int ck = 0; ck < 32; ++ck) { SSD_CHUNK(R0, ck); }
#undef SSD_CHUNK
#undef SSD_PREFETCH
    int r2 = r, c2 = c; asm volatile("" : "+v"(r2), "+v"(c2));
    float* so = A.out + O_SSM_P + li * (NBP * 32 * 8192) + (size_t)((b * 32 + h) * 64) * 128;
#pragma unroll
    for (int pt = 0; pt < 4; ++pt) *(f32x4*)(so + (size_t)(16 * pt + r2) * 128 + 16 * wave + 4 * c2) = Ht[pt];
    __syncthreads();
}

__device__ __forceinline__ void ssd_gatenorm_phase(const Args& A, int li, bf16* YG) {
    const int tid = threadIdx.x, lane = tid & 63, wave = __builtin_amdgcn_readfirstlane(tid >> 6);
    const int gw = blockIdx.x * NWAVES + wave, ngw = gridDim.x * NWAVES;
    const float* nrm = (const float*)A.in[I_SSMNORM] + li * DIN;
    for (int r0 = gw; r0 < MTOK; r0 += 2 * ngw) {
      v4u w2[2][4];
#pragma unroll
      for (int rr = 0; rr < 2; ++rr) { const int row = r0 + rr * ngw;
#pragma unroll
        for (int g = 0; g < 4; ++g) w2[rr][g] = (row < MTOK) ? *(const v4u*)(YG + (size_t)row * DIN + g * 512 + lane * 8) : (v4u){0u, 0u, 0u, 0u}; }
#pragma unroll
      for (int rr = 0; rr < 2; ++rr) { const int row = r0 + rr * ngw; if (row >= MTOK) break;
        v4u w[4];
#pragma unroll
        for (int g = 0; g < 4; ++g) w[g] = w2[rr][g];
#pragma unroll
        for (int g = 0; g < 4; ++g) {
            float v[8] = {bflo(w[g].x), bfhi(w[g].x), bflo(w[g].y), bfhi(w[g].y), bflo(w[g].z), bfhi(w[g].z), bflo(w[g].w), bfhi(w[g].w)};
            float q = 0.f;
#pragma unroll
            for (int e = 0; e < 8; ++e) q += v[e] * v[e];
            q = wave_sum(q); const float r = rsqrtf(q * (1.0f / 512.0f) + EPS);
            const f32x4 n0 = *(const f32x4*)(nrm + g * 512 + lane * 8), n1 = *(const f32x4*)(nrm + g * 512 + lane * 8 + 4);
            v4u o; o.x = pk2(v[0] * r * n0[0], v[1] * r * n0[1]); o.y = pk2(v[2] * r * n0[2], v[3] * r * n0[3]); o.z = pk2(v[4] * r * n1[0], v[5] * r * n1[1]); o.w = pk2(v[6] * r * n1[2], v[7] * r * n1[3]);
            *(v4u*)(YG + (size_t)row * DIN + g * 512 + lane * 8) = o;
        }
      }
    }
}

__device__ __forceinline__ float dot64_bb(const v4u (&q)[8], const bf16* krow) {
    const v4u* kp = (const v4u*)krow; float acc = 0.f;
#pragma unroll
    for (int i = 0; i < 8; ++i) { const v4u k = kp[i];
        acc += bflo(q[i].x) * bflo(k.x) + bfhi(q[i].x) * bfhi(k.x) + bflo(q[i].y) * bflo(k.y) + bfhi(q[i].y) * bfhi(k.y)
             + bflo(q[i].z) * bflo(k.z) + bfhi(q[i].z) * bfhi(k.z) + bflo(q[i].w) * bflo(k.w) + bfhi(q[i].w) * bfhi(k.w); }
    return acc;
}
__device__ __forceinline__ float dot64_bf(const v4u (&q)[8], const float* krow) {
    const f32x4* kp = (const f32x4*)krow; float acc = 0.f;
#pragma unroll
    for (int i = 0; i < 8; ++i) { const f32x4 k0 = kp[2 * i], k1 = kp[2 * i + 1];
        acc += bflo(q[i].x) * k0[0] + bfhi(q[i].x) * k0[1] + bflo(q[i].y) * k0[2] + bfhi(q[i].y) * k0[3]
             + bflo(q[i].z) * k1[0] + bfhi(q[i].z) * k1[1] + bflo(q[i].w) * k1[2] + bfhi(q[i].w) * k1[3]; }
    return acc;
}


__device__ __forceinline__ void swa_prompt_mfma(const Args& A, LAS unsigned char* lds) {
    const int tid = threadIdx.x, lane = tid & 63, wave = __builtin_amdgcn_readfirstlane(tid >> 6);
    const int gw = blockIdx.x * NWAVES + wave, ngw = gridDim.x * NWAVES, l31 = lane & 31, hh = lane >> 5;
    LAS float* tab = (LAS float*)(lds + 8192);
    const bf16* QS = (const bf16*)(A.ws + WS_QS); const bf16* KS = (const bf16*)(A.ws + WS_KS); const bf16* VTS = (const bf16*)(A.ws + WS_VTS); bf16* AO = (bf16*)(A.ws + WS_AO);
    float* LSE = (float*)(A.ws + WS_LSE);
    const float* relb = (const float*)A.in[I_RELB];
    const float LOG2E = 1.4426950408889634f, c1 = 0.125f * LOG2E;
    __syncthreads();
    for (int e = tid; e < 12 * 129; e += NTHR) { const int head = e / 129, n = e - head * 129; tab[head * 132 + n] = relb[rel_bucket(n << (2 * (head >> 2))) * 12 + head] * LOG2E; }
    __syncthreads();
    for (int task = gw; task < NBP * 12 * 64; task += ngw) {
        const int blk = task & 63, bhd = task >> 6, head = bhd % 12, b = bhd / 12, g = head >> 2, lg = 2 * g;
        const int ncb = 64 >> lg, cls = blk / ncb, qb = blk - cls * ncb, ncls = SEQ >> lg;
        const int qpos = 32 * qb + l31, qtok = b * SEQ + (qpos << lg) + cls;
        pg8::bf16x8 qf[4];
#pragma unroll
        for (int ks = 0; ks < 4; ++ks) qf[ks] = *(const pg8::bf16x8*)(QS + (size_t)qtok * SWAW + head * 64 + 16 * ks + 8 * hh);
        f32x16 o[2];
#pragma unroll
        for (int i = 0; i < 2; ++i)
#pragma unroll
            for (int r = 0; r < 16; ++r) o[i][r] = 0.f;
        float m_run = -INFINITY, l_run = 0.f;
        const bf16* vbase = VTS + (size_t)((b * 12 + head) * 64 + l31) * SEQ + cls * ncls + 8 * hh;
        const LAS float* tb = tab + head * 132;
        const int kt0 = qb >= 4 ? qb - 4 : 0;
        pg8::bf16x8 kf[4], vf[2][2];
#define SWA_LOAD(kt) do { const int ktok = b * SEQ + ((32 * (kt) + l31) << lg) + cls; \
            _Pragma("unroll") for (int ks = 0; ks < 4; ++ks) kf[ks] = *(const pg8::bf16x8*)(KS + (size_t)ktok * SWAW + head * 64 + 16 * ks + 8 * hh); \
            _Pragma("unroll") for (int dvt = 0; dvt < 2; ++dvt) _Pragma("unroll") for (int s2 = 0; s2 < 2; ++s2) vf[dvt][s2] = *(const pg8::bf16x8*)(vbase + (size_t)(dvt * 32) * SEQ + 32 * (kt) + 16 * s2); } while (0)
        SWA_LOAD(kt0);
        for (int kt = kt0; kt <= qb; ++kt) {
            f32x16 S;
#pragma unroll
            for (int r = 0; r < 16; ++r) S[r] = 0.f;
#pragma unroll
            for (int ks = 0; ks < 4; ++ks) S = __builtin_amdgcn_mfma_f32_32x32x16_bf16(kf[ks], qf[ks], S, 0, 0, 0);
            pg8::bf16x8 vc[2][2];
#pragma unroll
            for (int dvt = 0; dvt < 2; ++dvt)
#pragma unroll
                for (int s2 = 0; s2 < 2; ++s2) vc[dvt][s2] = vf[dvt][s2];
            if (kt < qb) SWA_LOAD(kt + 1);
            float mx = -INFINITY;
            if (kt < qb && (kt > qb - 4)) {
                const LAS float* tq = tb + (qpos - 32 * kt - 4 * hh);
#pragma unroll
                for (int r = 0; r < 16; ++r) { const float x = S[r] * c1 + tq[-((r & 3) + 8 * (r >> 2))]; S[r] = x; mx = fmaxf(mx, x); }
            } else {
#pragma unroll
                for (int r = 0; r < 16; ++r) { const int kq = 32 * kt + (r & 3) + 8 * (r >> 2) + 4 * hh, n = qpos - kq; const bool ok = (n >= 0) && (n <= 128);
                    const float x = ok ? S[r] * c1 + tb[ok ? n : 0] : -INFINITY; S[r] = x; mx = fmaxf(mx, x); }
            }
            mx = fmaxf(mx, __shfl_xor(mx, 32));
            const float m_new = (mx > m_run + 8.0f) ? mx : m_run;
            const bool moved = __builtin_amdgcn_ballot_w64(m_new != m_run) != 0ull;
            const float alpha = __builtin_amdgcn_exp2f(m_run - m_new);
            float rs = 0.f;
#pragma unroll
            for (int r = 0; r < 16; ++r) { const float pv = __builtin_amdgcn_exp2f(S[r] - m_new); S[r] = pv; rs += pv; }
            rs += __shfl_xor(rs, 32);
            l_run = l_run * alpha + rs; m_run = m_new;
            if (moved) {
#pragma unroll
                for (int i = 0; i < 2; ++i)
#pragma unroll
                    for (int r = 0; r < 16; ++r) o[i][r] *= alpha;
            }
#pragma unroll
            for (int s2 = 0; s2 < 2; ++s2) { const int r0 = 8 * s2;
                v4u w; w.x = pk2(S[r0], S[r0 + 1]); w.y = pk2(S[r0 + 2], S[r0 + 3]); w.z = pk2(S[r0 + 4], S[r0 + 5]); w.w = pk2(S[r0 + 6], S[r0 + 7]);
                const pg8::bf16x8 pf = __builtin_bit_cast(pg8::bf16x8, w);
#pragma unroll
                for (int dvt = 0; dvt < 2; ++dvt) o[dvt] = __builtin_amdgcn_mfma_f32_32x32x16_bf16(vc[dvt][s2], pf, o[dvt], 0, 0, 0); }
        }
#undef SWA_LOAD
        const float inv = 1.0f / l_run;
        bf16* orow = AO + (size_t)qtok * SWAW + head * 64;
#pragma unroll
        for (int i = 0; i < 2; ++i)
#pragma unroll
            for (int q4 = 0; q4 < 4; ++q4) { v2u w; w.x = pk2(o[i][4 * q4] * inv, o[i][4 * q4 + 1] * inv); w.y = pk2(o[i][4 * q4 + 2] * inv, o[i][4 * q4 + 3] * inv);
                *(v2u*)(orow + i * 32 + 8 * q4 + 4 * hh) = w; }
        if (hh == 0) LSE[(size_t)qtok * 12 + head] = (m_run + log2f(l_run)) * 0.6931471805599453f;
    }
    __syncthreads();
}

__device__ __forceinline__ void swa_combine_phase(const Args& A) {
    int tg = threadIdx.x; asm volatile("" : "+v"(tg)); const int gt = blockIdx.x * NTHR + tg, ngt = gridDim.x * NTHR;
    bf16* AO = (bf16*)(A.ws + WS_AO); const float* LSE = (const float*)(A.ws + WS_LSE);
    for (int task0 = gt; task0 < MP * 12 * 8; task0 += 4 * ngt) {
        v4u w[4]; float l0[4], l1[4], l2[4]; v4u* ptr[4]; int gq[4];
#pragma unroll
        for (int q = 0; q < 4; ++q) { const int task = task0 + q * ngt; ptr[q] = nullptr;
            if (task < MP * 12 * 8) { const int ch = task & 7, head = (task >> 3) % 12, tok = task / 96, j = head & 3; gq[q] = head >> 2;
                l0[q] = LSE[(size_t)tok * 12 + j]; l1[q] = LSE[(size_t)tok * 12 + 4 + j]; l2[q] = LSE[(size_t)tok * 12 + 8 + j];
                ptr[q] = (v4u*)(AO + (size_t)tok * SWAW + head * 64 + ch * 8); w[q] = *ptr[q]; } }
#pragma unroll
        for (int q = 0; q < 4; ++q) if (ptr[q]) {
            const float mm = fmaxf(fmaxf(l0[q], l1[q]), l2[q]), a0 = __expf(l0[q] - mm), a1 = __expf(l1[q] - mm), a2 = __expf(l2[q] - mm);
            const float al = (gq[q] == 0 ? a0 : (gq[q] == 1 ? a1 : a2)) * __builtin_amdgcn_rcpf(a0 + a1 + a2);
            v4u o; o.x = pk2(bflo(w[q].x) * al, bfhi(w[q].x) * al); o.y = pk2(bflo(w[q].y) * al, bfhi(w[q].y) * al); o.z = pk2(bflo(w[q].z) * al, bfhi(w[q].z) * al); o.w = pk2(bflo(w[q].w) * al, bfhi(w[q].w) * al);
            *ptr[q] = o; }
    }
}

__device__ __forceinline__ void swa_attn_phase(const Args& A, LAS unsigned char* lds) {
    const int tid = threadIdx.x, lane = tid & 63, wave = __builtin_amdgcn_readfirstlane(tid >> 6);
    const int gw = blockIdx.x * NWAVES + wave, ngw = gridDim.x * NWAVES;
    LAS float* pw = (LAS float*)lds + wave * 192;
    const bf16* QS = (const bf16*)(A.ws + WS_QS); const bf16* KS = (const bf16*)(A.ws + WS_KS); const bf16* VS = (const bf16*)(A.ws + WS_VS); bf16* AO = (bf16*)(A.ws + WS_AO);
    const float* relb = (const float*)A.in[I_RELB];
    swa_prompt_mfma(A, lds);
    constexpr int VPIT = 68;
    LAS float* vb = (LAS float*)(lds + 16384) + (wave < 3 ? wave : 0) * (129 * VPIT + 64);
    static_assert(16384 + 3 * (129 * VPIT + 64) * 4 <= RING_BYTES, "swa sample LDS map");
    const int G = gridDim.x;
    for (int task = (wave < 3) ? wave * G + (int)blockIdx.x : (1 << 30); task < MS * 4; task += 3 * G) {
        const int r = MP + (task >> 2), j = task & 3, b = (r - MP) >> 2, t = (r - MP) & 3;
        float og[3], lseg[3];
#pragma unroll
        for (int g = 0; g < 3; ++g) {
            const int head = g * 4 + j, dil = 1 << (2 * g), lb = 128 << (2 * g);
            const float* cache = (const float*)A.in[I_SWA0 + g];
            v4u qv[8];
#pragma unroll
            for (int i = 0; i < 8; ++i) qv[i] = ((const v4u*)(QS + (size_t)r * SWAW + head * 64))[i];
            float s[3];
#pragma unroll
            for (int kk = 0; kk < 3; ++kk) {
                const int n = lane + 64 * kk; float sc = -INFINITY;
                if (n <= 128) { const int idx = lb + t - n * dil; float d;
                    if (idx >= lb) d = dot64_bb(qv, KS + (size_t)(MP + b * 4 + idx - lb) * SWAW + head * 64);
                    else d = dot64_bf(qv, cache + ((size_t)((b * lb + idx) * 2 + 0) * 4 + j) * 64);
                    sc = d * 0.125f + relb[rel_bucket(n * dil) * 12 + head]; }
                s[kk] = sc;
            }
            const float mx = wave_max(fmaxf(fmaxf(s[0], s[1]), s[2]));
            float e[3];
#pragma unroll
            for (int kk = 0; kk < 3; ++kk) e[kk] = (s[kk] == -INFINITY) ? 0.f : __expf(s[kk] - mx);
            const float sum = wave_sum(e[0] + e[1] + e[2]), inv = 1.0f / sum;
            lseg[g] = mx + __logf(sum);
#pragma unroll
            for (int kk = 0; kk < 3; ++kk) {
                const int n = lane + 64 * kk;
                if (n <= 128) { const int idx = lb + t - n * dil; const float pn = e[kk] * inv; LAS f32x4* dst = (LAS f32x4*)(vb + n * VPIT);
                    if (idx >= lb) { const v4u* vp = (const v4u*)(VS + (size_t)(MP + b * 4 + idx - lb) * SWAW + head * 64);
#pragma unroll
                        for (int i = 0; i < 8; ++i) { const v4u w = vp[i]; dst[2 * i] = (f32x4){bflo(w.x) * pn, bfhi(w.x) * pn, bflo(w.y) * pn, bfhi(w.y) * pn}; dst[2 * i + 1] = (f32x4){bflo(w.z) * pn, bfhi(w.z) * pn, bflo(w.w) * pn, bfhi(w.w) * pn}; } }
                    else { const f32x4* vp = (const f32x4*)(cache + ((size_t)((b * lb + idx) * 2 + 1) * 4 + j) * 64);
#pragma unroll
                        for (int i = 0; i < 16; ++i) dst[i] = vp[i] * pn; } }
            }
            LDS_WAIT(); __builtin_amdgcn_wave_barrier();
            float o = 0.f;
#pragma unroll 43
            for (int n = 0; n <= 128; ++n) o += vb[n * VPIT + lane];
            og[g] = o;
            LDS_WAIT(); __builtin_amdgcn_wave_barrier();
        }
        const float mm = fmaxf(fmaxf(lseg[0], lseg[1]), lseg[2]);
        const float a0 = __expf(lseg[0] - mm), a1 = __expf(lseg[1] - mm), a2 = __expf(lseg[2] - mm), inv = 1.0f / (a0 + a1 + a2);
        AO[(size_t)r * SWAW + (0 * 4 + j) * 64 + lane] = (bf16)f2bf(og[0] * a0 * inv);
        AO[(size_t)r * SWAW + (1 * 4 + j) * 64 + lane] = (bf16)f2bf(og[1] * a1 * inv);
        AO[(size_t)r * SWAW + (2 * 4 + j) * 64 + lane] = (bf16)f2bf(og[2] * a2 * inv);
    }
}

__device__ __forceinline__ float diff_lambda(const float* lp, int lane, float lam_init) {
    const float s1 = wave_sum(lp[lane] * lp[64 + lane]), s2 = wave_sum(lp[128 + lane] * lp[192 + lane]);
    return __expf(s1) - __expf(s2) + lam_init;
}

__device__ __forceinline__ void diff_attn_prompt_phase(const Args& A, LAS unsigned char* lds, float lam_init) {
    const int tid = threadIdx.x, lane = tid & 63, wave = __builtin_amdgcn_readfirstlane(tid >> 6);
    const int gw = blockIdx.x * NWAVES + wave, ngw = gridDim.x * NWAVES;
    LAS float* pw = (LAS float*)lds + wave * 128;
    const bf16* QD = (const bf16*)(A.ws + WS_QD); const bf16* KD = (const bf16*)(A.ws + WS_KD); const bf16* VD = (const bf16*)(A.ws + WS_VD); bf16* AOD = (bf16*)(A.ws + WS_AOD);
    const float* relb = (const float*)A.in[I_RELB]; const float* onorm = (const float*)A.in[I_DON];
    const float lam = diff_lambda((const float*)A.in[I_DLAM], lane, lam_init);
    const float on0 = onorm[2 * lane], on1 = onorm[2 * lane + 1];
    for (int it = gw; it < NBP * 12 * SEQ; it += ngw) {
        const int hb = it % 96, i = it / 96; const int b = hb / 12, h = hb - b * 12, g = h / 3;
        const int row = b * SEQ + i;
        v4u q0[8], q1[8];
#pragma unroll
        for (int k = 0; k < 8; ++k) { q0[k] = ((const v4u*)(QD + (size_t)row * DQW + (h * 2 + 0) * 64))[k]; q1[k] = ((const v4u*)(QD + (size_t)row * DQW + (h * 2 + 1) * 64))[k]; }
        float m0 = -INFINITY, m1 = -INFINITY, l0 = 0.f, l1 = 0.f, o00 = 0.f, o01 = 0.f, o10 = 0.f, o11 = 0.f;
#pragma unroll 1
        for (int jb = 0; jb <= (i >> 6); ++jb) {
            const int jj = jb * 64 + lane; float s0 = -INFINITY, s1 = -INFINITY;
            if (jj <= i) { const bf16* krow = KD + (size_t)(b * SEQ + jj) * DKW + g * 128; const float bias = relb[rel_bucket(i - jj) * 12 + h];
                s0 = dot64_bb(q0, krow) * 0.125f + bias; s1 = dot64_bb(q1, krow + 64) * 0.125f + bias; }
            const float mn0 = fmaxf(m0, wave_max(s0)), mn1 = fmaxf(m1, wave_max(s1));
            const float c0 = __expf(m0 - mn0), c1 = __expf(m1 - mn1);
            const float p0 = (jj <= i) ? __expf(s0 - mn0) : 0.f, p1 = (jj <= i) ? __expf(s1 - mn1) : 0.f;
            l0 = l0 * c0 + wave_sum(p0); l1 = l1 * c1 + wave_sum(p1);
            o00 *= c0; o01 *= c0; o10 *= c1; o11 *= c1; m0 = mn0; m1 = mn1;
            pw[lane] = p0; pw[64 + lane] = p1;
            LDS_WAIT(); __builtin_amdgcn_wave_barrier();
            const int nv = (i - jb * 64 + 1) < 64 ? (i - jb * 64 + 1) : 64;
#pragma unroll 4
            for (int k = 0; k < nv; ++k) { const float pp0 = pw[k], pp1 = pw[64 + k];
                const unsigned vv = *(const unsigned*)(VD + (size_t)(b * SEQ + jb * 64 + k) * DKW + g * 128 + 2 * lane);
                const float v0 = bflo(vv), v1 = bfhi(vv);
                o00 += pp0 * v0; o01 += pp0 * v1; o10 += pp1 * v0; o11 += pp1 * v1; }
            LDS_WAIT(); __builtin_amdgcn_wave_barrier();
        }
        const float i0 = 1.0f / l0, i1 = 1.0f / l1;
        const float a0 = o00 * i0 - lam * o10 * i1, a1 = o01 * i0 - lam * o11 * i1;
        const float ssq = wave_sum(a0 * a0 + a1 * a1), rr = rsqrtf(ssq * (1.0f / 128.0f) + EPS) * (1.0f - lam_init);
        *(unsigned*)(AOD + (size_t)row * DQW + h * 128 + 2 * lane) = pk2(a0 * rr * on0, a1 * rr * on1);
    }
}

__device__ __forceinline__ void diff_attn_prompt_mfma(const Args& A, LAS unsigned char* lds, float lam_init, int cidx, int ncu) {
    const int tid = threadIdx.x, lane = tid & 63, wave = __builtin_amdgcn_readfirstlane(tid >> 6);
    const int l31 = lane & 31, hh = lane >> 5, rg = wave >> 1, m = wave & 1;
    constexpr int KPITCH = 272, VPITCH = 144, KT_BYTES = 64 * KPITCH, VT_BYTES = 128 * VPITCH, BUF_BYTES = KT_BYTES + VT_BYTES;
    constexpr int VB_OFF = 2 * KT_BYTES;
    constexpr int L1_OFF = 2 * KT_BYTES + 3 * VT_BYTES;
    constexpr int CP_OFF = L1_OFF + 1024, CP_STRIDE = 2208;
    static_assert(CP_OFF + 4 * CP_STRIDE * 4 <= RING_BYTES, "diff attention LDS map");
    LAS float* cpy = (LAS float*)(lds + CP_OFF);
    LAS float* ex = (LAS float*)lds;
    LAS float* exl = (LAS float*)(lds + L1_OFF);
    const bf16* QD = (const bf16*)(A.ws + WS_QD); const bf16* KD = (const bf16*)(A.ws + WS_KD); const bf16* VTD = (const bf16*)(A.ws + WS_VTD); bf16* AOD = (bf16*)(A.ws + WS_AOD);
    const float* relb = (const float*)A.in[I_RELB]; const float* onorm = (const float*)A.in[I_DON];
    const float lam = diff_lambda((const float*)A.in[I_DLAM], lane, lam_init);
    const float LOG2E = 1.4426950408889634f, c1 = 0.125f * LOG2E;
    const int c = cidx, Gd = ncu;
    for (int ui = 0; ; ++ui) {
        const int rnd = ui, base = rnd * Gd; const int k = (rnd & 1) ? base + (Gd - 1 - c) : base + c;
        if (base >= 1536) break;
        __syncthreads();
        if (k < 1536) {
        const int qblk = 15 - k / 96, bh = k % 96, b = bh / 12, h = bh - b * 12, g = h / 3;
        for (int i = tid; i < 2176; i += NTHR) { const int d = 2048 - i; cpy[i] = (d >= 0 && d < 2048) ? relb[rel_bucket(d) * 12 + h] * 8.0f : 0.f; }
        __syncthreads();
        for (int n = tid; n < 3 * 2176; n += NTHR) { const int sc = 1 + n / 2176, i = n - (sc - 1) * 2176; cpy[sc * CP_STRIDE + i] = (i >= sc) ? cpy[i - sc] : 0.f; }
        const int q_abs = qblk * 128 + rg * 32 + l31, row = b * SEQ + q_abs;
        pg8::bf16x8 qf[4];
#pragma unroll
        for (int ks = 0; ks < 4; ++ks) qf[ks] = *(const pg8::bf16x8*)(QD + (size_t)row * DQW + (h * 2 + m) * 64 + 16 * ks + 8 * hh);
        f32x16 o[4];
#pragma unroll
        for (int i = 0; i < 4; ++i)
#pragma unroll
            for (int r = 0; r < 16; ++r) o[i][r] = 0.f;
        float m_run = -INFINITY, l_run = 0.f;
        const float THRU = 8.0f / c1;
        const LAS float* cb = cpy + (l31 & 3) * CP_STRIDE + ((l31 & 3) + 2048 - q_abs + 4 * hh);
        const int ntiles = 2 * qblk + 2, my_last = 2 * qblk + (rg >> 1);
        const int kkey = tid >> 4, kc = tid & 15, vdv = tid >> 3, vc = tid & 7;
        const char* ksrc = (const char*)(KD + (size_t)(b * SEQ) * DKW + g * 128);
        const char* vsrc = (const char*)(VTD + (size_t)((b * 4 + g) * 128) * SEQ);
        const unsigned koff = (unsigned)((kkey * DKW + kc * 8) * 2), voff = (unsigned)((vdv * SEQ + vc * 8) * 2);
        const int kdst = kkey * KPITCH + kc * 16, vdst = VB_OFF + vdv * VPITCH + vc * 16;
        v4u sa0, sa1, sa2, sa3;
#define DA_LOAD(R0, R1, R2, R3, t) do { const char* ks2 = ksrc + (size_t)(t) * 64 * DKW * 2; const char* vs2 = vsrc + (t) * 128; \
            R0 = *(const v4u*)(ks2 + koff); R1 = *(const v4u*)(ks2 + (size_t)32 * DKW * 2 + koff); R2 = *(const v4u*)(vs2 + voff); R3 = *(const v4u*)(vs2 + (size_t)64 * SEQ * 2 + voff); } while (0)
#define DA_STORE(R0, R1, R2, R3, t, vo) do { LAS unsigned char* nk = lds + ((t) & 1) * KT_BYTES + kdst; LAS unsigned char* nv = lds + (vo) + vdst; \
            *(LAS v4u*)(nk) = R0; *(LAS v4u*)(nk + 32 * KPITCH) = R1; *(LAS v4u*)(nv) = R2; *(LAS v4u*)(nv + 64 * VPITCH) = R3; } while (0)
#define DA_PV(vo) do { LAS unsigned char* Vb = lds + VB_OFF + (vo); \
_Pragma("unroll") \
            for (int kk = 0; kk < 4; ++kk) \
_Pragma("unroll") \
                for (int dvt = 0; dvt < 4; ++dvt) { const pg8::bf16x8 a = *(const LAS pg8::bf16x8*)(Vb + (dvt * 32 + l31) * VPITCH + kk * 32 + hh * 16); \
                    o[dvt] = __builtin_amdgcn_mfma_f32_32x32x16_bf16(a, pfp[kk], o[dvt], 0, 0, 0); } \
        } while (0)
#define DA_COMPUTE(kt) do { \
                LAS unsigned char* Kb = lds + (kt & 1) * KT_BYTES; \
                const bool offdiag = kt * 64 + 63 <= qblk * 128 + rg * 32; \
                f32x16 S[2]; \
                if (offdiag) { \
                    const LAS float* cq = cb + kt * 64; \
_Pragma("unroll") \
                    for (int sub = 0; sub < 2; ++sub) \
_Pragma("unroll") \
                        for (int j = 0; j < 4; ++j) { const f32x4 t4 = *(const LAS f32x4*)(cq + sub * 32 + 8 * j); \
                            S[sub][4 * j] = t4[0]; S[sub][4 * j + 1] = t4[1]; S[sub][4 * j + 2] = t4[2]; S[sub][4 * j + 3] = t4[3]; } \
                } else { \
_Pragma("unroll") \
                    for (int sub = 0; sub < 2; ++sub) \
_Pragma("unroll") \
                        for (int r = 0; r < 16; ++r) S[sub][r] = 0.f; \
                } \
_Pragma("unroll") \
                for (int ks = 0; ks < 4; ++ks) \
_Pragma("unroll") \
                    for (int sub = 0; sub < 2; ++sub) { const pg8::bf16x8 a = *(const LAS pg8::bf16x8*)(Kb + (sub * 32 + l31) * KPITCH + m * 128 + ks * 32 + hh * 16); \
                        S[sub] = __builtin_amdgcn_mfma_f32_32x32x16_bf16(a, qf[ks], S[sub], 0, 0, 0); } \
                if (!offdiag) { \
_Pragma("unroll") \
                    for (int sub = 0; sub < 2; ++sub) \
_Pragma("unroll") \
                        for (int r = 0; r < 16; ++r) { const int key = kt * 64 + sub * 32 + (r & 3) + 8 * (r >> 2) + 4 * hh; const int d = q_abs - key; \
                            const float x = S[sub][r] + cpy[2048 - (d < 0 ? 0 : d)]; S[sub][r] = d < 0 ? -INFINITY : x; } \
                } \
                  \
                float mx0 = -INFINITY, mx1 = -INFINITY; \
_Pragma("unroll") \
                for (int r = 0; r < 16; ++r) { mx0 = fmaxf(mx0, S[0][r]); mx1 = fmaxf(mx1, S[1][r]); } \
                float mx = fmaxf(mx0, mx1); \
                mx = fmaxf(mx, __shfl_xor(mx, 32)); \
                const float m_new = (mx > m_run + THRU) ? mx : m_run; \
                const bool moved = __builtin_amdgcn_ballot_w64(m_new != m_run) != 0ull; \
                const float alpha = __builtin_amdgcn_exp2f((m_run - m_new) * c1); \
                const float nmc = -m_new * c1; \
                DA_PV(vo_prev); \
                float rs0 = 0.f, rs1 = 0.f; \
_Pragma("unroll") \
                for (int r = 0; r < 16; ++r) { const float p0 = __builtin_amdgcn_exp2f(__builtin_fmaf(S[0][r], c1, nmc)); S[0][r] = p0; rs0 += p0; \
                    const float p1 = __builtin_amdgcn_exp2f(__builtin_fmaf(S[1][r], c1, nmc)); S[1][r] = p1; rs1 += p1; } \
                float rs = rs0 + rs1; \
                rs += __shfl_xor(rs, 32); \
                l_run = l_run * alpha + rs; m_run = m_new; \
_Pragma("unroll") \
                for (int kk = 0; kk < 4; ++kk) { const int sub = kk >> 1, r0 = (kk & 1) * 8; \
                    v4u w; w.x = pk2(S[sub][r0], S[sub][r0 + 1]); w.y = pk2(S[sub][r0 + 2], S[sub][r0 + 3]); w.z = pk2(S[sub][r0 + 4], S[sub][r0 + 5]); w.w = pk2(S[sub][r0 + 6], S[sub][r0 + 7]); \
                    pfp[kk] = __builtin_bit_cast(pg8::bf16x8, w); } \
                if (moved) { \
_Pragma("unroll") \
                    for (int i = 0; i < 4; ++i) \
_Pragma("unroll") \
                        for (int r = 0; r < 16; ++r) o[i][r] *= alpha; \
                } \
        } while (0)
        pg8::bf16x8 pfp[4];
#pragma unroll
        for (int kk = 0; kk < 4; ++kk) pfp[kk] = __builtin_bit_cast(pg8::bf16x8, v4u{0u, 0u, 0u, 0u});
        int vo_prev = 0, vo_cur = 0, vo_next = VT_BYTES, vo_free = 2 * VT_BYTES;
        DA_LOAD(sa0, sa1, sa2, sa3, 0); DA_STORE(sa0, sa1, sa2, sa3, 0, 0);
        __syncthreads();
#pragma unroll 1
        for (int kt = 0; kt < ntiles; ++kt) {
            if (kt + 1 < ntiles) DA_LOAD(sa0, sa1, sa2, sa3, kt + 1);
            DA_COMPUTE(kt);
            if (kt + 1 < ntiles) DA_STORE(sa0, sa1, sa2, sa3, kt + 1, vo_next);
            { const int t = (kt == 0) ? vo_free : vo_prev; vo_prev = vo_cur; vo_cur = vo_next; vo_next = t; }
            __syncthreads();
        }
        DA_PV(vo_prev);
        __syncthreads();
#undef DA_PV
#undef DA_COMPUTE
#undef DA_LOAD
#undef DA_STORE
        const float inv_l = 1.0f / l_run;
        if (m == 1) {
#pragma unroll
            for (int i = 0; i < 4; ++i)
#pragma unroll
                for (int r = 0; r < 16; ++r) ex[(rg * 64 + i * 16 + r) * 64 + lane] = o[i][r] * inv_l;
        }
        __syncthreads();
        if (m == 0) {
            float ssq = 0.f; float lam2 = lam; asm volatile("" : "+v"(lam2));
#pragma unroll
            for (int i = 0; i < 4; ++i)
#pragma unroll
                for (int r = 0; r < 16; ++r) { const float a = o[i][r] * inv_l - lam2 * ex[(rg * 64 + i * 16 + r) * 64 + lane]; o[i][r] = a; ssq += a * a; }
            ssq += __shfl_xor(ssq, 32);
            const float rr = rsqrtf(ssq * (1.0f / 128.0f) + EPS) * (1.0f - lam_init);
            int hh4 = 4 * hh; asm volatile("" : "+v"(hh4)); const float* onb = onorm + hh4; bf16* orow = AOD + (size_t)row * DQW + h * 128 + hh4;
#pragma unroll
            for (int i = 0; i < 4; ++i)
#pragma unroll
                for (int q4 = 0; q4 < 4; ++q4) { const int dv0 = i * 32 + 8 * q4; const f32x4 on = *(const f32x4*)(onb + dv0);
                    v2u w; w.x = pk2(o[i][4 * q4] * rr * on[0], o[i][4 * q4 + 1] * rr * on[1]); w.y = pk2(o[i][4 * q4 + 2] * rr * on[2], o[i][4 * q4 + 3] * rr * on[3]);
                    *(v2u*)(orow + dv0) = w; }
        }
        }
    }
    __syncthreads();
    (void)exl;
}

__device__ __forceinline__ void diff_sample_partial_phase(const Args& A, LAS unsigned char* lds) {
    const int tid = threadIdx.x, lane = tid & 63, wave = __builtin_amdgcn_readfirstlane(tid >> 6);
    LAS float* qs = (LAS float*)lds;
    LAS float* sc = qs + 24 * 64;
    LAS float* ml = sc + 1024 * 24;
    LAS int* pg = (LAS int*)(ml + 32);
    const bf16* QD = (const bf16*)(A.ws + WS_QD); float* PART = (float*)(A.ws + WS_PART);
    const float* ck = (const float*)A.in[I_DCK]; const float* cv = (const float*)A.in[I_DCV]; const int* pt = (const int*)A.in[I_PT];
    const float* relb = (const float*)A.in[I_RELB];
    for (int u = blockIdx.x; u < 1024; u += gridDim.x) {
        const int b = u >> 5, g = (u >> 3) & 3, c = u & 7;
        __syncthreads();
        for (int e = tid; e < 24 * 64; e += NTHR) { const int qi = e >> 6, d = e & 63, m = qi / 12, tr = qi - m * 12, t = tr / 3, r = tr - t * 3;
            qs[e] = bf2f(QD[(size_t)(MP + b * 4 + t) * DQW + ((g * 3 + r) * 2 + m) * 64 + d]); }
        if (tid < 8) pg[tid] = pt[b * 64 + c * 8 + tid];
        __syncthreads();
        {
            const int phys = pg[wave];
#pragma unroll 1
            for (int ks = 0; ks < 2; ++ks) {
                const int slot = lane + 64 * ks;
                const float* kb = ck + ((size_t)(phys * 128 + slot) * 4 + g) * 128;
                float acc[24];
#pragma unroll
                for (int q = 0; q < 24; ++q) acc[q] = 0.f;
#pragma unroll 1
                for (int dc = 0; dc < 16; ++dc) {
                    const f32x4 k0 = *(const f32x4*)(kb + 4 * dc), k1 = *(const f32x4*)(kb + 64 + 4 * dc);
#pragma unroll
                    for (int q = 0; q < 12; ++q) { const f32x4 qa = *(const LAS f32x4*)(qs + q * 64 + 4 * dc), qb = *(const LAS f32x4*)(qs + (12 + q) * 64 + 4 * dc);
                        acc[q] += (qa[0] * k0[0] + qa[1] * k0[1]) + (qa[2] * k0[2] + qa[3] * k0[3]);
                        acc[12 + q] += (qb[0] * k1[0] + qb[1] * k1[1]) + (qb[2] * k1[2] + qb[3] * k1[3]); }
                }
                const int kpos = (c * 8 + wave) * 128 + slot, kl = wave * 128 + slot;
#pragma unroll
                for (int t = 0; t < 4; ++t) { const int bk = rel_bucket(PAST + t - kpos);
#pragma unroll
                    for (int r = 0; r < 3; ++r) { const float bias = relb[bk * 12 + g * 3 + r];
                        sc[kl * 24 + t * 3 + r] = acc[t * 3 + r] * 0.125f + bias; sc[kl * 24 + 12 + t * 3 + r] = acc[12 + t * 3 + r] * 0.125f + bias; } }
            }
        }
        __syncthreads();
        for (int qi = wave; qi < 24; qi += NWAVES) {
            float mx = -INFINITY;
            for (int k = lane; k < 1024; k += 64) mx = fmaxf(mx, sc[k * 24 + qi]);
            mx = wave_max(mx);
            float sm = 0.f;
            for (int k = lane; k < 1024; k += 64) { const float p = __expf(sc[k * 24 + qi] - mx); sc[k * 24 + qi] = p; sm += p; }
            sm = wave_sum(sm);
            if (lane == 0) { PART[((size_t)u * 24 + qi) * PART_STRIDE + 128] = mx; PART[((size_t)u * 24 + qi) * PART_STRIDE + 129] = sm; }
        }
        __syncthreads();
        {
            const int dv = tid & 127, qg = tid >> 7;
            float o[6] = {0.f, 0.f, 0.f, 0.f, 0.f, 0.f};
            for (int kl = 0; kl < 1024; ++kl) {
                const int phys = pg[kl >> 7], slot = kl & 127;
                const float v = cv[((size_t)(phys * 128 + slot) * 4 + g) * 128 + dv];
                const LAS f32x2* pp = (const LAS f32x2*)(sc + kl * 24 + qg * 6);
                const f32x2 pa = pp[0], pb = pp[1], pc = pp[2];
                o[0] += pa[0] * v; o[1] += pa[1] * v; o[2] += pb[0] * v; o[3] += pb[1] * v; o[4] += pc[0] * v; o[5] += pc[1] * v;
            }
#pragma unroll
            for (int q = 0; q < 6; ++q) PART[((size_t)u * 24 + qg * 6 + q) * PART_STRIDE + dv] = o[q];
        }
    }
}


__device__ __forceinline__ void diff_sample_partial_mfma(const Args& A, LAS unsigned char* lds, int cidx, int ncu) {
    int tid = threadIdx.x; asm volatile("" : "+v"(tid));
    const int lane = tid & 63, wave = __builtin_amdgcn_readfirstlane(tid >> 6);
    const int r = lane & 15, c4 = lane >> 4;
    LAS float* ow = (LAS float*)lds;
    static_assert(8 * 24 * 132 * 4 <= RING_BYTES, "diff sample LDS map");
    const bf16* QD = (const bf16*)(A.ws + WS_QD); float* PART = (float*)(A.ws + WS_PART);
    const float* ck = (const float*)A.in[I_DCK]; const float* cv = (const float*)A.in[I_DCV]; const int* pt = (const int*)A.in[I_PT];
    const float* relb = (const float*)A.in[I_RELB];
    const int tq = r / 3, rep = r - tq * 3;
    for (int u = cidx; u < 1024; u += ncu) {
        const int b = u >> 5, g = (u >> 3) & 3, cc = u & 7, head = g * 3 + rep;
        __syncthreads();
        pg8::bf16x8 qf[2][2];
#pragma unroll
        for (int m = 0; m < 2; ++m)
#pragma unroll
            for (int ks = 0; ks < 2; ++ks) { v4u w = (v4u){0u, 0u, 0u, 0u};
                if (r < 12) w = *(const v4u*)(QD + (size_t)(MP + b * 4 + tq) * DQW + (head * 2 + m) * 64 + 16 * c4 + 8 * ks);
                qf[m][ks] = __builtin_bit_cast(pg8::bf16x8, w); }
        const int phys = pt[b * 64 + cc * 8 + wave], page_start = (cc * 8 + wave) * 128;
        const float* kp = ck + (size_t)phys * 128 * 512 + g * 128 + (size_t)r * 512 + 16 * c4;
        const float* vp = cv + (size_t)phys * 128 * 512 + g * 128 + (size_t)(4 * c4) * 512 + 8 * r;
        const bool far = (PAST - (page_start + 127)) >= 2048;
        const float bfar = (r < 12) ? relb[31 * 12 + head] : 0.f;
        f32x4 oacc[2][8];
#pragma unroll
        for (int m = 0; m < 2; ++m)
#pragma unroll
            for (int d = 0; d < 8; ++d) oacc[m][d] = (f32x4){0.f, 0.f, 0.f, 0.f};
        float m_run0 = -INFINITY, m_run1 = -INFINITY, l_run0 = 0.f, l_run1 = 0.f;
#pragma unroll 1
        for (int sb = 0; sb < 4; ++sb) {
            f32x4 S[2][2];
#pragma unroll
            for (int tt = 0; tt < 2; ++tt) { const float* kr = kp + (size_t)(sb * 32 + tt * 16) * 512;
#pragma unroll
                for (int m = 0; m < 2; ++m) { S[m][tt] = (f32x4){0.f, 0.f, 0.f, 0.f};
#pragma unroll
                    for (int ks = 0; ks < 2; ++ks) { const f32x4 a = *(const f32x4*)(kr + m * 64 + 8 * ks), a2 = *(const f32x4*)(kr + m * 64 + 8 * ks + 4);
                        v4u w; w.x = pk2(a[0], a[1]); w.y = pk2(a[2], a[3]); w.z = pk2(a2[0], a2[1]); w.w = pk2(a2[2], a2[3]);
                        S[m][tt] = __builtin_amdgcn_mfma_f32_16x16x32_bf16(__builtin_bit_cast(pg8::bf16x8, w), qf[m][ks], S[m][tt], 0, 0, 0); } } }
            float bias[2][4];
#pragma unroll
            for (int tt = 0; tt < 2; ++tt)
#pragma unroll
                for (int q = 0; q < 4; ++q) { float bv = bfar;
                    if (!far) { const int kpos = page_start + sb * 32 + tt * 16 + 4 * c4 + q; bv = (r < 12) ? relb[rel_bucket(PAST + tq - kpos) * 12 + head] : 0.f; }
                    bias[tt][q] = bv; }
            pg8::bf16x8 pf[2];
#pragma unroll
            for (int m = 0; m < 2; ++m) {
                float mx = -INFINITY;
#pragma unroll
                for (int tt = 0; tt < 2; ++tt)
#pragma unroll
                    for (int q = 0; q < 4; ++q) { const float x = S[m][tt][q] * 0.125f + bias[tt][q]; S[m][tt][q] = x; mx = fmaxf(mx, x); }
                mx = fmaxf(mx, __shfl_xor(mx, 16)); mx = fmaxf(mx, __shfl_xor(mx, 32));
                const float m_old = m ? m_run1 : m_run0, m_new = fmaxf(m_old, mx), alpha = __expf(m_old - m_new);
                float rs = 0.f;
#pragma unroll
                for (int tt = 0; tt < 2; ++tt)
#pragma unroll
                    for (int q = 0; q < 4; ++q) { const float pv = __expf(S[m][tt][q] - m_new); S[m][tt][q] = pv; rs += pv; }
                rs += __shfl_xor(rs, 16); rs += __shfl_xor(rs, 32);
                if (m) { l_run1 = l_run1 * alpha + rs; m_run1 = m_new; } else { l_run0 = l_run0 * alpha + rs; m_run0 = m_new; }
#pragma unroll
                for (int d = 0; d < 8; ++d) oacc[m][d] = oacc[m][d] * alpha;
                v4u w; w.x = pk2(S[m][0][0], S[m][0][1]); w.y = pk2(S[m][0][2], S[m][0][3]); w.z = pk2(S[m][1][0], S[m][1][1]); w.w = pk2(S[m][1][2], S[m][1][3]);
                pf[m] = __builtin_bit_cast(pg8::bf16x8, w);
            }
            const float* vr = vp + (size_t)(sb * 32) * 512;
#pragma unroll
            for (int hf = 0; hf < 2; ++hf) {
                __builtin_amdgcn_sched_barrier(0);
                f32x4 vv[8];
#pragma unroll
                for (int jj = 0; jj < 8; ++jj) vv[jj] = *(const f32x4*)(vr + (size_t)(16 * (jj >> 2) + (jj & 3)) * 512 + 4 * hf);
#pragma unroll
                for (int d = 0; d < 4; ++d) { v4u w; w.x = pk2(vv[0][d], vv[1][d]); w.y = pk2(vv[2][d], vv[3][d]); w.z = pk2(vv[4][d], vv[5][d]); w.w = pk2(vv[6][d], vv[7][d]);
                    const pg8::bf16x8 vf = __builtin_bit_cast(pg8::bf16x8, w);
                    oacc[0][4 * hf + d] = __builtin_amdgcn_mfma_f32_16x16x32_bf16(vf, pf[0], oacc[0][4 * hf + d], 0, 0, 0);
                    oacc[1][4 * hf + d] = __builtin_amdgcn_mfma_f32_16x16x32_bf16(vf, pf[1], oacc[1][4 * hf + d], 0, 0, 0); }
                __builtin_amdgcn_sched_barrier(0);
            }
        }
        if (r < 12) {
#pragma unroll
            for (int m = 0; m < 2; ++m) { LAS float* dst = ow + (wave * 24 + m * 12 + r) * 132;
#pragma unroll
                for (int q = 0; q < 4; ++q) { *(LAS f32x4*)(dst + 32 * c4 + 8 * q) = (f32x4){oacc[m][0][q], oacc[m][1][q], oacc[m][2][q], oacc[m][3][q]};
                    *(LAS f32x4*)(dst + 32 * c4 + 8 * q + 4) = (f32x4){oacc[m][4][q], oacc[m][5][q], oacc[m][6][q], oacc[m][7][q]}; }
                if (c4 == 0) { dst[128] = m ? m_run1 : m_run0; dst[129] = m ? l_run1 : l_run0; } }
        }
        __syncthreads();
        for (int idx = tid; idx < 24 * 128; idx += NTHR) { const int qi = idx >> 7, dv = idx & 127;
            float M = -INFINITY;
#pragma unroll
            for (int w = 0; w < 8; ++w) M = fmaxf(M, ow[(w * 24 + qi) * 132 + 128]);
            float o = 0.f, L = 0.f;
#pragma unroll
            for (int w = 0; w < 8; ++w) { const float e = __expf(ow[(w * 24 + qi) * 132 + 128] - M); o += ow[(w * 24 + qi) * 132 + dv] * e; L += ow[(w * 24 + qi) * 132 + 129] * e; }
            PART[((size_t)u * 24 + qi) * PART_STRIDE + dv] = o;
            if (dv == 0) { PART[((size_t)u * 24 + qi) * PART_STRIDE + 128] = M; PART[((size_t)u * 24 + qi) * PART_STRIDE + 129] = L; }
        }
    }
    __syncthreads();
}

__device__ __forceinline__ void diff_sample_combine_phase(const Args& A, float lam_init) {
    const int tid = threadIdx.x, lane = tid & 63, wave = __builtin_amdgcn_readfirstlane(tid >> 6);
    const int gw = blockIdx.x * NWAVES + wave, ngw = gridDim.x * NWAVES;
    const bf16* QD = (const bf16*)(A.ws + WS_QD); const bf16* KD = (const bf16*)(A.ws + WS_KD); const bf16* VD = (const bf16*)(A.ws + WS_VD); bf16* AOD = (bf16*)(A.ws + WS_AOD);
    const float* PART = (const float*)(A.ws + WS_PART);
    const float* relb = (const float*)A.in[I_RELB]; const float* onorm = (const float*)A.in[I_DON];
    const float lam = diff_lambda((const float*)A.in[I_DLAM], lane, lam_init);
    const float on0 = onorm[2 * lane], on1 = onorm[2 * lane + 1];
    for (int it = gw; it < NBS * 4 * 12; it += ngw) {
        const int b = it / 48, rem = it - b * 48, g = rem / 12, tr = rem - g * 12, t = tr / 3, r = tr - t * 3, h = g * 3 + r;
        const int row = MP + b * 4 + t;
        float res[2][2];
#pragma unroll
        for (int m = 0; m < 2; ++m) {
            const int qi = m * 12 + tr;
            const float qd = bf2f(QD[(size_t)row * DQW + (h * 2 + m) * 64 + lane]);
            float sn[4];
#pragma unroll
            for (int t2 = 0; t2 < 4; ++t2) { const float kd = bf2f(KD[(size_t)(MP + b * 4 + t2) * DKW + (g * 2 + m) * 64 + lane]);
                const float d = wave_sum(qd * kd); sn[t2] = (t2 <= t) ? d * 0.125f + relb[rel_bucket(t - t2) * 12 + h] : -INFINITY; }
            float M = fmaxf(fmaxf(sn[0], sn[1]), fmaxf(sn[2], sn[3]));
            float mc[8];
#pragma unroll
            for (int c = 0; c < 8; ++c) { mc[c] = PART[((size_t)((b * 4 + g) * 8 + c) * 24 + qi) * PART_STRIDE + 128]; M = fmaxf(M, mc[c]); }
            float Lsum = 0.f, o0 = 0.f, o1 = 0.f;
#pragma unroll
            for (int c = 0; c < 8; ++c) { const float* pp = PART + ((size_t)((b * 4 + g) * 8 + c) * 24 + qi) * PART_STRIDE; const float w = __expf(mc[c] - M);
                Lsum += pp[129] * w; const f32x2 ov = *(const f32x2*)(pp + 2 * lane); o0 += ov[0] * w; o1 += ov[1] * w; }
#pragma unroll
            for (int t2 = 0; t2 < 4; ++t2) { if (t2 <= t) { const float w = __expf(sn[t2] - M); Lsum += w;
                const unsigned vv = *(const unsigned*)(VD + (size_t)(MP + b * 4 + t2) * DKW + g * 128 + 2 * lane); o0 += w * bflo(vv); o1 += w * bfhi(vv); } }
            const float inv = 1.0f / Lsum; res[m][0] = o0 * inv; res[m][1] = o1 * inv;
        }
        const float a0 = res[0][0] - lam * res[1][0], a1 = res[0][1] - lam * res[1][1];
        const float ssq = wave_sum(a0 * a0 + a1 * a1), rr = rsqrtf(ssq * (1.0f / 128.0f) + EPS) * (1.0f - lam_init);
        *(unsigned*)(AOD + (size_t)row * DQW + h * 128 + 2 * lane) = pk2(a0 * rr * on0, a1 * rr * on1);
    }
}

constexpr int N_PHASES = 27;
__global__ void __launch_bounds__(NTHR, 2) hybrid_fwd(Args args) {
    extern __shared__ __attribute__((aligned(16))) unsigned char lds_raw[];
    LAS unsigned char* lds = (LAS unsigned char*)lds_raw;
    const int tid = threadIdx.x;
    volatile LAS unsigned* MISC = (volatile LAS unsigned*)(lds + MISC_OFF);
    for (int u = tid; u < (LDS_BYTES - LDSCTL_OFF) / 4; u += NTHR) ((LAS unsigned*)(lds + LDSCTL_OFF))[u] = 0u;
    __syncthreads();
    unsigned char* ws = args.ws;
    XcdBarrier bar; bar.bar = (unsigned*)(ws + WS_CTL) + CW_BAR; bar.x = 0; bar.st = nullptr;
#if !MK_PER_PHASE
    bar = xcd_barrier_post((unsigned*)(ws + WS_CTL) + CW_BAR, MISC + 8);
#endif
    const int lo = args.ph_lo, hi = args.ph_hi, G = gridDim.x, bx = blockIdx.x;
#define IN(k) (lo <= (k) && (k) < hi)
#if MK_PER_PHASE
#define SEAM(k) do { } while (0)
#else
#define SEAM(k) do { if (IN((k) + 1)) xcd_barrier(bar); } while (0)
#endif
    float* SS = (float*)(ws + WS_SS);
    bf16* XB = (bf16*)(ws + WS_XB);
    const float lam_init2 = 0.47071301f;

#define GEMM_PHASE(EPI, E, Aptr, Bptr, Ncols, Kdim) do { pg8::Gemm g_{(const pg8::bf16_t*)(Aptr), (const pg8::bf16_t*)(Bptr), MP, (Ncols), (Kdim)}; pg8::StaticOrder S_; S_.init(MP, (Ncols), G, bx); \
        pg8::gemm_phase<EPI, pg8::StaticOrder, true, true>(lds, g_, S_, E); } while (0)

    int ph = 0;
    if (IN(0)) { for (int rep = 0; rep < REP_PRO; ++rep) { prologue_phase(args, lds); __syncthreads(); } SEAM(0); for (int rep = 0; rep < PROBE_BAR; ++rep) xcd_barrier(bar); }

#define SSD_LAYER(P, LI, SSIN, SSMID, FFL, SSOUT, FIN) \
    if (IN((P) + 0)) { EpiSsdIn E{(bf16*)(ws + WS_ZX), (float*)(ws + WS_DT), SS + (SSIN) * (MPAD * 16), (const float*)args.in[I_DTB] + (LI) * 32}; \
        if (PROBE_SSDIN) GEMM_PHASE(EpiSsdIn, E, XB, ws + WS_WSSDIN + (LI) * al4k(SZ_WSSDIN), ZXW, DM); GEMM_PHASE(EpiSsdIn, E, XB, ws + WS_WSSDIN + (LI) * al4k(SZ_WSSDIN), ZXW, DM); \
        sk_ssdin(args, (const bf16*)(ws + WS_WSSDIN + (LI) * al4k(SZ_WSSDIN)), SS + (SSIN) * (MPAD * 16), (const float*)args.in[I_DTB] + (LI) * 32, (64 * 20) % G); SEAM((P) + 0); } \
    if (IN((P) + 1)) { for (int rep = 0; rep < REP_PRE; ++rep) ssd_prepass_phase(args, lds, (LI)); SEAM((P) + 1); } \
    if (IN((P) + 2)) { for (int rep = 0; rep < REP_SCAN; ++rep) { ssd_scan_phase(args, lds, (LI)); __syncthreads(); } SEAM((P) + 2); } \
    if (IN((P) + 3)) { ssd_gatenorm_phase(args, (LI), (bf16*)(ws + WS_YG)); if (PROBE_GN) ssd_gatenorm_phase(args, (LI), (bf16*)(ws + WS_ACT)); SEAM((P) + 3); } \
    if (IN((P) + 4)) { EpiRes E{XB, SS + (SSMID) * (MPAD * 16), nullptr, XB}; GEMM_PHASE(EpiRes, E, ws + WS_YG, ws + WS_WSSDOUT + (LI) * al4k(SZ_WSSDOUT), DM, DIN); \
        sk_res(args, (const bf16*)(ws + WS_YG), DIN, (const bf16*)(ws + WS_WSSDOUT + (LI) * al4k(SZ_WSSDOUT)), SS + (SSMID) * (MPAD * 16), nullptr, 0); SEAM((P) + 4); } \
    FFN_LAYER((P) + 5, FFL, SSMID, SSOUT, FIN)
#define FFN_LAYER(P, FFL, SSMID, SSOUT, FIN) \
    if (IN((P) + 0)) { EpiSwiGlu E{(bf16*)(ws + WS_ACT), SS + (SSMID) * (MPAD * 16)}; if (PROBE_FFIN == 1) { GEMM_PHASE(EpiSwiGlu, E, XB, ws + WS_WFFIN + (FFL) * al4k(SZ_WFFIN), 2 * DFF, DM); } if (PROBE_FFIN == 2) { EpiNone EN; GEMM_PHASE(EpiNone, EN, XB, ws + WS_WFFIN + (FFL) * al4k(SZ_WFFIN), 2 * DFF, DM); } GEMM_PHASE(EpiSwiGlu, E, XB, ws + WS_WFFIN + (FFL) * al4k(SZ_WFFIN), 2 * DFF, DM); \
        for (int rep = 0; rep < REP_SKSW; ++rep) sk_swiglu(args, (const bf16*)(ws + WS_WFFIN + (FFL) * al4k(SZ_WFFIN)), SS + (SSMID) * (MPAD * 16), (64 * 22) % G); for (int rep = 0; rep < REP_COPY; ++rep) cache_copy_slice(args, (FFL), 6, (64 * 22) % G); SEAM((P) + 0); } \
    if (IN((P) + 1)) { EpiRes E{XB, SS + ((SSOUT) & 7) * (MPAD * 16), (FIN) ? args.out : nullptr, XB}; if (PROBE_FFOUT) { EpiRes E2{XB, (float*)(ws + WS_ZX + ((size_t)96 << 20)), nullptr, (bf16*)(ws + WS_YG)}; GEMM_PHASE(EpiRes, E2, ws + WS_ACT, ws + WS_WFFOUT + (FFL) * al4k(SZ_WFFOUT), DM, DFF); } GEMM_PHASE(EpiRes, E, ws + WS_ACT, ws + WS_WFFOUT + (FFL) * al4k(SZ_WFFOUT), DM, DFF); \
        sk_res(args, (const bf16*)(ws + WS_ACT), DFF, (const bf16*)(ws + WS_WFFOUT + (FFL) * al4k(SZ_WFFOUT)), SS + ((SSOUT) & 7) * (MPAD * 16), (FIN) ? args.out : nullptr, 0); SEAM((P) + 1); }

    SSD_LAYER(1, 0, 0, 1, 0, 2, false)

    if (IN(8)) { EpiSwaQkv E{(bf16*)(ws + WS_QS), (bf16*)(ws + WS_KS), (bf16*)(ws + WS_VS), (bf16*)(ws + WS_VTS), SS + 2 * (MPAD * 16), (const float*)args.in[I_SWAQN], (const float*)args.in[I_SWAKN], args.out};
        if (PROBE_QKV) GEMM_PHASE(EpiSwaQkv, E, XB, ws + WS_WSWAQKV, 2304, DM); GEMM_PHASE(EpiSwaQkv, E, XB, ws + WS_WSWAQKV, 2304, DM); sk_swaqkv(args, (const bf16*)(ws + WS_WSWAQKV), SS + 2 * (MPAD * 16), (64 * 9) % G); cache_copy_slice(args, 4, 6, (64 * 9) % G); SEAM(8); }
    if (IN(9)) { for (int rep = 0; rep < REP_SWA; ++rep) { swa_attn_phase(args, lds); __syncthreads(); } SEAM(9); }
    if (IN(10)) { swa_combine_phase(args); SEAM(10); }
    if (IN(11)) { EpiRes E{XB, SS + 3 * (MPAD * 16), nullptr, XB}; GEMM_PHASE(EpiRes, E, ws + WS_AO, ws + WS_WSWAOUT, DM, SWAW); sk_res(args, (const bf16*)(ws + WS_AO), SWAW, (const bf16*)(ws + WS_WSWAOUT), SS + 3 * (MPAD * 16), nullptr, 0); SEAM(11); }
    FFN_LAYER(12, 1, 3, 4, false)

    if (IN(14)) { EpiDiffQkv E{(bf16*)(ws + WS_QD), (bf16*)(ws + WS_KD), (bf16*)(ws + WS_VD), (bf16*)(ws + WS_VTD), SS + 4 * (MPAD * 16), (const float*)args.in[I_DQN], (const float*)args.in[I_DKN], args.out};
        if (PROBE_QKV) GEMM_PHASE(EpiDiffQkv, E, XB, ws + WS_WDQKV, 2560, DM); GEMM_PHASE(EpiDiffQkv, E, XB, ws + WS_WDQKV, 2560, DM); sk_diffqkv(args, (const bf16*)(ws + WS_WDQKV), SS + 4 * (MPAD * 16), (64 * 10) % G); cache_copy_slice(args, 5, 6, (64 * 10) % G); SEAM(14); }
    if (IN(15)) {
        if (DIFF_PARTITION && G % 32 == 0) { const int grp = bx >> 3, xl = bx & 7;
            if ((grp & 3) == 0) diff_sample_partial_mfma(args, lds, (grp >> 2) * 8 + xl, G / 4);
            else diff_attn_prompt_mfma(args, lds, lam_init2, ((grp >> 2) * 3 + (grp & 3) - 1) * 8 + xl, G - G / 4); }
        else { diff_attn_prompt_mfma(args, lds, lam_init2, bx, G); if (REP_DATT > 1) diff_attn_prompt_mfma(args, lds, lam_init2, bx, G); diff_sample_partial_mfma(args, lds, bx, G); if (REP_DSMP > 1) diff_sample_partial_mfma(args, lds, bx, G); }
        SEAM(15); }
    if (IN(16)) { diff_sample_combine_phase(args, lam_init2); SEAM(16); }
    if (IN(17)) { EpiRes E{XB, SS + 5 * (MPAD * 16), nullptr, XB}; GEMM_PHASE(EpiRes, E, ws + WS_AOD, ws + WS_WDOUT, DM, DQW); sk_res(args, (const bf16*)(ws + WS_AOD), DQW, (const bf16*)(ws + WS_WDOUT), SS + 5 * (MPAD * 16), nullptr, 0); SEAM(17); }
    FFN_LAYER(18, 2, 5, 6, false)

    SSD_LAYER(20, 1, 6, 7, 3, 8, true)
    (void)ph;
#undef IN
#undef SEAM
}

extern "C" void kernel_launch(void* const* d_in, const int* in_sizes, int n_in, void* d_out, int out_size, void* d_ws, size_t ws_size, hipStream_t stream) {
    static int grid = 0;
    if (grid == 0) {
        if (n_in != N_IN || out_size != O_TOTAL || ws_size < WS_END) { fprintf(stderr, "kernel_launch: unexpected shapes: n_in %d out %d ws %zu (need %zu)\n", n_in, out_size, ws_size, (size_t)WS_END); grid = -1; return; }
        int dev = 0, cus = 0, per_cu = 0;
        if (hipGetDevice(&dev) != hipSuccess || hipDeviceGetAttribute(&cus, hipDeviceAttributeMultiprocessorCount, dev) != hipSuccess) { grid = -1; return; }
        if (hipFuncSetAttribute((const void*)hybrid_fwd, hipFuncAttributeMaxDynamicSharedMemorySize, LDS_BYTES) != hipSuccess) { fprintf(stderr, "kernel_launch: hipFuncSetAttribute failed\n"); grid = -1; return; }
        if (hipOccupancyMaxActiveBlocksPerMultiprocessor(&per_cu, (const void*)hybrid_fwd, NTHR, LDS_BYTES) != hipSuccess || per_cu < 1) fprintf(stderr, "kernel_launch: occupancy query says %d\n", per_cu);
        (void)hipGetLastError();
        grid = cus;
    }
    if (grid < 0) return;
    if (hipMemsetAsync((char*)d_ws + WS_CTL, 0, WS_ZERO_BYTES, stream) != hipSuccess) { fprintf(stderr, "kernel_launch: memset failed\n"); return; }
    Args a{};
    for (int i = 0; i < N_IN; ++i) a.in[i] = d_in[i];
    a.out = (float*)d_out; a.ws = (unsigned char*)d_ws;
#if MK_PER_PHASE
    for (int p = 0; p < N_PHASES; ++p) { a.ph_lo = p; a.ph_hi = p + 1; hipLaunchKernelGGL(hybrid_fwd, dim3(grid), dim3(NTHR), LDS_BYTES, stream, a); }
#else
    a.ph_lo = 0; a.ph_hi = N_PHASES; hipLaunchKernelGGL(hybrid_fwd, dim3(grid), dim3(NTHR), LDS_BYTES, stream, a);
#endif
    const hipError_t le = hipPeekAtLastError();
    if (le != hipSuccess) fprintf(stderr, "kernel_launch: launch failed: %s\n", hipGetErrorName(le));
}
```
